# Optimizing an MI355X kernel written in HIP

```python
import jax, jax.numpy as jnp
from jax import lax
import numpy as np

D_MODEL = 1024
BATCH = 2
SEQ = 8192
DEPTH = 4

CHUNK = 64
Q_BLOCK = 128
ROPE_THETA = 10000.0
NORM_EPS = 1e-6

SB_HEADS = 6
SB_DIM = 64
MLA_HEADS = 6
MLA_NOPE = 64
MLA_ROPE = 32
MLA_V = 64
MLA_Q_RANK = 256
MLA_KV_RANK = 128
DSA_HEADS = 4
DSA_DIM = 64
IDX_HEADS = 8
IDX_DIM = 32
DSA_TOPK_MAX = 256
N_BRANCHES = 3
N_EXPERTS = 32
TOP_K = 4
D_EXPERT = D_MODEL
SWIGLU_LIMIT = 7.0
SWIGLU_ALPHA = 1.702

IN_SPLIT_SIZES = (
    SB_HEADS * SB_DIM, SB_HEADS * SB_DIM, SB_HEADS * SB_DIM,
    MLA_Q_RANK, MLA_KV_RANK, MLA_ROPE,
    DSA_HEADS * DSA_DIM, DSA_HEADS * DSA_DIM, DSA_HEADS * DSA_DIM,
    IDX_HEADS * IDX_DIM, IDX_DIM, IDX_HEADS,
    N_BRANCHES * D_MODEL,
)
D_IN = (3 * SB_HEADS * SB_DIM + MLA_Q_RANK + MLA_KV_RANK + MLA_ROPE
        + 3 * DSA_HEADS * DSA_DIM + IDX_HEADS * IDX_DIM + IDX_DIM + IDX_HEADS
        + N_BRANCHES * D_MODEL)

kernel_name = "hybrid_sb_mla_dsa_moe_adaln"


def rms_norm(x, g):
    xf = x.astype(jnp.float32)
    y = xf * lax.rsqrt(jnp.mean(xf * xf, axis=-1, keepdims=True) + NORM_EPS)
    return (y * g.astype(jnp.float32)).astype(x.dtype)


def rope_tables(positions, dim):
    inv_freq = ROPE_THETA ** (-jnp.arange(0, dim, 2, dtype=jnp.float32) / dim)
    ang = positions.astype(jnp.float32)[..., None] * inv_freq
    return jnp.cos(ang), jnp.sin(ang)


def apply_rope(x, cos, sin):
    c = cos[:, :, None, :]
    s = sin[:, :, None, :]
    x1, x2 = jnp.split(x, 2, axis=-1)
    return jnp.concatenate([x1 * c - x2 * s, x2 * c + x1 * s], axis=-1)


def sweep_query_blocks(block_fn, seq_len):
    out = lax.map(block_fn, jnp.arange(seq_len // Q_BLOCK))
    nb, b, qb, w = out.shape
    return jnp.swapaxes(out, 0, 1).reshape(b, nb * qb, w)


def chunk_mask(t_ids, key_ids):
    return (key_ids // CHUNK)[None, :] <= (t_ids // CHUNK)[:, None]


def stick_breaking_attention(q, k, v):
    b, s_len, h, d = q.shape
    key_ids = jnp.arange(s_len)
    scale = d ** -0.5

    def block(i):
        t_ids = i * Q_BLOCK + jnp.arange(Q_BLOCK)
        qb = lax.dynamic_slice_in_dim(q, i * Q_BLOCK, Q_BLOCK, axis=1)
        z = jnp.einsum('bqhd,bkhd->bhqk', qb, k).astype(jnp.float32) * scale
        causal = key_ids[None, :] < t_ids[:, None]
        log_stay = jnp.where(causal, jax.nn.log_sigmoid(-z), 0.0)
        log_remain = lax.cumsum(log_stay, axis=3, reverse=True) - log_stay
        a = jnp.where(causal, jnp.exp(jax.nn.log_sigmoid(z) + log_remain), 0.0)
        o = jnp.einsum('bhqk,bkhd->bqhd', a.astype(v.dtype), v)
        return o.reshape(b, Q_BLOCK, h * d)

    return sweep_query_blocks(block, s_len)


def mla_attention(q_nope, q_rope, k_nope, k_rope, v):
    b, s_len, h, _ = q_nope.shape
    key_ids = jnp.arange(s_len)
    scale = (MLA_NOPE + MLA_ROPE) ** -0.5

    def block(i):
        t_ids = i * Q_BLOCK + jnp.arange(Q_BLOCK)
        qn = lax.dynamic_slice_in_dim(q_nope, i * Q_BLOCK, Q_BLOCK, axis=1)
        qr = lax.dynamic_slice_in_dim(q_rope, i * Q_BLOCK, Q_BLOCK, axis=1)
        sc = (jnp.einsum('bqhd,bkhd->bhqk', qn, k_nope)
              + jnp.einsum('bqhr,bkr->bhqk', qr, k_rope)).astype(jnp.float32) * scale
        sc = jnp.where(chunk_mask(t_ids, key_ids)[None, None], sc, -jnp.inf)
        p = jax.nn.softmax(sc, axis=-1)
        o = jnp.einsum('bhqk,bkhd->bqhd', p.astype(v.dtype), v)
        return o.reshape(b, Q_BLOCK, h * MLA_V)

    return sweep_query_blocks(block, s_len)


def dsa_attention(q, k, v, q_idx, k_idx, w_idx, n_select):
    b, s_len, h, d = q.shape
    key_ids = jnp.arange(s_len)
    scale = d ** -0.5
    gather = jax.vmap(lambda arr, ids: arr[ids])

    def block(i):
        t_ids = i * Q_BLOCK + jnp.arange(Q_BLOCK)
        qi = lax.dynamic_slice_in_dim(q_idx, i * Q_BLOCK, Q_BLOCK, axis=1)
        wi = lax.dynamic_slice_in_dim(w_idx, i * Q_BLOCK, Q_BLOCK, axis=1)
        rel = jax.nn.relu(jnp.einsum('bqhd,bkd->bqhk', qi, k_idx).astype(jnp.float32) * IDX_DIM ** -0.5)
        score = jnp.einsum('bqhk,bqh->bqk', rel, wi.astype(jnp.float32)) * IDX_HEADS ** -0.5
        score = jnp.where(chunk_mask(t_ids, key_ids)[None], score, -jnp.inf)
        _, sel = lax.top_k(score, n_select)
        valid = (sel // CHUNK) <= (t_ids // CHUNK)[None, :, None]
        kg = gather(k, sel)
        vg = gather(v, sel)
        qb = lax.dynamic_slice_in_dim(q, i * Q_BLOCK, Q_BLOCK, axis=1)
        sc = jnp.einsum('bqhd,bqkhd->bhqk', qb, kg).astype(jnp.float32) * scale
        sc = jnp.where(valid[:, None], sc, -jnp.inf)
        p = jax.nn.softmax(sc, axis=-1)
        o = jnp.einsum('bhqk,bqkhd->bqhd', p.astype(vg.dtype), vg)
        return o.reshape(b, Q_BLOCK, h * d)

    return sweep_query_blocks(block, s_len)


def hybrid_mixer(h, w_in, q_norm_g, kv_norm_g, w_uq, w_ukv, w_sb_out, w_mla_out, w_dsa_out,
                 w_out, rope_dsa, rope_mla, rope_idx, n_select):
    b, s_len, _ = h.shape
    split_points = np.cumsum(IN_SPLIT_SIZES)[:-1].tolist()
    (sb_q, sb_k, sb_v, mla_cq, mla_ckv, mla_kr, dsa_q, dsa_k, dsa_v,
     idx_q, idx_k, idx_w, gate_logits) = jnp.split(h @ w_in, split_points, axis=-1)

    def heads(t, n):
        return t.reshape(b, s_len, n, -1)

    y_sb = stick_breaking_attention(heads(sb_q, SB_HEADS), heads(sb_k, SB_HEADS),
                                    heads(sb_v, SB_HEADS)) @ w_sb_out

    q_mla = heads(rms_norm(mla_cq, q_norm_g) @ w_uq, MLA_HEADS)
    q_nope, q_rope = jnp.split(q_mla, [MLA_NOPE], axis=-1)
    q_rope = apply_rope(q_rope, *rope_mla)
    kv = heads(rms_norm(mla_ckv, kv_norm_g) @ w_ukv, MLA_HEADS)
    k_nope, v_mla = jnp.split(kv, [MLA_NOPE], axis=-1)
    k_rope = apply_rope(mla_kr[:, :, None, :], *rope_mla)[:, :, 0, :]
    y_mla = mla_attention(q_nope, q_rope, k_nope, k_rope, v_mla) @ w_mla_out

    qd = apply_rope(heads(dsa_q, DSA_HEADS), *rope_dsa)
    kd = apply_rope(heads(dsa_k, DSA_HEADS), *rope_dsa)
    vd = heads(dsa_v, DSA_HEADS)
    qi = apply_rope(heads(idx_q, IDX_HEADS), *rope_idx)
    ki = apply_rope(idx_k[:, :, None, :], *rope_idx)[:, :, 0, :]
    y_dsa = dsa_attention(qd, kd, vd, qi, ki, idx_w, n_select) @ w_dsa_out

    g_sb, g_mla, g_dsa = jnp.split(jax.nn.sigmoid(gate_logits), N_BRANCHES, axis=-1)
    return (g_sb * y_sb + g_mla * y_mla + g_dsa * y_dsa) @ w_out


def clamped_swiglu(gu):
    gate, up = jnp.split(gu, 2, axis=-1)
    gate = jnp.minimum(gate, SWIGLU_LIMIT)
    up = jnp.clip(up, -SWIGLU_LIMIT, SWIGLU_LIMIT)
    return (up + 1.0) * (gate * jax.nn.sigmoid(SWIGLU_ALPHA * gate))


def moe_ffn(h, router_w, router_b, w_gu, b_gu, w_down, b_down):
    b, s_len, d = h.shape
    tok = h.reshape(b * s_len, d)
    logits = (tok @ router_w + router_b).astype(jnp.float32)
    top_v, top_i = lax.top_k(logits, TOP_K)
    top_w = jax.nn.softmax(top_v, axis=-1)
    combine = jnp.einsum('tk,tke->te', top_w, jax.nn.one_hot(top_i, N_EXPERTS, dtype=jnp.float32))
    y = jnp.zeros((b * s_len, d), jnp.float32)
    for e in range(N_EXPERTS):
        out_e = clamped_swiglu(tok @ w_gu[e] + b_gu[e]) @ w_down[e] + b_down[e]
        y = y + combine[:, e:e + 1] * out_e
    return y.reshape(b, s_len, d).astype(h.dtype)


def setup_inputs(seed: int = 0) -> dict:
    key = jax.random.key(seed)
    ks = jax.random.split(key, 24)

    def nrm(k, shape, scale):
        return jax.random.normal(k, shape, jnp.float32) * scale

    def gain(k, shape):
        return 1.0 + nrm(k, shape, 0.05)

    d_sb = SB_HEADS * SB_DIM
    d_mla = MLA_HEADS * MLA_V
    d_dsa = DSA_HEADS * DSA_DIM
    offsets = jax.random.randint(ks[2], (BATCH,), 0, 64, dtype=jnp.int32) * CHUNK
    positions = offsets[:, None] + jnp.arange(SEQ, dtype=jnp.int32)[None, :]
    return {
        "x": nrm(ks[0], (BATCH, SEQ, D_MODEL), 1.0),
        "c": nrm(ks[1], (BATCH, D_MODEL), 1.0),
        "positions": positions,
        "ada_w": nrm(ks[3], (DEPTH, D_MODEL, 6 * D_MODEL), 0.5 * D_MODEL ** -0.5),
        "ada_b": nrm(ks[4], (DEPTH, 6 * D_MODEL), 0.02),
        "norm_mix_g": gain(ks[5], (DEPTH, D_MODEL)),
        "w_in": nrm(ks[6], (DEPTH, D_MODEL, D_IN), D_MODEL ** -0.5),
        "mla_q_norm_g": gain(ks[7], (DEPTH, MLA_Q_RANK)),
        "mla_kv_norm_g": gain(ks[8], (DEPTH, MLA_KV_RANK)),
        "mla_w_uq": nrm(ks[9], (DEPTH, MLA_Q_RANK, MLA_HEADS * (MLA_NOPE + MLA_ROPE)), MLA_Q_RANK ** -0.5),
        "mla_w_ukv": nrm(ks[10], (DEPTH, MLA_KV_RANK, MLA_HEADS * (MLA_NOPE + MLA_V)), MLA_KV_RANK ** -0.5),
        "w_sb_out": nrm(ks[11], (DEPTH, d_sb, D_MODEL), d_sb ** -0.5),
        "w_mla_out": nrm(ks[12], (DEPTH, d_mla, D_MODEL), d_mla ** -0.5),
        "w_dsa_out": nrm(ks[13], (DEPTH, d_dsa, D_MODEL), d_dsa ** -0.5),
        "w_out": nrm(ks[14], (DEPTH, D_MODEL, D_MODEL), D_MODEL ** -0.5),
        "norm_ffn_g": gain(ks[15], (DEPTH, D_MODEL)),
        "router_w": nrm(ks[16], (DEPTH, D_MODEL, N_EXPERTS), D_MODEL ** -0.5),
        "router_b": nrm(ks[17], (DEPTH, N_EXPERTS), 0.01),
        "expert_w_gu": nrm(ks[18], (DEPTH, N_EXPERTS, D_MODEL, 2 * D_EXPERT), D_MODEL ** -0.5),
        "expert_b_gu": nrm(ks[19], (DEPTH, N_EXPERTS, 2 * D_EXPERT), 0.02),
        "expert_w_down": nrm(ks[20], (DEPTH, N_EXPERTS, D_EXPERT, D_MODEL), D_EXPERT ** -0.5),
        "expert_b_down": nrm(ks[21], (DEPTH, N_EXPERTS, D_MODEL), 0.02),
        "final_norm_g": gain(ks[22], (D_MODEL,)),
    }


def reference(x, c, positions, ada_w, ada_b, norm_mix_g, w_in, mla_q_norm_g, mla_kv_norm_g,
              mla_w_uq, mla_w_ukv, w_sb_out, w_mla_out, w_dsa_out, w_out, norm_ffn_g,
              router_w, router_b, expert_w_gu, expert_b_gu, expert_w_down, expert_b_down,
              final_norm_g):
    seq_len = x.shape[1]
    n_select = min(DSA_TOPK_MAX, seq_len // 4)
    rope_dsa = rope_tables(positions, DSA_DIM)
    rope_mla = rope_tables(positions, MLA_ROPE)
    rope_idx = rope_tables(positions, IDX_DIM)
    silu_c = jax.nn.silu(c)
    for l in range(DEPTH):
        mod = silu_c @ ada_w[l] + ada_b[l]
        sh_m, sc_m, g_m, sh_f, sc_f, g_f = [m[:, None, :] for m in jnp.split(mod, 6, axis=-1)]
        h = rms_norm(x, norm_mix_g[l]) * (1.0 + sc_m) + sh_m
        x = x + g_m * hybrid_mixer(h, w_in[l], mla_q_norm_g[l], mla_kv_norm_g[l], mla_w_uq[l],
                                   mla_w_ukv[l], w_sb_out[l], w_mla_out[l], w_dsa_out[l], w_out[l],
                                   rope_dsa, rope_mla, rope_idx, n_select)
        h = rms_norm(x, norm_ffn_g[l]) * (1.0 + sc_f) + sh_f
        x = x + g_f * moe_ffn(h, router_w[l], router_b[l], expert_w_gu[l], expert_b_gu[l],
                              expert_w_down[l], expert_b_down[l])
    return rms_norm(x, final_norm_g)
```

```cpp
#include <hip/hip_runtime.h>
#include <cstdio>
#include <cstdint>

#define LAS __attribute__((address_space(3)))
#define GAS __attribute__((address_space(1)))
typedef unsigned short bf16_t;
typedef short bf16x8 __attribute__((ext_vector_type(8)));
typedef short s16x4 __attribute__((ext_vector_type(4)));
typedef float f32x2 __attribute__((ext_vector_type(2)));
typedef float f32x4 __attribute__((ext_vector_type(4)));
typedef float f32x16 __attribute__((ext_vector_type(16)));
typedef unsigned u32x2 __attribute__((ext_vector_type(2)));
typedef unsigned u32x4 __attribute__((ext_vector_type(4)));
typedef GAS unsigned gu32;
#define RLX_AGENT __ATOMIC_RELAXED, __HIP_MEMORY_SCOPE_AGENT
#define DI __device__ __forceinline__

constexpr int BATCH = 2, SEQ = 8192, DM = 1024, DEPTH = 4, T = BATCH * SEQ;
constexpr int D_IN = 5704, NPROJ = 5888;
constexpr int C_SBQ = 0, C_SBK = 384, C_SBV = 768, C_CQ = 1152, C_CKV = 1408, C_KR = 1536, C_DQ = 1568, C_DK = 1824, C_DV = 2080,
              C_IQ = 2336, C_IK = 2592, C_IW = 2624, C_GATE = 2632;
constexpr int NEXP = 32, ECAP = T;
constexpr float NORM_EPS = 1e-6f;
constexpr int NWAVES = 8, NTHR = 512;

DI unsigned f2bf(float f) { unsigned u = __builtin_bit_cast(unsigned, f); return (u + 0x7fffu + ((u >> 16) & 1u)) >> 16; }
DI unsigned pk2(float lo, float hi) { return f2bf(lo) | (f2bf(hi) << 16); }
DI float bf2f(unsigned short h) { return __builtin_bit_cast(float, (unsigned)h << 16); }
DI float bflo(unsigned w) { return __builtin_bit_cast(float, w << 16); }
DI float bfhi(unsigned w) { return __builtin_bit_cast(float, w & 0xffff0000u); }
DI unsigned cvt_pk_bf16(float lo, float hi) { unsigned r; asm volatile("v_cvt_pk_bf16_f32 %0, %1, %2" : "=v"(r) : "v"(lo), "v"(hi)); return r; }
DI float shx(float v, int o, int lane) { return __builtin_bit_cast(float, __builtin_amdgcn_ds_bpermute((lane ^ o) << 2, __builtin_bit_cast(int, v))); }
DI float shl(float v, int src) { return __builtin_bit_cast(float, __builtin_amdgcn_ds_bpermute(src << 2, __builtin_bit_cast(int, v))); }
DI unsigned long long shx64(unsigned long long v, int o, int lane) {
    const unsigned lo = (unsigned)__builtin_amdgcn_ds_bpermute((lane ^ o) << 2, (int)(unsigned)v), hi = (unsigned)__builtin_amdgcn_ds_bpermute((lane ^ o) << 2, (int)(unsigned)(v >> 32));
    return ((unsigned long long)hi << 32) | lo; }
DI float wave_sum(float v, int lane) {
#pragma unroll
    for (int o = 1; o < 64; o <<= 1) v += shx(v, o, lane);
    return v;
}
DI float zero_op() { float z = 0.f; asm volatile("" : "+v"(z)); return z; }
DI size_t opq(size_t v) { asm volatile("" : "+s"(v)); return v; }
DI float fast_sigmoid(float x) { return __builtin_amdgcn_rcpf(1.0f + __builtin_amdgcn_exp2f(-1.4426950408889634f * x)); }

namespace pg8 {
constexpr int BM = 256, BK = 64, HALF = 128, HTB = HALF * BK * 2, STAGE_BYTES = 8 * HTB, NXCD = 8, WGM = 8;
__host__ __device__ __forceinline__ int lds_byte(int r, int c) { const int st = (r >> 4) * 2 + (c >> 5), rr = r & 15, cc = c & 31, ob = rr * 64 + cc * 2; return st * 1024 + (ob ^ (((ob >> 9) & 1) << 5)); }
__host__ __device__ __forceinline__ void stage_rc(int b, int& R, int& C) { const int st = b / 1024, sb = b % 1024, swz = sb ^ (((sb >> 9) & 1) << 5); R = (st >> 1) * 16 + swz / 64; C = (st & 1) * 32 + (swz % 64) / 2; }
__host__ __device__ __forceinline__ int perm32(int rho) { const int n = rho >> 4, i = rho & 15; return 8 * (i >> 2) + 4 * n + (i & 3); }

struct Unit { int pm, pn, e, row0, nrows, par; };

struct DenseSched {
    const bf16_t* A; const bf16_t* Bt; int K; int nM, nN, nwg, G, c, lda;
    DI void init(const bf16_t* A_, const bf16_t* Bt_, int M, int N, int K_, int G_, int c_, int lda_ = 0) { A = A_; Bt = Bt_; K = K_; nM = M / BM; nN = N / BM; nwg = nM * nN; G = G_; c = c_; lda = lda_ ? lda_ : K_; }
    DI bool next(int i, Unit& u) const {
        const long L = (long)i * G + c; if (L >= nwg) return false;
        int wgid = (int)L; { const int q = nwg / NXCD, r = nwg % NXCD, xcd = wgid % NXCD, off = wgid / NXCD; wgid = (xcd < r ? xcd * (q + 1) : r * (q + 1) + (xcd - r) * q) + off; }
        const int nig = WGM * nN, gid = wgid / nig, fm = gid * WGM, gsz = (nM - fm) < WGM ? (nM - fm) : WGM;
        u.pm = fm + ((wgid % nig) % gsz); u.pn = (wgid % nig) / gsz; u.e = 0; u.row0 = u.pm * BM; u.nrows = BM; return true;
    }
    DI const char* abase(const Unit& u) const { return (const char*)A + (size_t)u.pm * BM * lda * 2; }
    DI const char* bbase(const Unit& u) const { return (const char*)Bt + (size_t)u.pn * BM * K * 2; }
    DI void aoffs(const Unit&, int R, int C, unsigned (&v)[4]) const {
#pragma unroll
        for (int m = 0; m < 4; ++m) v[m] = (unsigned)((R + 64 * m) * lda + C) * 2u;
    }
    DI void prefetch(const Unit&, int, int) const {}
    DI void aoffs_next(const Unit& u, int R, int C, unsigned (&v)[4], int) const { aoffs(u, R, C, v); }
};

template <class Epi, class Sched, bool ALIGN_EPI>
DI void gemm_phase(LAS unsigned char* lds, const Sched& S, const Epi& E) {
    int tid = threadIdx.x; asm volatile("" : "+v"(tid));
    const int wid = __builtin_amdgcn_readfirstlane(tid >> 6), lane = tid & 63, wr = wid >> 2, wc = wid & 3, fr = lane & 15, fq = lane >> 4;
    const int K = S.K, nt = K / BK;
    int sR, sC; stage_rc(tid * 16, sR, sC);
    unsigned voffB[2];
#pragma unroll
    for (int i = 0; i < 2; ++i) { const int R = sR + 64 * i; const int Rb = Epi::PERM ? ((R & ~31) + perm32(R & 31)) : R; voffB[i] = (unsigned)(Rb * K + sC) * 2u; }
    const size_t kstep = (size_t)(BK * 2);
    const size_t hstep = (size_t)HALF * K * 2;
    const unsigned ldsw = (unsigned)wid * 1024u;
    const int aoff = lds_byte(wr * 64 + fr, fq * 8), boff = lds_byte(wc * 32 + fr, fq * 8);
#define PG8_SA(b, h) (((b) * 2 + (h)) * HTB)
#define PG8_SB(b, h) ((4 + (b) * 2 + (h)) * HTB)
#define PG8_STAGEB(bufoff, gbase) do { _Pragma("unroll") for (int _i = 0; _i < 2; ++_i) \
        __builtin_amdgcn_global_load_lds((const unsigned*)((const char*)(gbase) + voffB[_i]), (LAS unsigned*)(lds + (bufoff) + ldsw + _i * 8192), 16, 0, 0); } while (0)
#define PG8_STAGEA(bufoff, gbase, v0, v1) do { \
        __builtin_amdgcn_global_load_lds((const unsigned*)((const char*)(gbase) + (v0)), (LAS unsigned*)(lds + (bufoff) + ldsw), 16, 0, 0); \
        __builtin_amdgcn_global_load_lds((const unsigned*)((const char*)(gbase) + (v1)), (LAS unsigned*)(lds + (bufoff) + ldsw + 8192), 16, 0, 0); } while (0)
#define PG8_LDA(dst, b, h) do { _Pragma("unroll") for (int m = 0; m < 4; ++m) _Pragma("unroll") for (int k = 0; k < 2; ++k) dst[m][k] = *(const LAS bf16x8*)(lds + PG8_SA(b, h) + aoff + m * 2048 + k * 1024); } while (0)
#define PG8_LDB(dst, b, h) do { _Pragma("unroll") for (int n = 0; n < 2; ++n) _Pragma("unroll") for (int k = 0; k < 2; ++k) dst[n][k] = *(const LAS bf16x8*)(lds + PG8_SB(b, h) + boff + n * 2048 + k * 1024); } while (0)
#define PG8_MMA(ai, bj, At, Bt) do { __builtin_amdgcn_s_setprio(1); _Pragma("unroll") for (int m = 0; m < 4; ++m) _Pragma("unroll") for (int n = 0; n < 2; ++n) _Pragma("unroll") for (int k = 0; k < 2; ++k) \
        acc[ai][bj][m][n] = __builtin_amdgcn_mfma_f32_16x16x32_bf16(Bt[n][k], At[m][k], acc[ai][bj][m][n], 0, 0, 0); __builtin_amdgcn_s_setprio(0); } while (0)
#define PG8_WAIT_V(n) asm volatile("s_waitcnt vmcnt(" #n ")" ::: "memory")
#define PG8_WAIT_L(n) asm volatile("s_waitcnt lgkmcnt(" #n ")" ::: "memory")
#define PG8_BAR __builtin_amdgcn_s_barrier()
#define PG8_SCHED __builtin_amdgcn_sched_barrier(0)
    Unit cur, nxt; int ui = 0;
    if (!S.next(0, cur)) return;
    f32x4 acc[2][2][4][2];
    float zz = 0.f; asm volatile("" : "+v"(zz));
#pragma unroll
    for (int a = 0; a < 2; ++a)
#pragma unroll
        for (int b = 0; b < 2; ++b)
#pragma unroll
            for (int m = 0; m < 4; ++m)
#pragma unroll
                for (int n = 0; n < 2; ++n) acc[a][b][m][n] = (f32x4){zz, zz, zz, zz};
    bf16x8 At[4][2], B0[2][2], B1[2][2];
    const char* cA = S.abase(cur); const char* cB = S.bbase(cur);
    unsigned cv[4];
    S.aoffs(cur, sR, sC, cv);
    PG8_STAGEB(PG8_SB(0, 0), cB); PG8_STAGEB(PG8_SB(0, 1), cB + hstep); PG8_STAGEA(PG8_SA(0, 0), cA, cv[0], cv[1]); PG8_STAGEA(PG8_SA(0, 1), cA, cv[2], cv[3]);
    if (wr == 1) PG8_BAR;
    PG8_WAIT_V(2); PG8_BAR;
    PG8_STAGEB(PG8_SB(1, 0), cB + kstep); PG8_STAGEA(PG8_SA(1, 0), cA + kstep, cv[0], cv[1]); PG8_STAGEB(PG8_SB(1, 1), cB + hstep + kstep);
    PG8_WAIT_V(6); PG8_BAR;
    for (;;) {
        const bool has_next = S.next(ui + 1, nxt);
        cur.par = ui & 1;
        { int t2 = threadIdx.x; asm volatile("" : "+v"(t2)); E.prefetch(cur, t2); }
        const char* nA = cA; const char* nB = cB;
        if (has_next) { nA = S.abase(nxt); nB = S.bbase(nxt); int t2 = threadIdx.x; asm volatile("" : "+v"(t2)); S.prefetch(nxt, t2, (ui + 1) & 1); }
        for (int t = 0; t < nt; t += 2) {
            const bool last = (t == nt - 2);
            const char* a1 = cA + (size_t)(t + 1) * kstep;
            const char* a2 = last ? nA : cA + (size_t)(t + 2) * kstep; const char* b2 = last ? nB : cB + (size_t)(t + 2) * kstep;
            const char* a3 = a2 + kstep; const char* b3 = b2 + kstep;
            unsigned wv[4];
#pragma unroll
            for (int m = 0; m < 4; ++m) wv[m] = cv[m];
            if (last && has_next) { int t2 = threadIdx.x; asm volatile("" : "+v"(t2)); int R2, C2; stage_rc(t2 * 16, R2, C2); S.aoffs_next(nxt, R2, C2, wv, (ui + 1) & 1); }
            const unsigned w0 = wv[0], w1 = wv[1], w2 = wv[2], w3 = wv[3];
            PG8_LDB(B0, 0, 0); PG8_LDB(B1, 0, 1); PG8_SCHED; PG8_LDA(At, 0, 0); PG8_STAGEA(PG8_SA(1, 1), a1, cv[2], cv[3]);
            PG8_WAIT_V(8); PG8_WAIT_L(0); PG8_BAR; PG8_MMA(0, 0, At, B0); PG8_MMA(0, 1, At, B1); PG8_BAR; PG8_SCHED;
            PG8_LDA(At, 0, 1); PG8_STAGEB(PG8_SB(0, 0), b2); PG8_STAGEB(PG8_SB(0, 1), b2 + hstep); PG8_STAGEA(PG8_SA(0, 0), a2, w0, w1);
            PG8_WAIT_V(8); PG8_WAIT_L(0); PG8_BAR; PG8_MMA(1, 0, At, B0); PG8_MMA(1, 1, At, B1); PG8_BAR; PG8_SCHED;
            PG8_LDB(B0, 1, 0); PG8_LDB(B1, 1, 1); PG8_SCHED; PG8_LDA(At, 1, 0); PG8_STAGEA(PG8_SA(0, 1), a2, w2, w3);
            PG8_WAIT_V(8); PG8_WAIT_L(0); PG8_BAR; PG8_MMA(0, 0, At, B0); PG8_MMA(0, 1, At, B1); PG8_BAR; PG8_SCHED;
            PG8_LDA(At, 1, 1); PG8_STAGEB(PG8_SB(1, 0), b3); PG8_STAGEB(PG8_SB(1, 1), b3 + hstep); PG8_STAGEA(PG8_SA(1, 0), a3, w0, w1);
            PG8_WAIT_V(8); PG8_WAIT_L(0); PG8_BAR; PG8_MMA(1, 0, At, B0); PG8_MMA(1, 1, At, B1); PG8_BAR; PG8_SCHED;
        }
        if constexpr (ALIGN_EPI) { if (wr == 0) PG8_BAR; }
        { int t2 = threadIdx.x; asm volatile("" : "+v"(t2)); const int l2 = t2 & 63; E(acc, cur, wr, wc, l2 & 15, l2 >> 4); }
        if (!has_next) break;
#pragma unroll
        for (int a = 0; a < 2; ++a)
#pragma unroll
            for (int b = 0; b < 2; ++b)
#pragma unroll
                for (int m = 0; m < 4; ++m)
#pragma unroll
                    for (int n = 0; n < 2; ++n) acc[a][b][m][n] = (f32x4){zz, zz, zz, zz};
        cur = nxt; cA = nA; cB = nB; ++ui;
        { int t2 = threadIdx.x; asm volatile("" : "+v"(t2)); int R2, C2; stage_rc(t2 * 16, R2, C2); S.aoffs_next(cur, R2, C2, cv, ui & 1); }
        if constexpr (ALIGN_EPI) { if (wr == 1) PG8_BAR; }
    }
    PG8_WAIT_V(0);
    if constexpr (!ALIGN_EPI) { if (wr == 0) PG8_BAR; }
    PG8_BAR;
#undef PG8_SA
#undef PG8_SB
#undef PG8_STAGEA
#undef PG8_STAGEB
#undef PG8_LDA
#undef PG8_LDB
#undef PG8_MMA
#undef PG8_WAIT_V
#undef PG8_WAIT_L
#undef PG8_BAR
#undef PG8_SCHED
}
}
constexpr size_t MiB = 1u << 20;
constexpr size_t WS_CTL = 0, CTL_ZERO_BYTES = 1 * MiB;
constexpr size_t WS_MOD   = 1 * MiB;
constexpr size_t WS_ROPE32 = 2 * MiB;
constexpr size_t WS_ROPE16 = 6 * MiB;
constexpr size_t WS_WIN   = 8 * MiB;
constexpr size_t WS_WUQ   = 56 * MiB;
constexpr size_t WS_WUKV  = 58 * MiB;
constexpr size_t WS_WSB   = 60 * MiB;
constexpr size_t WS_WMLA  = 64 * MiB;
constexpr size_t WS_WDSA  = 68 * MiB;
constexpr size_t WS_WOUT  = 72 * MiB;
constexpr size_t WS_WGU   = 80 * MiB;
constexpr size_t WS_WDN   = 592 * MiB;
constexpr size_t WS_X     = 848 * MiB;
constexpr size_t WS_XN    = 912 * MiB;
constexpr size_t WS_PROJ  = 944 * MiB;
constexpr size_t WS_CQN   = 1128 * MiB;
constexpr size_t WS_CKVN  = 1136 * MiB;
constexpr size_t WS_KR    = 1140 * MiB;
constexpr size_t WS_DK    = 1141 * MiB;
constexpr size_t WS_IK    = 1149 * MiB;
constexpr size_t WS_IW    = 1150 * MiB;
constexpr size_t WS_QM    = 1152 * MiB;
constexpr size_t WS_KVM   = 1176 * MiB;
constexpr size_t WS_OSB   = 1200 * MiB;
constexpr size_t WS_OMLA  = 1212 * MiB;
constexpr size_t WS_ODSA  = 1224 * MiB;
constexpr size_t WS_MRG   = 1232 * MiB;
constexpr size_t WS_LIST  = 1264 * MiB;
constexpr size_t WS_LISTW = 1266 * MiB;
constexpr size_t WS_TOKE  = 1268 * MiB;
constexpr size_t WS_ACT   = 1272 * MiB;
constexpr size_t WS_EOUT  = 1402 * MiB;
constexpr size_t WS_BM    = 1532 * MiB;
constexpr size_t WS_END   = 1548 * MiB;
constexpr int CW_BAR = 4096;
constexpr int CW_CNT = 8192;
constexpr int CW_QATT = 8192 + 256;
constexpr int CW_SELF = 16384;
constexpr int CW_KMAX = 8192 + 1024;

constexpr int RING_OFF = 0, RING_BYTES = 131072;
constexpr int MISC_OFF = RING_BYTES;
constexpr int LDS_BYTES = 147456;

#define XB_TMO      128
#define XB_XCNT(j)  (256  + 64 * (j))
#define XB_XSUB(j)  (1280 + 64 * (j))
#define XB_XGEN(j)  (2304 + 64 * (j))
#define XB_TOP      3328
#define XB_TOPGEN   3392
#define XCD_BAR_WORDS 3456
#define XB_SPIN_CAP (1u << 18)

__device__ __forceinline__ unsigned xb_ld(unsigned* p)              { return __hip_atomic_load(p, __ATOMIC_RELAXED, __HIP_MEMORY_SCOPE_AGENT); }
__device__ __forceinline__ unsigned xb_add(unsigned* p, unsigned v) { return __hip_atomic_fetch_add(p, v, __ATOMIC_RELAXED, __HIP_MEMORY_SCOPE_AGENT); }
__device__ __forceinline__ unsigned xb_xcc_id() { return (unsigned)__builtin_amdgcn_s_getreg((3 << 11) | 20) & 0xFu; }
#define XB_SPIN(cond, bar) do { unsigned _sp = 0; while (cond) { __builtin_amdgcn_s_sleep(1); \
    if ((++_sp & 255u) == 0u) { if (xb_ld(&(bar)[XB_TMO])) break; if (_sp > XB_SPIN_CAP) { atomicAdd(&(bar)[XB_TMO], 1u); break; } } } } while (0)

struct XcdBarrier { unsigned* bar; unsigned x; volatile LAS unsigned* st; };

__device__ __forceinline__ XcdBarrier xcd_barrier_post(unsigned* bar, volatile LAS unsigned* st) {
    XcdBarrier b; b.bar = bar; b.x = xb_xcc_id(); b.st = st;
    if (threadIdx.x == 0) (void)xb_add(&bar[XB_XCNT(b.x)], 1u);
    return b;
}
__device__ __forceinline__ void xcd_barrier_complete(unsigned* bar, unsigned x, unsigned& nloc, unsigned& nx) {
    const unsigned G = gridDim.x * gridDim.y * gridDim.z;
    unsigned sum, cnt, mine, sp = 0u;
    for (;;) {
        sum = 0u; cnt = 0u; mine = 0u;
#pragma unroll
        for (unsigned j = 0; j < 16; ++j) { const unsigned c = xb_ld(&bar[XB_XCNT(j)]); sum += c; cnt += (c > 0u) ? 1u : 0u; mine = (j == x) ? c : mine; }
        if (sum == G) break;
        __builtin_amdgcn_s_sleep(1);
        if ((++sp & 255u) == 0u) { if (xb_ld(&bar[XB_TMO])) break; if (sp > XB_SPIN_CAP) { atomicAdd(&bar[XB_TMO], 1u); break; } }
    }
    nloc = mine > 0u ? mine : 1u; nx = cnt > 0u ? cnt : 1u;
}
__device__ __forceinline__ void xcd_barrier(const XcdBarrier& b) {
    asm volatile("s_waitcnt vmcnt(0)" ::: "memory");
    __syncthreads();
    if (threadIdx.x == 0) {
        unsigned* bar = b.bar;
        __builtin_amdgcn_s_waitcnt(0);
        unsigned nloc = b.st[0], nx = b.st[1];
        if (nloc == 0u) { xcd_barrier_complete(bar, b.x, nloc, nx); b.st[0] = nloc; b.st[1] = nx; }
        const unsigned old = xb_add(&bar[XB_XSUB(b.x)], 1u);
        const unsigned gen = old / nloc;
        if (old + 1u == (gen + 1u) * nloc) {
            __builtin_amdgcn_fence(__ATOMIC_RELEASE, "agent");
            asm volatile("s_waitcnt vmcnt(0)" ::: "memory");
            const unsigned og = xb_add(&bar[XB_TOP], 1u);
            const unsigned tg = og / nx;
            if (og + 1u == (tg + 1u) * nx) xb_add(&bar[XB_TOPGEN], 1u);
            else XB_SPIN(xb_ld(&bar[XB_TOPGEN]) == tg, bar);
            __builtin_amdgcn_fence(__ATOMIC_ACQUIRE, "agent");
            xb_add(&bar[XB_XGEN(b.x)], 1u);
            asm volatile("s_waitcnt vmcnt(0)" ::: "memory");
        } else {
            XB_SPIN(xb_ld(&bar[XB_XGEN(b.x)]) == gen, bar);
            __builtin_amdgcn_fence(__ATOMIC_ACQUIRE, "agent");
            asm volatile("s_waitcnt vmcnt(0)" ::: "memory");
        }
    }
    __syncthreads();
}

typedef const GAS float* gcf; typedef const GAS int* gci;
struct Args {
    gcf x, c; gci pos;
    gcf ada_w, ada_b, norm_mix_g, w_in, q_norm_g, kv_norm_g, w_uq, w_ukv, w_sb_out, w_mla_out, w_dsa_out, w_out,
        norm_ffn_g, router_w, router_b, w_gu, b_gu, w_dn, b_dn, final_g;
    GAS float* out; GAS unsigned char* ws;
    int ph_lo, ph_hi;
};
typedef const __attribute__((address_space(4))) Args* ArgsP;
struct Frame {
    LAS unsigned char* lds;
    volatile LAS unsigned* MISC;
    gu32* ctl;
    int tid, lane, wave, G, gw, NGW, bx;
    unsigned char* ws;
};
__constant__ float INVF32[32] = {1.f, 0.749894261f, 0.562341332f, 0.421696514f, 0.316227764f, 0.237137377f, 0.177827939f, 0.133352131f, 0.100000001f, 0.0749894157f, 0.0562341325f, 0.0421696529f, 0.0316227749f, 0.0237137377f, 0.0177827943f, 0.0133352149f, 0.00999999978f, 0.00749894185f, 0.00562341325f, 0.00421696482f, 0.00316227763f, 0.00237137359f, 0.00177827943f, 0.00133352145f, 0.00100000005f, 0.000749894243f, 0.000562341302f, 0.000421696517f, 0.000316227757f, 0.00023713737f, 0.00017782794f, 0.00013335215f};
__constant__ float INVF16[16] = {1.f, 0.562341332f, 0.316227764f, 0.177827939f, 0.100000001f, 0.0562341325f, 0.0316227749f, 0.0177827943f, 0.00999999978f, 0.00562341325f, 0.00316227763f, 0.00177827943f, 0.00100000005f, 0.000562341302f, 0.000316227757f, 0.00017782794f};

DI void p0_mod(Frame& F, ArgsP a) {
    LAS float* sc = (LAS float*)(F.lds + RING_OFF);
    LAS float* part = sc + 2048;
    for (int i = F.tid; i < 2048; i += NTHR) { const float v = ((const float*)a->c)[i]; sc[i] = v * fast_sigmoid(v); }
    __syncthreads();
    float* MOD = (float*)(F.ws + opq(WS_MOD));
    for (int task = F.bx; task < DEPTH * 96; task += F.G) {
        const int l = task / 96, n = (task % 96) * 64 + F.lane;
        const float* W = ((const float*)a->ada_w) + (size_t)l * DM * 6 * DM + n;
        float a0 = 0.f, a1 = 0.f; const int kb = F.wave * 128;
#pragma unroll 8
        for (int k = 0; k < 128; ++k) { const float w = W[(size_t)(kb + k) * (6 * DM)]; a0 = __builtin_fmaf(sc[kb + k], w, a0); a1 = __builtin_fmaf(sc[1024 + kb + k], w, a1); }
        part[(F.wave * 2 + 0) * 64 + F.lane] = a0; part[(F.wave * 2 + 1) * 64 + F.lane] = a1;
        __syncthreads();
        if (F.wave < 2) { float s = ((const float*)a->ada_b)[l * 6 * DM + n];
#pragma unroll
            for (int w = 0; w < 8; ++w) s += part[(w * 2 + F.wave) * 64 + F.lane];
            MOD[(size_t)(l * 2 + F.wave) * 6 * DM + n] = s; }
        __syncthreads();
    }
}
DI void p0_rope(Frame& F, ArgsP a) {
    float* R32 = (float*)(F.ws + opq(WS_ROPE32)); float* R16 = (float*)(F.ws + opq(WS_ROPE16));
    const int gt = F.bx * NTHR + F.tid, NT = F.G * NTHR;
    for (int i = gt; i < T * 32; i += NT) { const int t = i >> 5, f = i & 31; const float ang = (float)((const int*)a->pos)[t] * INVF32[f]; R32[i] = cosf(ang); R32[T * 32 + i] = sinf(ang); }
    for (int i = gt; i < T * 16; i += NT) { const int t = i >> 4, f = i & 15; const float ang = (float)((const int*)a->pos)[t] * INVF16[f]; R16[i] = cosf(ang); R16[T * 16 + i] = sinf(ang); }
}
struct CvtItem { const float* W; bf16_t* WT; int ld, nvalid, K, Ndst, mode, item; };
constexpr int CV_IN = (NPROJ / 32) * 16, CV_UQ = 0, CV_UKV = 0, CV_SB = 32 * 6, CV_MLA = 32 * 6, CV_DSA = 32 * 4, CV_OUT = 32 * 16, CV_GU = 64 * 16, CV_DN = 32 * 16;
constexpr int CV_SMALL = CV_IN + CV_UQ + CV_UKV + CV_SB + CV_MLA + CV_DSA + CV_OUT, CV_EXP = NEXP * (CV_GU + CV_DN);
constexpr int CV_UNIT = 96, N_CVT = CV_EXP / CV_UNIT;
DI void cvt_decode_small(CvtItem& c, Frame& F, ArgsP a, int it) {
    const int l = it / CV_SMALL; int r = it % CV_SMALL;
    if (r < CV_IN)  { c = CvtItem{((const float*)a->w_in) + (size_t)l * DM * D_IN, (bf16_t*)(F.ws + opq(WS_WIN)) + (size_t)l * NPROJ * DM, D_IN, D_IN, DM, NPROJ, 0, r}; return; } r -= CV_IN;
    if (r < CV_UQ)  { c = CvtItem{((const float*)a->w_uq) + (size_t)l * 256 * 576, (bf16_t*)(F.ws + opq(WS_WUQ)) + (size_t)l * 768 * 256, 576, 576, 256, 768, 0, r}; return; } r -= CV_UQ;
    if (r < CV_UKV) { c = CvtItem{((const float*)a->w_ukv) + (size_t)l * 128 * 768, (bf16_t*)(F.ws + opq(WS_WUKV)) + (size_t)l * 768 * 128, 768, 768, 128, 768, 0, r}; return; } r -= CV_UKV;
    if (r < CV_SB)  { c = CvtItem{((const float*)a->w_sb_out) + (size_t)l * 384 * DM, (bf16_t*)(F.ws + opq(WS_WSB)) + (size_t)l * DM * 384, DM, DM, 384, DM, 0, r}; return; } r -= CV_SB;
    if (r < CV_MLA) { c = CvtItem{((const float*)a->w_mla_out) + (size_t)l * 384 * DM, (bf16_t*)(F.ws + opq(WS_WMLA)) + (size_t)l * DM * 384, DM, DM, 384, DM, 0, r}; return; } r -= CV_MLA;
    if (r < CV_DSA) { c = CvtItem{((const float*)a->w_dsa_out) + (size_t)l * 256 * DM, (bf16_t*)(F.ws + opq(WS_WDSA)) + (size_t)l * DM * 256, DM, DM, 256, DM, 0, r}; return; } r -= CV_DSA;
    c = CvtItem{((const float*)a->w_out) + (size_t)l * DM * DM, (bf16_t*)(F.ws + opq(WS_WOUT)) + (size_t)l * DM * DM, DM, DM, DM, DM, 0, r};
}
DI void cvt_decode_expert(CvtItem& c, Frame& F, ArgsP a, int l, int r) {
    if (r < NEXP * CV_GU) { const int e = r / CV_GU; c = CvtItem{((const float*)a->w_gu) + (size_t)(l * NEXP + e) * DM * 2048, (bf16_t*)(F.ws + opq(WS_WGU)) + (size_t)(l * NEXP + e) * 2048 * DM, 2048, 2048, DM, 2048, 1, r % CV_GU}; return; } r -= NEXP * CV_GU;
    { const int e = r / CV_DN; c = CvtItem{((const float*)a->w_dn) + (size_t)(l * NEXP + e) * DM * DM, (bf16_t*)(F.ws + opq(WS_WDN)) + (size_t)(l * NEXP + e) * DM * DM, DM, DM, DM, DM, 0, r % CV_DN}; }
}
DI void cvt_load(f32x4 (&v)[8], const CvtItem& c, int lane) {
    const int nblk = c.Ndst / 32, kb = c.item / nblk, nb = c.item % nblk, k0 = 64 * kb, n0 = 32 * nb, quad = lane & 7;
    int col; if (c.mode == 0) col = n0 + 4 * quad; else col = (quad < 4) ? (n0 / 2 + 4 * quad) : (1024 + n0 / 2 + 4 * (quad - 4));
    const bool ok = (c.mode != 0) || (col < c.nvalid);
#pragma unroll
    for (int i = 0; i < 8; ++i) { const int row = (lane >> 3) + 8 * i; const float z0 = zero_op(); v[i] = (f32x4){z0, z0, z0, z0}; if (ok) v[i] = *(const f32x4*)(c.W + (size_t)(k0 + row) * c.ld + col); }
}
DI void cvt_store(const f32x4 (&v)[8], const CvtItem& c, LAS float* scr, int lane) {
    const int nblk = c.Ndst / 32, kb = c.item / nblk, nb = c.item % nblk, k0 = 64 * kb, n0 = 32 * nb, quad = lane & 7;
#pragma unroll
    for (int i = 0; i < 8; ++i) { const int row = (lane >> 3) + 8 * i; LAS float* d = scr + row * 33 + 4 * quad; d[0] = v[i][0]; d[1] = v[i][1]; d[2] = v[i][2]; d[3] = v[i][3]; }
    asm volatile("s_waitcnt lgkmcnt(0)" ::: "memory");
    const int cc = lane & 7;
#pragma unroll
    for (int j = 0; j < 4; ++j) { const int nn = (lane >> 3) + 8 * j; const int slot = (c.mode == 0) ? nn : ((nn & 1) * 16 + (nn >> 1)); const LAS float* s = scr + (8 * cc) * 33 + slot;
        u32x4 o; o.x = pk2(s[0 * 33], s[1 * 33]); o.y = pk2(s[2 * 33], s[3 * 33]); o.z = pk2(s[4 * 33], s[5 * 33]); o.w = pk2(s[6 * 33], s[7 * 33]);
        *(u32x4*)(c.WT + (size_t)(n0 + nn) * c.K + k0 + 8 * cc) = o; }
    asm volatile("s_waitcnt lgkmcnt(0)" ::: "memory");
}
DI void p0_convert_up(Frame& F, ArgsP a) {
    const int gt = F.bx * NTHR + F.tid, NT_ = F.G * NTHR;
    bf16_t* WUQ = (bf16_t*)(F.ws + opq(WS_WUQ)); bf16_t* WUKV = (bf16_t*)(F.ws + opq(WS_WUKV));
    for (int i = gt; i < DEPTH * 256 * 768; i += NT_) { const int n = i % 768, k = (i / 768) % 256, l = i / (768 * 256);
        const float v = n < 576 ? ((const float*)a->w_uq)[((size_t)l * 256 + k) * 576 + n] * ((const float*)a->q_norm_g)[l * 256 + k] : 0.f;
        WUQ[((size_t)l * 768 + n) * 256 + k] = (bf16_t)f2bf(v); }
    for (int i = gt; i < DEPTH * 128 * 768; i += NT_) { const int n = i % 768, k = (i / 768) % 128, l = i / (768 * 128);
        const float v = ((const float*)a->w_ukv)[((size_t)l * 128 + k) * 768 + n] * ((const float*)a->kv_norm_g)[l * 128 + k];
        WUKV[((size_t)l * 768 + n) * 128 + k] = (bf16_t)f2bf(v); }
}
DI void p0_convert(Frame& F, ArgsP a) {
    LAS float* scr = (LAS float*)(F.lds + RING_OFF + 16384 + F.wave * 12288);
    constexpr int NIT = DEPTH * CV_SMALL;
    f32x4 va[8], vb[8]; CvtItem ca, cb;
    int it = F.gw;
    if (it < NIT) { cvt_decode_small(ca, F, a, it); cvt_load(va, ca, F.lane); }
    while (it < NIT) {
        const int it1 = it + F.NGW;
        if (it1 < NIT) { cvt_decode_small(cb, F, a, it1); cvt_load(vb, cb, F.lane); }
        cvt_store(va, ca, scr, F.lane);
        if (it1 >= NIT) break;
        const int it2 = it1 + F.NGW;
        if (it2 < NIT) { cvt_decode_small(ca, F, a, it2); cvt_load(va, ca, F.lane); }
        cvt_store(vb, cb, scr, F.lane);
        it = it2;
    }
}
DI void cvt_unit(Frame& F, ArgsP a, int l, int cu) {
    LAS float* scr = (LAS float*)(F.lds + RING_OFF + F.wave * 12288);
    const int base = cu * CV_UNIT + F.wave; constexpr int NK = CV_UNIT / NWAVES;
    f32x4 va[8], vb[8], vc[8], vd[8]; CvtItem ca, cb, cc, cd;
    cvt_decode_expert(ca, F, a, l, base); cvt_load(va, ca, F.lane);
    cvt_decode_expert(cb, F, a, l, base + 8); cvt_load(vb, cb, F.lane);
    cvt_decode_expert(cc, F, a, l, base + 16); cvt_load(vc, cc, F.lane);
#pragma unroll 1
    for (int k = 0; k < NK; k += 4) {
        cvt_decode_expert(cd, F, a, l, base + 8 * (k + 3)); cvt_load(vd, cd, F.lane);
        cvt_store(va, ca, scr, F.lane);
        if (k + 4 < NK) { cvt_decode_expert(ca, F, a, l, base + 8 * (k + 4)); cvt_load(va, ca, F.lane); }
        cvt_store(vb, cb, scr, F.lane);
        if (k + 4 < NK) { cvt_decode_expert(cb, F, a, l, base + 8 * (k + 5)); cvt_load(vb, cb, F.lane); }
        cvt_store(vc, cc, scr, F.lane);
        if (k + 4 < NK) { cvt_decode_expert(cc, F, a, l, base + 8 * (k + 6)); cvt_load(vc, cc, F.lane); }
        cvt_store(vd, cd, scr, F.lane);
    }
}

struct RowCoef { f32x4 a[4], b[4]; };
DI void load_coef(RowCoef& c, const float* g, const float* sh, const float* sc, int lane) {
    f32x4 gg[4], ss[4];
#pragma unroll
    for (int j = 0; j < 4; ++j) { const int o = 4 * lane + 256 * j; gg[j] = *(const f32x4*)(g + o); ss[j] = *(const f32x4*)(sc + o); c.b[j] = *(const f32x4*)(sh + o); }
    __builtin_amdgcn_sched_barrier(0);
#pragma unroll
    for (int j = 0; j < 4; ++j) c.a[j] = gg[j] * (ss[j] + 1.0f);
}
DI float row_rstd(const f32x4 (&v)[4], int lane) {
    float s = 0.f;
#pragma unroll
    for (int j = 0; j < 4; ++j) s += (v[j].x * v[j].x + v[j].y * v[j].y) + (v[j].z * v[j].z + v[j].w * v[j].w);
    return 1.0f / sqrtf(wave_sum(s, lane) * (1.0f / DM) + NORM_EPS);
}
DI void store_xn(bf16_t* xn_row, const f32x4 (&h)[4], int lane) {
#pragma unroll
    for (int j = 0; j < 4; ++j) { u32x2 w; w.x = pk2(h[j].x, h[j].y); w.y = pk2(h[j].z, h[j].w); *(u32x2*)(xn_row + 4 * lane + 256 * j) = w; }
}
DI void p_norm_first(Frame& F, ArgsP a) {
    const float* MOD = (const float*)(F.ws + opq(WS_MOD)); float* X = (float*)(F.ws + opq(WS_X)); bf16_t* XN = (bf16_t*)(F.ws + opq(WS_XN));
    constexpr int RPW = 8;
    for (int r0 = F.gw * RPW; r0 < T; r0 += F.NGW * RPW) {
        const int b = r0 / SEQ; const float* mod = MOD + (size_t)(0 * 2 + b) * 6 * DM;
        RowCoef c; load_coef(c, ((const float*)a->norm_mix_g), mod + 0 * DM, mod + 1 * DM, F.lane);
        for (int r = r0; r < r0 + RPW; ++r) {
            f32x4 v[4];
#pragma unroll
            for (int j = 0; j < 4; ++j) v[j] = *(const f32x4*)(((const float*)a->x) + (size_t)r * DM + 4 * F.lane + 256 * j);
            const float rstd = row_rstd(v, F.lane);
            f32x4 h[4];
#pragma unroll
            for (int j = 0; j < 4; ++j) { *(f32x4*)(X + (size_t)r * DM + 4 * F.lane + 256 * j) = v[j]; h[j] = v[j] * rstd * c.a[j] + c.b[j]; }
            store_xn(XN + (size_t)r * DM, h, F.lane);
        }
    }
}
template <int NC> DI void rs_table(Frame& F, const bf16_t* src, LAS float* tab) {
    constexpr int LPR = NC / 8, RPI = 64 / LPR, NI = 32 / RPI;
    const int lane = F.lane, sub = lane / LPR, cl = lane % LPR;
    u32x4 v[NI];
#pragma unroll
    for (int j = 0; j < NI; ++j) v[j] = *(const u32x4*)(src + (size_t)(32 * F.wave + RPI * j + sub) * NPROJ + 8 * cl);
#pragma unroll
    for (int j = 0; j < NI; ++j) { float s = 0.f;
#pragma unroll
        for (int p = 0; p < 4; ++p) { const float x0 = bflo(v[j][p]), x1 = bfhi(v[j][p]); s = __builtin_fmaf(x0, x0, s); s = __builtin_fmaf(x1, x1, s); }
#pragma unroll
        for (int o = 1; o < LPR; o <<= 1) s += shx(s, o, lane);
        if (cl == 0) tab[32 * F.wave + RPI * j + sub] = 1.0f / sqrtf(s * (1.0f / NC) + NORM_EPS); }
}
DI void p_post1(Frame& F, ArgsP a, int l) {
    const bf16_t* PROJ = (const bf16_t*)(F.ws + opq(WS_PROJ));
    bf16_t* KR = (bf16_t*)(F.ws + opq(WS_KR));
    bf16_t* DK = (bf16_t*)(F.ws + opq(WS_DK)); bf16_t* IK = (bf16_t*)(F.ws + opq(WS_IK)); float* IW = (float*)(F.ws + opq(WS_IW));
    const float* C32 = (const float*)(F.ws + opq(WS_ROPE32)); const float* S32 = C32 + (size_t)T * 32;
    const float* C16 = (const float*)(F.ws + opq(WS_ROPE16)); const float* S16 = C16 + (size_t)T * 16;
    const int lane = F.lane;
    float kmx0 = 0.f, kmx1 = 0.f;
    const int hd = lane >> 4, i2 = 2 * (lane & 15), i1 = lane & 15; const bool second = lane >= 16;
    constexpr int RB = 8;
    for (int r0 = F.gw; r0 < T; r0 += RB * F.NGW) {
        unsigned w1[RB], w2[RB]; f32x2 cs[RB], sn[RB]; float x1[RB], x2[RB], c16[RB], s16[RB], iw[RB];
#pragma unroll
        for (int j = 0; j < RB; ++j) { const int r = r0 + j * F.NGW; const float z0 = zero_op();
            w1[j] = 0u; w2[j] = 0u; cs[j] = (f32x2){z0, z0}; sn[j] = (f32x2){z0, z0}; x1[j] = z0; x2[j] = z0; c16[j] = z0; s16[j] = z0; iw[j] = z0;
            if (r < T) { const bf16_t* p = PROJ + (size_t)r * NPROJ;
                { const bf16_t* q = p + C_DK + hd * 64; w1[j] = *(const unsigned*)(q + i2); w2[j] = *(const unsigned*)(q + 32 + i2); }
                cs[j] = *(const f32x2*)(C32 + (size_t)r * 32 + i2); sn[j] = *(const f32x2*)(S32 + (size_t)r * 32 + i2);
                if (lane < 32) { const bf16_t* q = p + (second ? C_IK : C_KR); x1[j] = bf2f(q[i1]); x2[j] = bf2f(q[i1 + 16]); c16[j] = C16[(size_t)r * 16 + i1]; s16[j] = S16[(size_t)r * 16 + i1]; }
                if (lane < 8) iw[j] = bf2f(p[C_IW + lane]); } }
#pragma unroll
        for (int j = 0; j < RB; ++j) { const int r = r0 + j * F.NGW;
            if (r < T) {
            { const float a0 = bflo(w1[j]), a1 = bfhi(w1[j]), b0 = bflo(w2[j]), b1 = bfhi(w2[j]);
              bf16_t* o = DK + (size_t)r * 256 + hd * 64;
              *(unsigned*)(o + i2) = pk2(a0 * cs[j].x - b0 * sn[j].x, a1 * cs[j].y - b1 * sn[j].y); *(unsigned*)(o + 32 + i2) = pk2(b0 * cs[j].x + a0 * sn[j].x, b1 * cs[j].y + a1 * sn[j].y); }
            float kn2 = 0.f;
            if (lane < 32) { bf16_t* o = (second ? IK : KR) + (size_t)r * 32; o[i1] = (bf16_t)f2bf(x1[j] * c16[j] - x2[j] * s16[j]); o[i1 + 16] = (bf16_t)f2bf(x2[j] * c16[j] + x1[j] * s16[j]);
              kn2 = second ? (x1[j] * x1[j] + x2[j] * x2[j]) : 0.f; }
            kn2 = wave_sum(kn2, lane);
            if (r < SEQ) kmx0 = fmaxf(kmx0, kn2); else kmx1 = fmaxf(kmx1, kn2);
            if (lane < 8) IW[(size_t)r * 8 + lane] = iw[j] * 0.0625f;
            } }
    }
    if (lane == 0) { F.MISC[32 + F.wave] = __builtin_bit_cast(unsigned, kmx0); F.MISC[40 + F.wave] = __builtin_bit_cast(unsigned, kmx1); }
    __syncthreads();
    if (F.tid < 2) { unsigned m = 0u; for (int w = 0; w < NWAVES; ++w) { const unsigned v = F.MISC[32 + 8 * F.tid + w]; m = v > m ? v : m; }
        atomicMax((unsigned*)(F.ctl + CW_KMAX + 64 * (l * 2 + F.tid)), m); }
}
namespace pg8 {
struct EpiStore {
    static constexpr bool PERM = true;
    DI void prefetch(const Unit&, int) const {}
    bf16_t* O; int ld;
    DI void operator()(const f32x4 (&acc)[2][2][4][2], const Unit& u, int wr, int wc, int fr, int fq) const {
        const int row0 = u.pm * BM + wr * 64 + fr, col0 = u.pn * BM + wc * 32 + 8 * fq;
#pragma unroll
        for (int ai = 0; ai < 2; ++ai)
#pragma unroll
            for (int m = 0; m < 4; ++m) { bf16_t* rowp = O + (size_t)(row0 + ai * HALF + m * 16) * ld + col0;
#pragma unroll
                for (int bj = 0; bj < 2; ++bj) { const f32x4 v0 = acc[ai][bj][m][0], v1 = acc[ai][bj][m][1];
                    u32x4 w; w.x = cvt_pk_bf16(v0[0], v0[1]); w.y = cvt_pk_bf16(v0[2], v0[3]); w.z = cvt_pk_bf16(v1[0], v1[1]); w.w = cvt_pk_bf16(v1[2], v1[3]);
                    *(u32x4*)(rowp + bj * HALF) = w; } }
    }
};
struct EpiStoreRS {
    static constexpr bool PERM = true;
    DI void prefetch(const Unit&, int) const {}
    bf16_t* O; int ld; LAS const float* rs;
    DI void operator()(const f32x4 (&acc)[2][2][4][2], const Unit& u, int wr, int wc, int fr, int fq) const {
        const int row0 = u.pm * BM + wr * 64 + fr, col0 = u.pn * BM + wc * 32 + 8 * fq;
#pragma unroll
        for (int ai = 0; ai < 2; ++ai)
#pragma unroll
            for (int m = 0; m < 4; ++m) { bf16_t* rowp = O + (size_t)(row0 + ai * HALF + m * 16) * ld + col0; const float s = rs[wr * 64 + fr + ai * HALF + m * 16];
#pragma unroll
                for (int bj = 0; bj < 2; ++bj) { const f32x4 v0 = acc[ai][bj][m][0] * s, v1 = acc[ai][bj][m][1] * s;
                    u32x4 w; w.x = cvt_pk_bf16(v0[0], v0[1]); w.y = cvt_pk_bf16(v0[2], v0[3]); w.z = cvt_pk_bf16(v1[0], v1[1]); w.w = cvt_pk_bf16(v1[2], v1[3]);
                    *(u32x4*)(rowp + bj * HALF) = w; } }
    }
};
struct EpiBranch {
    static constexpr bool PERM = true;
    DI void prefetch(const Unit&, int) const {}
    bf16_t* MRG; const bf16_t* PROJ; int gate0; int first;
    DI void operator()(const f32x4 (&acc)[2][2][4][2], const Unit& u, int wr, int wc, int fr, int fq) const {
        const int row0 = u.pm * BM + wr * 64 + fr, col0 = u.pn * BM + wc * 32 + 8 * fq;
#pragma unroll
        for (int ai = 0; ai < 2; ++ai)
#pragma unroll
            for (int mp = 0; mp < 2; ++mp) {
                u32x4 gl[2][2], pv[2][2];
#pragma unroll
                for (int mm = 0; mm < 2; ++mm) { const size_t row = (size_t)(row0 + ai * HALF + (2 * mp + mm) * 16);
#pragma unroll
                    for (int bj = 0; bj < 2; ++bj) { gl[mm][bj] = *(const u32x4*)(PROJ + row * NPROJ + gate0 + col0 + bj * HALF);
                        if (!first) pv[mm][bj] = *(const u32x4*)(MRG + row * DM + col0 + bj * HALF); else pv[mm][bj] = (u32x4){0u, 0u, 0u, 0u}; } }
                __builtin_amdgcn_sched_barrier(0);
#pragma unroll
                for (int mm = 0; mm < 2; ++mm) { const int m = 2 * mp + mm; const size_t row = (size_t)(row0 + ai * HALF + m * 16);
#pragma unroll
                    for (int bj = 0; bj < 2; ++bj) { const f32x4 v0 = acc[ai][bj][m][0], v1 = acc[ai][bj][m][1]; const u32x4 g_ = gl[mm][bj], p_ = pv[mm][bj];
                        bf16_t* mp_ = MRG + row * DM + col0 + bj * HALF;
                        float o[8];
                        o[0] = fast_sigmoid(bflo(g_.x)) * v0[0]; o[1] = fast_sigmoid(bfhi(g_.x)) * v0[1]; o[2] = fast_sigmoid(bflo(g_.y)) * v0[2]; o[3] = fast_sigmoid(bfhi(g_.y)) * v0[3];
                        o[4] = fast_sigmoid(bflo(g_.z)) * v1[0]; o[5] = fast_sigmoid(bfhi(g_.z)) * v1[1]; o[6] = fast_sigmoid(bflo(g_.w)) * v1[2]; o[7] = fast_sigmoid(bfhi(g_.w)) * v1[3];
                        if (!first) { o[0] += bflo(p_.x); o[1] += bfhi(p_.x); o[2] += bflo(p_.y); o[3] += bfhi(p_.y); o[4] += bflo(p_.z); o[5] += bfhi(p_.z); o[6] += bflo(p_.w); o[7] += bfhi(p_.w); }
                        u32x4 w; w.x = cvt_pk_bf16(o[0], o[1]); w.y = cvt_pk_bf16(o[2], o[3]); w.z = cvt_pk_bf16(o[4], o[5]); w.w = cvt_pk_bf16(o[6], o[7]);
                        *(u32x4*)mp_ = w; } }
            }
    }
};
struct EpiResid {
    static constexpr bool PERM = false;
    DI void prefetch(const Unit&, int) const {}
    float* X; const float* gvec; size_t dofs;
    DI void operator()(const f32x4 (&acc)[2][2][4][2], const Unit& u, int wr, int wc, int fr, int fq) const {
        const int row0 = u.pm * BM + wr * 64 + fr, col0 = u.pn * BM + wc * 32 + 4 * fq; const float* g = gvec + (size_t)((u.pm * BM) / SEQ) * 6 * DM;
#pragma unroll
        for (int bj = 0; bj < 2; ++bj) { f32x4 gv[2];
#pragma unroll
            for (int n = 0; n < 2; ++n) gv[n] = *(const f32x4*)(g + col0 + bj * HALF + n * 16);
#pragma unroll
            for (int ai = 0; ai < 2; ++ai) { f32x4 xv[4][2];
#pragma unroll
                for (int m = 0; m < 4; ++m)
#pragma unroll
                    for (int n = 0; n < 2; ++n) xv[m][n] = *(const f32x4*)(X + (size_t)(row0 + ai * HALF + m * 16) * DM + col0 + bj * HALF + n * 16);
                __builtin_amdgcn_sched_barrier(0);
#pragma unroll
                for (int m = 0; m < 4; ++m)
#pragma unroll
                    for (int n = 0; n < 2; ++n) { float* xp = X + (size_t)(row0 + ai * HALF + m * 16) * DM + col0 + bj * HALF + n * 16;
                        *(f32x4*)((char*)xp + dofs) = xv[m][n] + gv[n] * acc[ai][bj][m][n]; } } }
    }
};
struct MoeTab { LAS const int* cnt; LAS const int* tpre; LAS const int* off; LAS const int* xe; LAS const int* xt; };
template <bool GATHER, int NCOLT> struct MoeSched {
    const bf16_t* A; const bf16_t* Bt; const int* list; MoeTab tb; int K, G, c; LAS unsigned* ltab;
    DI bool next(int i, Unit& u) const {
        const int GX = G >> 3, x = c & 7, j = c >> 3; if (j >= GX) return false;
        LAS const int* xt = tb.xt + x * 5;
        const int L = i * GX + j; if (L >= __builtin_amdgcn_readfirstlane(xt[4]) * NCOLT) return false;
        const int tile = L / NCOLT; u.pn = L % NCOLT; int k = 0; while (__builtin_amdgcn_readfirstlane(xt[k + 1]) <= tile) ++k;
        const int e = __builtin_amdgcn_readfirstlane(tb.xe[x * 4 + k]), tp = __builtin_amdgcn_readfirstlane(xt[k]);
        const int of = __builtin_amdgcn_readfirstlane(tb.off[e]), cn = __builtin_amdgcn_readfirstlane(tb.cnt[e]);
        u.e = e; u.pm = (tile - tp) * BM; u.row0 = of + u.pm; const int left = cn - u.pm; u.nrows = left < BM ? left : BM; return true;
    }
    DI const char* abase(const Unit& u) const { return GATHER ? (const char*)A : (const char*)A + (size_t)u.row0 * K * 2; }
    DI const char* bbase(const Unit& u) const { return (const char*)Bt + ((size_t)u.e * NCOLT * BM + (size_t)u.pn * BM) * K * 2; }
    DI void aoffs(const Unit& u, int R, int C, unsigned (&v)[4]) const {
#pragma unroll
        for (int m = 0; m < 4; ++m) { int rr = R + 64 * m;
            if (GATHER) { rr = rr < u.nrows ? rr : 0; rr = list[u.e * ECAP + u.pm + rr]; }
            v[m] = (unsigned)(rr * K + C) * 2u; }
    }
    DI void prefetch(const Unit& u, int tid, int par) const {
        if (GATHER) { if (tid < 256) { const int rr = tid < u.nrows ? tid : 0;
            __builtin_amdgcn_global_load_lds((const unsigned*)(list + u.e * ECAP + u.pm + rr), (LAS unsigned*)(ltab + par * 256 + (tid & ~63)), 4, 0, 0); } }
    }
    DI void aoffs_next(const Unit& u, int R, int C, unsigned (&v)[4], int par) const {
        if (GATHER) {
#pragma unroll
            for (int m = 0; m < 4; ++m) v[m] = (unsigned)((int)ltab[par * 256 + R + 64 * m] * K + C) * 2u;
        } else aoffs(u, R, C, v);
    }
};
struct EpiSwiglu {
    static constexpr bool PERM = true;
    bf16_t* ACT; const float* bgu; LAS float* etab;
    DI void prefetch(const Unit& u, int tid) const {
        if (tid < 64) { const float* bg = bgu + (size_t)u.e * 2048 + u.pn * 128 + (tid < 32 ? 4 * tid : 1024 + 4 * (tid - 32));
            __builtin_amdgcn_global_load_lds((const unsigned*)bg, (LAS unsigned*)(etab + u.par * 256), 16, 0, 0); }
    }
    DI void operator()(const f32x4 (&acc)[2][2][4][2], const Unit& u, int wr, int wc, int fr, int fq) const {
        const int r0 = wr * 64 + fr, c0 = u.pn * BM + wc * 32 + 8 * fq; LAS const float* tb_ = etab + u.par * 256;
        f32x4 bgate[2], bup[2];
#pragma unroll
        for (int bj = 0; bj < 2; ++bj) { const int jj = wc * 16 + 4 * fq + bj * 64; bgate[bj] = *(LAS const f32x4*)(tb_ + jj); bup[bj] = *(LAS const f32x4*)(tb_ + 128 + jj); }
#pragma unroll
        for (int bj = 0; bj < 2; ++bj) { const int j0 = (c0 + bj * HALF) >> 1;
#pragma unroll
            for (int ai = 0; ai < 2; ++ai)
#pragma unroll
                for (int m = 0; m < 4; ++m) { const int r = r0 + ai * HALF + m * 16; const f32x4 v0 = acc[ai][bj][m][0], v1 = acc[ai][bj][m][1];
                    float g[4] = {v0[0] + bgate[bj][0], v0[2] + bgate[bj][1], v1[0] + bgate[bj][2], v1[2] + bgate[bj][3]};
                    float p[4] = {v0[1] + bup[bj][0], v0[3] + bup[bj][1], v1[1] + bup[bj][2], v1[3] + bup[bj][3]};
                    float o[4];
#pragma unroll
                    for (int k = 0; k < 4; ++k) { const float gg = fminf(g[k], 7.0f), uu = fminf(fmaxf(p[k], -7.0f), 7.0f); o[k] = (uu + 1.0f) * (gg * fast_sigmoid(1.702f * gg)); }
                    if (r < u.nrows) { u32x2 w; w.x = cvt_pk_bf16(o[0], o[1]); w.y = cvt_pk_bf16(o[2], o[3]); *(u32x2*)(ACT + (size_t)(u.row0 + r) * DM + j0) = w; } } }
    }
};
struct EpiDown {
    static constexpr bool PERM = true;
    bf16_t* EOUT; const float* bdn; const float* listw; LAS float* etab;
    DI void prefetch(const Unit& u, int tid) const {
        if (tid < 128) { const float* src = tid < 64 ? bdn + (size_t)u.e * DM + u.pn * BM + 4 * tid : listw + (size_t)u.e * ECAP + u.pm + 4 * (tid - 64);
            __builtin_amdgcn_global_load_lds((const unsigned*)src, (LAS unsigned*)(etab + u.par * 512 + (tid & 64) * 4), 16, 0, 0); }
    }
    DI void operator()(const f32x4 (&acc)[2][2][4][2], const Unit& u, int wr, int wc, int fr, int fq) const {
        const int r0 = wr * 64 + fr, c0 = u.pn * BM + wc * 32 + 8 * fq; LAS const float* tb_ = etab + u.par * 512;
        f32x4 b0[2], b1[2]; float cw[2][4];
#pragma unroll
        for (int bj = 0; bj < 2; ++bj) { const int cc = wc * 32 + 8 * fq + bj * HALF; b0[bj] = *(LAS const f32x4*)(tb_ + cc); b1[bj] = *(LAS const f32x4*)(tb_ + cc + 4); }
#pragma unroll
        for (int ai = 0; ai < 2; ++ai)
#pragma unroll
            for (int m = 0; m < 4; ++m) cw[ai][m] = tb_[256 + r0 + ai * HALF + m * 16];
#pragma unroll
        for (int ai = 0; ai < 2; ++ai)
#pragma unroll
            for (int m = 0; m < 4; ++m) { const int r = r0 + ai * HALF + m * 16;
                if (r < u.nrows) {
#pragma unroll
                    for (int bj = 0; bj < 2; ++bj) {
                        const f32x4 v0 = (acc[ai][bj][m][0] + b0[bj]) * cw[ai][m], v1 = (acc[ai][bj][m][1] + b1[bj]) * cw[ai][m];
                        u32x4 w; w.x = cvt_pk_bf16(v0[0], v0[1]); w.y = cvt_pk_bf16(v0[2], v0[3]); w.z = cvt_pk_bf16(v1[0], v1[1]); w.w = cvt_pk_bf16(v1[2], v1[3]);
                        *(u32x4*)(EOUT + (size_t)(u.row0 + r) * DM + c0 + bj * HALF) = w; } } }
    }
};
}

DI pg8::MoeTab moe_tables_again(Frame& F) {
    pg8::MoeTab tb; tb.cnt = (LAS int*)(F.MISC + 64); tb.tpre = (LAS int*)(F.MISC + 100); tb.off = (LAS int*)(F.MISC + 140); tb.xe = (LAS int*)(F.MISC + 176); tb.xt = (LAS int*)(F.MISC + 208);
    __syncthreads();
    return tb;
}
DI pg8::MoeTab moe_tables(Frame& F, int l) {
    LAS int* cnt = (LAS int*)(F.MISC + 64); LAS int* tpre = (LAS int*)(F.MISC + 100); LAS int* off = (LAS int*)(F.MISC + 140);
    LAS int* xe = (LAS int*)(F.MISC + 176); LAS int* xt = (LAS int*)(F.MISC + 208);
    __syncthreads();
    if (F.tid < NEXP) cnt[F.tid] = (int)__hip_atomic_load(F.ctl + CW_CNT + l * NEXP + F.tid, RLX_AGENT);
    __syncthreads();
    if (F.tid == 0) { int tp = 0, so = 0; for (int e = 0; e < NEXP; ++e) { tpre[e] = tp; off[e] = so; tp += (cnt[e] + 255) >> 8; so += cnt[e]; } tpre[NEXP] = tp; off[NEXP] = so; }
    if (F.tid >= 64 && F.tid < 64 + NEXP) {
        const int e = F.tid - 64, tl = (cnt[e] + 255) >> 8; int r = 0;
        for (int o = 0; o < NEXP; ++o) { const int to = (cnt[o] + 255) >> 8; r += (to > tl || (to == tl && o < e)) ? 1 : 0; }
        const int grp = r >> 3, pos = r & 7, x = (grp & 1) ? 7 - pos : pos; xe[x * 4 + grp] = e; }
    __syncthreads();
    if (F.tid < 8) { int s = 0; for (int k = 0; k < 4; ++k) { xt[F.tid * 5 + k] = s; s += (cnt[xe[F.tid * 4 + k]] + 255) >> 8; } xt[F.tid * 5 + 4] = s; }
    __syncthreads();
    pg8::MoeTab tb; tb.cnt = cnt; tb.tpre = tpre; tb.off = off; tb.xe = xe; tb.xt = xt; return tb;
}
DI unsigned f_sortable(float f) { const unsigned b = __builtin_bit_cast(unsigned, f); return b ^ ((b >> 31) ? 0xFFFFFFFFu : 0x80000000u); }
DI void p_norm2_router(Frame& F, ArgsP a, int l, size_t dofs = 0, int cslot = -1) {
    if (cslot < 0) cslot = l;
    LAS float* WT = (LAS float*)(F.lds + RING_OFF);
    { const float* rw = ((const float*)a->router_w) + (size_t)l * DM * NEXP;
#pragma unroll
      for (int ch = 0; ch < 2; ++ch) { const int k = 128 * F.wave + 64 * ch + F.lane; f32x4 w[8];
#pragma unroll
          for (int e4 = 0; e4 < 8; ++e4) w[e4] = *(const f32x4*)(rw + (size_t)k * NEXP + 4 * e4);
#pragma unroll
          for (int e4 = 0; e4 < 8; ++e4) { WT[(4 * e4 + 0) * DM + k] = w[e4].x; WT[(4 * e4 + 1) * DM + k] = w[e4].y; WT[(4 * e4 + 2) * DM + k] = w[e4].z; WT[(4 * e4 + 3) * DM + k] = w[e4].w; } } }
    __syncthreads();
    const float* MOD = (const float*)(F.ws + opq(WS_MOD)); const float* X = (const float*)(F.ws + opq(WS_X)); bf16_t* XN = (bf16_t*)(F.ws + opq(WS_XN) + dofs);
    int* LIST = (int*)(F.ws + opq(WS_LIST) + dofs); float* LISTW = (float*)(F.ws + opq(WS_LISTW) + dofs); int* TOKE = (int*)(F.ws + opq(WS_TOKE) + dofs);
    volatile LAS unsigned* RENT = (volatile LAS unsigned*)(F.lds + MISC_OFF + 1024);
    if (F.tid < NEXP) F.MISC[64 + F.tid] = 0u;
    const int lane = F.lane; const int e_mine = lane >> 1;
    const float rb = ((const float*)a->router_b)[l * NEXP + e_mine];
    constexpr int RPW = 8;
    const int rstride = F.NGW * RPW, riters = (T + rstride - 1) / rstride;
    for (int rit = 0; rit < riters; ++rit) {
        const int r0 = F.gw * RPW + rit * rstride; const bool ract = r0 < T;
        if (ract) {
        const int b = r0 / SEQ; const float* mod = MOD + (size_t)(l * 2 + b) * 6 * DM;
        RowCoef c; load_coef(c, ((const float*)a->norm_ffn_g) + l * DM, mod + 3 * DM, mod + 4 * DM, lane);
        f32x4 nx[4];
#pragma unroll
        for (int j = 0; j < 4; ++j) nx[j] = *(const f32x4*)(X + (size_t)r0 * DM + 4 * lane + 256 * j);
        for (int r = r0; r < r0 + RPW; ++r) {
            f32x4 h[4];
#pragma unroll
            for (int j = 0; j < 4; ++j) h[j] = nx[j];
            if (r + 1 < r0 + RPW) {
#pragma unroll
                for (int j = 0; j < 4; ++j) nx[j] = *(const f32x4*)(X + (size_t)(r + 1) * DM + 4 * lane + 256 * j); }
            const float rstd = row_rstd(h, lane);
#pragma unroll
            for (int j = 0; j < 4; ++j) h[j] = h[j] * rstd * c.a[j] + c.b[j];
            store_xn(XN + (size_t)r * DM, h, lane);
            float v[32];
#pragma unroll
            for (int e = 0; e < 32; ++e) { float s = 0.f;
#pragma unroll
                for (int j = 0; j < 4; ++j) { const f32x4 w = *(const LAS f32x4*)(WT + e * DM + 4 * lane + 256 * j); s += (h[j].x * w.x + h[j].y * w.y) + (h[j].z * w.z + h[j].w * w.w); }
                v[e] = s; if ((e & 3) == 3) __builtin_amdgcn_sched_barrier(0); }
            float a16[16], a8[8], a4[4], a2[2], a1;
            { const bool up = lane & 32;
#pragma unroll
              for (int i = 0; i < 16; ++i) { const float keep = up ? v[16 + i] : v[i], send = up ? v[i] : v[16 + i]; a16[i] = keep + shx(send, 32, lane); } }
            { const bool up = lane & 16;
#pragma unroll
              for (int i = 0; i < 8; ++i) { const float keep = up ? a16[8 + i] : a16[i], send = up ? a16[i] : a16[8 + i]; a8[i] = keep + shx(send, 16, lane); } }
            { const bool up = lane & 8;
#pragma unroll
              for (int i = 0; i < 4; ++i) { const float keep = up ? a8[4 + i] : a8[i], send = up ? a8[i] : a8[4 + i]; a4[i] = keep + shx(send, 8, lane); } }
            { const bool up = lane & 4;
#pragma unroll
              for (int i = 0; i < 2; ++i) { const float keep = up ? a4[2 + i] : a4[i], send = up ? a4[i] : a4[2 + i]; a2[i] = keep + shx(send, 4, lane); } }
            { const bool up = lane & 2; const float keep = up ? a2[1] : a2[0], send = up ? a2[0] : a2[1]; a1 = keep + shx(send, 2, lane); }
            a1 += shx(a1, 1, lane);
            const float logit = a1 + rb;
            unsigned long long key = ((unsigned long long)f_sortable(logit) << 32) | (unsigned)(31 - e_mine);
            int te[4]; float tv[4];
#pragma unroll
            for (int k = 0; k < 4; ++k) {
                unsigned long long m = key;
#pragma unroll
                for (int o = 1; o < 64; o <<= 1) { const unsigned long long t = shx64(m, o, lane); m = t > m ? t : m; }
                te[k] = 31 - (int)(unsigned)(m & 0xFFFFFFFFull); tv[k] = shl(logit, 2 * te[k]);
                if (e_mine == te[k]) key = 0ull;
            }
            const float e1 = __expf(tv[1] - tv[0]), e2 = __expf(tv[2] - tv[0]), e3 = __expf(tv[3] - tv[0]); const float inv = 1.0f / (1.0f + e1 + e2 + e3);
            if (lane < 4) {
                const int ek = lane == 0 ? te[0] : lane == 1 ? te[1] : lane == 2 ? te[2] : te[3];
                const float wk = (lane == 0 ? 1.0f : lane == 1 ? e1 : lane == 2 ? e2 : e3) * inv;
                const unsigned lr = __hip_atomic_fetch_add((LAS unsigned*)(F.MISC + 64 + ek), 1u, __ATOMIC_RELAXED, __HIP_MEMORY_SCOPE_WORKGROUP);
                RENT[((F.wave * RPW + (r - r0)) * 4 + lane) * 2] = (unsigned)ek | (lr << 8); RENT[((F.wave * RPW + (r - r0)) * 4 + lane) * 2 + 1] = __builtin_bit_cast(unsigned, wk);
            }
        }
        }
        __syncthreads();
        if (F.tid < NEXP) { const unsigned c = F.MISC[64 + F.tid]; F.MISC[96 + F.tid] = c ? __hip_atomic_fetch_add(F.ctl + CW_CNT + cslot * NEXP + F.tid, c, RLX_AGENT) : 0u; F.MISC[64 + F.tid] = 0u; }
        __syncthreads();
        if (ract && lane < 4 * RPW) { const int ri = lane >> 2, k = lane & 3, r = r0 + ri;
            const unsigned en = RENT[((F.wave * RPW + ri) * 4 + k) * 2]; const int ek = en & 0xff; const int rank = (int)(F.MISC[96 + ek] + (en >> 8));
            LIST[ek * ECAP + rank] = r; LISTW[ek * ECAP + rank] = __builtin_bit_cast(float, RENT[((F.wave * RPW + ri) * 4 + k) * 2 + 1]); TOKE[r * 4 + k] = ek | (rank << 8); }
        __syncthreads();
    }
}
DI void p_combine(Frame& F, ArgsP a, int l, const pg8::MoeTab& tb, size_t dofs = 0) {
    const float* MOD = (const float*)(F.ws + opq(WS_MOD)); const float* X = (const float*)(F.ws + opq(WS_X)); float* XO = (float*)(F.ws + opq(WS_X) + dofs); bf16_t* XN = (bf16_t*)(F.ws + opq(WS_XN) + dofs);
    const bf16_t* EOUT = (const bf16_t*)(F.ws + opq(WS_EOUT)); const int* TOKE = (const int*)(F.ws + opq(WS_TOKE));
    const int lane = F.lane; const bool lastl = (l == DEPTH - 1);
    constexpr int RPW = 8;
    for (int r0 = F.gw * RPW; r0 < T; r0 += F.NGW * RPW) {
        const int b = r0 / SEQ; const float* mod = MOD + (size_t)(l * 2 + b) * 6 * DM;
        f32x4 gf[4];
#pragma unroll
        for (int j = 0; j < 4; ++j) gf[j] = *(const f32x4*)(mod + 5 * DM + 4 * lane + 256 * j);
        RowCoef c;
        if (!lastl) { const float* modn = MOD + (size_t)((l + 1) * 2 + b) * 6 * DM; load_coef(c, ((const float*)a->norm_mix_g) + (l + 1) * DM, modn + 0 * DM, modn + 1 * DM, lane); }
        else {
#pragma unroll
            for (int j = 0; j < 4; ++j) { c.a[j] = *(const f32x4*)(((const float*)a->final_g) + 4 * lane + 256 * j); const float z0 = zero_op(); c.b[j] = (f32x4){z0, z0, z0, z0}; } }
        int myslot = 0;
        if (lane < 4 * RPW) { const int te = TOKE[(size_t)r0 * 4 + lane]; myslot = tb.off[te & 0xff] + (te >> 8); }
        u32x2 ne[4][4]; f32x4 nx[4];
#define CB_LOAD(r_) do { _Pragma("unroll") for (int k = 0; k < 4; ++k) { const int slot = __builtin_amdgcn_readlane(myslot, 4 * ((r_) - r0) + k); const bf16_t* ep = EOUT + (size_t)slot * DM; \
            _Pragma("unroll") for (int j = 0; j < 4; ++j) ne[k][j] = *(const u32x2*)(ep + 4 * lane + 256 * j); } \
            _Pragma("unroll") for (int j = 0; j < 4; ++j) nx[j] = *(const f32x4*)(X + (size_t)(r_) * DM + 4 * lane + 256 * j); } while (0)
        f32x4 v[4]; u32x2 ce[4][4];
#pragma unroll 1
        for (int r = r0; r < r0 + RPW; ++r) {
            if (r == r0) {
#pragma unroll
                for (int ri = 0; ri < 1; ++ri) CB_LOAD(r0); }
#pragma unroll
            for (int k = 0; k < 4; ++k)
#pragma unroll
                for (int j = 0; j < 4; ++j) ce[k][j] = ne[k][j];
#pragma unroll
            for (int j = 0; j < 4; ++j) v[j] = nx[j];
            if (r + 1 < r0 + RPW) CB_LOAD(r + 1);
            f32x4 y[4];
#pragma unroll
            for (int j = 0; j < 4; ++j) { const float z0 = zero_op(); y[j] = (f32x4){z0, z0, z0, z0}; }
#ifndef DBG_SKIP_MOE
#pragma unroll
            for (int k = 0; k < 4; ++k)
#pragma unroll
                for (int j = 0; j < 4; ++j) { const u32x2 w = ce[k][j]; y[j].x += bflo(w.x); y[j].y += bfhi(w.x); y[j].z += bflo(w.y); y[j].w += bfhi(w.y); }
#endif
#pragma unroll
            for (int j = 0; j < 4; ++j) v[j] = v[j] + gf[j] * y[j];
            const float rstd = row_rstd(v, lane);
            f32x4 h[4];
#pragma unroll
            for (int j = 0; j < 4; ++j) h[j] = v[j] * rstd * c.a[j] + c.b[j];
            if (!lastl) {
#pragma unroll
                for (int j = 0; j < 4; ++j) *(f32x4*)(XO + (size_t)r * DM + 4 * lane + 256 * j) = v[j];
                store_xn(XN + (size_t)r * DM, h, lane);
            } else {
#pragma unroll
                for (int j = 0; j < 4; ++j) *(f32x4*)((dofs ? XO : (float*)a->out) + (size_t)r * DM + 4 * lane + 256 * j) = h[j];
            }
        }
    }
}
DI f32x16 mfma32(bf16x8 a, bf16x8 b, f32x16 c) { return __builtin_amdgcn_mfma_f32_32x32x16_bf16(a, b, c, 0, 0, 0); }
typedef short v4i16_t __attribute__((ext_vector_type(4)));
DI s16x4 tr_read(LAS const unsigned char* p) { return __builtin_bit_cast(s16x4, __builtin_amdgcn_ds_read_tr16_b64_v4i16((LAS v4i16_t*)p)); }
DI int crow(int reg, int h) { return (reg & 3) + 8 * (reg >> 2) + 4 * h; }
template <int S> DI bf16x8 pack8(const f32x16& x) {
    u32x4 p; p.x = cvt_pk_bf16(x[8 * S + 0], x[8 * S + 1]); p.y = cvt_pk_bf16(x[8 * S + 2], x[8 * S + 3]); p.z = cvt_pk_bf16(x[8 * S + 4], x[8 * S + 5]); p.w = cvt_pk_bf16(x[8 * S + 6], x[8 * S + 7]);
    return __builtin_bit_cast(bf16x8, p);
}
DI bf16x8 scale8(bf16x8 v, float s) {
    u32x4 w = __builtin_bit_cast(u32x4, v); u32x4 o;
    o.x = pk2(bflo(w.x) * s, bfhi(w.x) * s); o.y = pk2(bflo(w.y) * s, bfhi(w.y) * s); o.z = pk2(bflo(w.z) * s, bfhi(w.z) * s); o.w = pk2(bflo(w.w) * s, bfhi(w.w) * s);
    return __builtin_bit_cast(bf16x8, o);
}
struct Rope8 { float c[8], d[8]; };
DI void rope_load(Rope8& r, const float* cs, const float* sn) {
    const f32x4 c0 = *(const f32x4*)cs, c1 = *(const f32x4*)(cs + 4), s0 = *(const f32x4*)sn, s1 = *(const f32x4*)(sn + 4);
#pragma unroll
    for (int j = 0; j < 4; ++j) { r.c[j] = c0[j]; r.c[4 + j] = c1[j]; r.d[j] = s0[j]; r.d[4 + j] = s1[j]; }
}
DI void rope_apply(bf16x8& a, bf16x8& b, const Rope8& r, float s) {
    const u32x4 wa = __builtin_bit_cast(u32x4, a), wb = __builtin_bit_cast(u32x4, b); u32x4 oa, ob;
#pragma unroll
    for (int p = 0; p < 4; ++p) { const float a0 = bflo(wa[p]), a1 = bfhi(wa[p]), b0 = bflo(wb[p]), b1 = bfhi(wb[p]);
        oa[p] = pk2((a0 * r.c[2 * p] - b0 * r.d[2 * p]) * s, (a1 * r.c[2 * p + 1] - b1 * r.d[2 * p + 1]) * s);
        ob[p] = pk2((b0 * r.c[2 * p] + a0 * r.d[2 * p]) * s, (b1 * r.c[2 * p + 1] + a1 * r.d[2 * p + 1]) * s); }
    asm volatile("" : "+v"(oa), "+v"(ob));
    a = __builtin_bit_cast(bf16x8, oa); b = __builtin_bit_cast(bf16x8, ob);
}
DI void rope8(bf16x8& a, bf16x8& b, const float* cs, const float* sn, float s) { Rope8 r; rope_load(r, cs, sn); rope_apply(a, b, r, s); }
template <int KB2, int PST = 4096> DI void pv_block(f32x16 (&o)[2], const f32x16& p, LAS const unsigned char* vs, int lane) {
    const int hi = lane >> 5, i16 = lane & 15, q4 = i16 >> 2, p4 = i16 & 3, blk = (lane >> 4) & 1;
    const bf16x8 pb0 = pack8<0>(p), pb1 = pack8<1>(p);
    LAS const unsigned char* base = vs + (32 * KB2 + 4 * hi + q4) * 64 + (16 * blk + 4 * p4) * 2;
#pragma unroll
    for (int dh = 0; dh < 2; ++dh) {
        const s16x4 l0 = tr_read(base + dh * PST), h0 = tr_read(base + dh * PST + 8 * 64), l1 = tr_read(base + dh * PST + 16 * 64), h1 = tr_read(base + dh * PST + 24 * 64);
        const bf16x8 v0 = __builtin_shufflevector(l0, h0, 0, 1, 2, 3, 4, 5, 6, 7), v1 = __builtin_shufflevector(l1, h1, 0, 1, 2, 3, 4, 5, 6, 7);
        o[dh] = mfma32(v0, pb0, o[dh]); o[dh] = mfma32(v1, pb1, o[dh]);
    }
}
DI void store_ot(bf16_t* orow, const f32x16 (&o)[2], float sc, int hi) {
#pragma unroll
    for (int dh = 0; dh < 2; ++dh)
#pragma unroll
        for (int g = 0; g < 4; ++g) { u32x2 w; w.x = pk2(o[dh][4 * g] * sc, o[dh][4 * g + 1] * sc); w.y = pk2(o[dh][4 * g + 2] * sc, o[dh][4 * g + 3] * sc);
            *(u32x2*)(orow + 32 * dh + 8 * g + 4 * hi) = w; }
}
DI float max3f(float a, float b, float c) { float r; asm("v_max3_f32 %0, %1, %2, %3" : "=v"(r) : "v"(a), "v"(b), "v"(c)); return r; }
DI float rowmax32(const f32x16& A, const f32x16& B) {
    float m = max3f(A[0], B[0], A[1]), n = max3f(B[1], A[2], B[2]);
#pragma unroll
    for (int i = 3; i < 15; i += 2) { m = max3f(m, A[i], B[i]); n = max3f(n, A[i + 1], B[i + 1]); }
    return max3f(m, n, fmaxf(A[15], B[15]));
}
DI void raise_ref(f32x16& p0, f32x16& p1, f32x16 (&o)[2], f32x16& negm, float& m_ref, float& l_run, bool& init, float mx, int lane) {
    mx = fmaxf(mx, shx(mx, 32, lane)); const float dl = init ? fmaxf(mx, 0.f) : mx; init = true;
    m_ref += dl; const float alpha = __builtin_amdgcn_exp2f(-dl); l_run *= alpha;
#pragma unroll
    for (int i = 0; i < 16; ++i) { o[0][i] *= alpha; o[1][i] *= alpha; p0[i] -= dl; p1[i] -= dl; negm[i] = -m_ref; }
}
template <int BIT> DI float mask_bit(float e, unsigned word) {
    unsigned m; asm("v_bfe_i32 %0, %1, %2, 1" : "=v"(m) : "v"(word), "n"(BIT));
    return __builtin_bit_cast(float, __builtin_bit_cast(unsigned, e) & m);
}
constexpr int AT_KS = 13312, AT_K0 = 0, AT_V0 = 2 * AT_KS, AT_VS = 8192;

DI void mla_unit(Frame& F, int b, int h, int qb) {
    const bf16_t* QM = (const bf16_t*)(F.ws + opq(WS_QM)); const bf16_t* KVM = (const bf16_t*)(F.ws + opq(WS_KVM)); const bf16_t* KR = (const bf16_t*)(F.ws + opq(WS_KR)); bf16_t* OUT = (bf16_t*)(F.ws + opq(WS_OMLA));
    const float* C16 = (const float*)(F.ws + opq(WS_ROPE16)); const float* S16 = C16 + (size_t)T * 16;
    const int tid = F.tid, lane = F.lane, r32 = lane & 31, hi = lane >> 5, w = F.wave;
    const int qw = qb * 256 + 32 * w; const size_t row = (size_t)b * SEQ + qw + r32;
    constexpr float QS = 0.10206207261596577f * 1.4426950408889634f;
    bf16x8 qf[6];
    { const bf16_t* qp = QM + row * 768 + h * 96 + 8 * hi;
#pragma unroll
      for (int s = 0; s < 6; ++s) qf[s] = *(const bf16x8*)(qp + 16 * s);
#pragma unroll
      for (int s = 0; s < 4; ++s) qf[s] = scale8(qf[s], QS);
      rope8(qf[4], qf[5], C16 + row * 16 + 8 * hi, S16 + row * 16 + 8 * hi, QS); }
    const int NS = 2 * (qb + 1), cw = 4 * qb + (w >> 1);
    constexpr int MK = 4 * AT_KS;
    const int kr = tid >> 3, c8 = tid & 7, kr2 = (tid >> 2) & 63, c4 = tid & 3, rp = tid >> 8;
    const bf16_t* gk = KVM + ((size_t)b * SEQ + kr) * 768 + h * 128 + 8 * c8;
    const bf16_t* gr = KR + ((size_t)b * SEQ + rp * 64 + kr2) * 32 + 8 * c4;
    const int lk = kr * 208 + c8 * 16, lr = rp * AT_KS + kr2 * 208 + 128 + c4 * 16, lv = (c8 >> 2) * 4096 + kr * 64 + (c8 & 3) * 16;
    LAS unsigned char* L = F.lds + RING_OFF;
    u32x4 rkA, rvA, rkB, rvB, rr;
#define MLA_LOAD(s) do { const bf16_t* g_ = gk + (size_t)(s) * 128 * 768; rkA = *(const u32x4*)g_; rvA = *(const u32x4*)(g_ + 64); rkB = *(const u32x4*)(g_ + 64 * 768); rvB = *(const u32x4*)(g_ + 64 * 768 + 64); rr = *(const u32x4*)(gr + (size_t)(s) * 128 * 32); } while (0)
#define MLA_WRITE(bf) do { LAS unsigned char* k_ = L + (bf) * 2 * AT_KS; LAS unsigned char* v_ = L + MK + (bf) * 2 * AT_VS; *(LAS u32x4*)(k_ + lk) = rkA; *(LAS u32x4*)(v_ + lv) = rvA; *(LAS u32x4*)(k_ + AT_KS + lk) = rkB; *(LAS u32x4*)(v_ + AT_VS + lv) = rvB; *(LAS u32x4*)(k_ + lr) = rr; } while (0)
    MLA_LOAD(0); MLA_WRITE(0);
    __syncthreads();
    float m_ref = 0.f, l_run = 0.f; bool init = false; f32x16 o[2], negm; const float zz0 = zero_op();
#pragma unroll
    for (int i = 0; i < 16; ++i) { o[0][i] = zz0; o[1][i] = zz0; negm[i] = zz0; }
    for (int s = 0; s < NS; ++s) {
        const int bf = s & 1;
        if (s + 1 < NS) MLA_LOAD(s + 1);
#pragma unroll
        for (int u2 = 0; u2 < 2; ++u2) {
            if (2 * s + u2 <= cw) {
                f32x16 p0, p1;
                LAS const unsigned char* kb = L + (bf * 2 + u2) * AT_KS + r32 * 208 + hi * 16;
#pragma unroll
                for (int s6 = 0; s6 < 6; ++s6) { const bf16x8 a0 = *(LAS const bf16x8*)(kb + 32 * s6), a1 = *(LAS const bf16x8*)(kb + 32 * 208 + 32 * s6); p0 = mfma32(a0, qf[s6], s6 == 0 ? negm : p0); p1 = mfma32(a1, qf[s6], s6 == 0 ? negm : p1); }
                asm volatile("s_nop 15\n\ts_nop 7" : "+v"(p0), "+v"(p1));
                const float mx = rowmax32(p0, p1);
                if (!init || __any(mx > 8.0f)) raise_ref(p0, p1, o, negm, m_ref, l_run, init, mx, lane);
                float ls0 = 0.f, one = 1.0f; asm volatile("" : "+v"(one));
#pragma unroll
                for (int i = 0; i < 16; ++i) { p0[i] = __builtin_amdgcn_exp2f(p0[i]); p1[i] = __builtin_amdgcn_exp2f(p1[i]); ls0 = __builtin_fmaf(p0[i], one, ls0); ls0 = __builtin_fmaf(p1[i], one, ls0); }
                l_run += ls0;
                LAS const unsigned char* vs = L + MK + (bf * 2 + u2) * AT_VS;
                pv_block<0>(o, p0, vs, lane); pv_block<1>(o, p1, vs, lane);
            }
        }
        if (s + 1 < NS) MLA_WRITE(bf ^ 1);
        __syncthreads();
    }
#undef MLA_LOAD
#undef MLA_WRITE
    const float lt = l_run + shx(l_run, 32, lane);
#ifdef DBG_ZERO_MLA
    store_ot(OUT + row * 384 + h * 64, o, zz0, hi);
#else
    store_ot(OUT + row * 384 + h * 64, o, 1.0f / lt, hi);
#endif
}

DI void sb_unit(Frame& F, int b, int h, int qb) {
    const bf16_t* PROJ = (const bf16_t*)(F.ws + opq(WS_PROJ)); bf16_t* OUT = (bf16_t*)(F.ws + opq(WS_OSB));
    const int tid = F.tid, lane = F.lane, r32 = lane & 31, hi = lane >> 5, w = F.wave;
    const int qw = qb * 256 + 32 * w, qg = qw + r32; const size_t row = (size_t)b * SEQ + qg;
    bf16x8 qf[4];
    { const bf16_t* qp = PROJ + row * NPROJ + C_SBQ + h * 64 + 8 * hi;
#pragma unroll
      for (int s = 0; s < 4; ++s) qf[s] = *(const bf16x8*)(qp + 16 * s); }
    const int t_hi = 4 * qb + 3, cw = 4 * qb + (w >> 1);
    const int kr = tid >> 3, c8 = tid & 7;
    const bf16_t* gk = PROJ + ((size_t)b * SEQ + kr) * NPROJ + C_SBK + h * 64 + 8 * c8;
    const bf16_t* gv = PROJ + ((size_t)b * SEQ + kr) * NPROJ + C_SBV + h * 64 + 8 * c8;
    const int lk = kr * 144 + c8 * 16, lv = (c8 >> 2) * 4096 + kr * 64 + (c8 & 3) * 16;
    LAS unsigned char* L = F.lds + RING_OFF;
    volatile LAS unsigned* dflag = F.MISC + 16;
    u32x4 rk, rv;
#define SB_LOAD(t) do { rk = *(const u32x4*)(gk + (size_t)(t) * 64 * NPROJ); rv = *(const u32x4*)(gv + (size_t)(t) * 64 * NPROJ); } while (0)
#define SB_WRITE(bf) do { *(LAS u32x4*)(L + AT_K0 + (bf) * AT_KS + lk) = rk; *(LAS u32x4*)(L + AT_V0 + (bf) * AT_VS + lv) = rv; } while (0)
    SB_LOAD(t_hi); SB_WRITE(0);
    __syncthreads();
    float carry = 0.f; bool done = false; f32x16 o[2]; const float zz0 = zero_op();
#pragma unroll
    for (int i = 0; i < 16; ++i) { o[0][i] = zz0; o[1][i] = zz0; }
    int kt = t_hi;
    for (int it = 0;; ++it, --kt) {
        const int bf = it & 1;
        if (kt > 0) SB_LOAD(kt - 1);
        if (kt <= cw && !done) {
            f32x16 z[2];
#pragma unroll
            for (int i = 0; i < 16; ++i) { z[0][i] = zz0; z[1][i] = zz0; }
            LAS const unsigned char* kb = L + AT_K0 + bf * AT_KS + r32 * 144 + hi * 16;
#pragma unroll
            for (int s = 0; s < 4; ++s) { const bf16x8 a0 = *(LAS const bf16x8*)(kb + 32 * s), a1 = *(LAS const bf16x8*)(kb + 32 * 144 + 32 * s); z[0] = mfma32(a0, qf[s], z[0]); z[1] = mfma32(a1, qf[s], z[1]); }
            const int kbase = 64 * kt;
            float own[8];
#pragma unroll
            for (int kb2 = 0; kb2 < 2; ++kb2)
#pragma unroll
                for (int g = 0; g < 4; ++g) {
                    float lsv[4];
#pragma unroll
                    for (int j = 0; j < 4; ++j) { const int i = 4 * g + j; const float zz = z[kb2][i] * 0.125f; const int key = kbase + 32 * kb2 + crow(i, hi);
                        const float sp = fmaxf(zz, 0.f) + 0.6931471805599453f * __builtin_amdgcn_logf(1.0f + __builtin_amdgcn_exp2f(-1.4426950408889634f * fabsf(zz)));
                        const bool valid = key < qg; lsv[j] = valid ? -sp : 0.f; z[kb2][i] = valid ? (zz - sp) : -INFINITY; }
                    const float e2 = lsv[3], e1 = e2 + lsv[2], e0 = e1 + lsv[1];
                    z[kb2][4 * g + 2] += e2; z[kb2][4 * g + 1] += e1; z[kb2][4 * g + 0] += e0;
                    own[4 * kb2 + g] = e0 + lsv[0];
                }
            float par[8];
#pragma unroll
            for (int g = 0; g < 8; ++g) par[g] = shx(own[g], 32, lane);
            float so = 0.f, sp_ = 0.f;
#pragma unroll
            for (int g = 7; g >= 0; --g) {
                const float off = carry + so + (hi ? sp_ : sp_ + par[g]);
#pragma unroll
                for (int j = 0; j < 4; ++j) { const int kb2 = g >> 2, i = 4 * (g & 3) + j; z[kb2][i] = __builtin_amdgcn_exp2f(1.4426950408889634f * (z[kb2][i] + off)); }
                so += own[g]; sp_ += par[g];
            }
            carry += hi ? (sp_ + so) : (so + sp_);
            LAS const unsigned char* vs = L + AT_V0 + bf * AT_VS;
            pv_block<0>(o, z[0], vs, lane); pv_block<1>(o, z[1], vs, lane);
            done = __all(carry < -104.0f);
        }
        if (lane == 0) dflag[bf * 8 + w] = (done || kt == 0) ? 1u : 0u;
        if (kt > 0) SB_WRITE(bf ^ 1);
        __syncthreads();
        if (kt == 0) break;
        bool alld = true;
#pragma unroll
        for (int i = 0; i < 8; ++i) alld = alld && (dflag[bf * 8 + i] != 0u);
        if (alld) break;
    }
#undef SB_LOAD
#undef SB_WRITE
#ifdef DBG_ZERO_SB
    store_ot(OUT + row * 384 + h * 64, o, zz0, hi);
#else
    store_ot(OUT + row * 384 + h * 64, o, 1.0f, hi);
#endif
}
constexpr int DS_HIST = 0, DS_BITS = 65536, DS_VST = 98304, DS_NB = 512, DS_CAP = 256, DS_TOPK = 256;
constexpr int DM_ABOVE = 160, DM_CNT = 192;
constexpr int DL_INV = DS_VST, DL_OFF = DS_VST + 3 * 128, DL_BIN = DS_VST + 6 * 128;

DI int ds_bin(float s, float inv, float off) { const float t = __builtin_fmaf(s, inv, off); return (int)__builtin_amdgcn_fmed3f(t, 0.f, (float)(DS_NB - 1)); }

DI void ds_scores(float (&sc)[16], const bf16x8 k0, const bf16x8 k1, const bf16x8 (&qt)[2], const bf16x8 (&qi)[8][2], const float (&wh)[8], float zz0) {
    f32x16 z;
#pragma unroll
    for (int i = 0; i < 16; ++i) z[i] = zz0;
    f32x16 lin = mfma32(k0, qt[0], z); lin = mfma32(k1, qt[1], lin);
    f32x16 cur = mfma32(k0, qi[0][0], z); cur = mfma32(k1, qi[0][1], cur);
#pragma unroll
    for (int i = 0; i < 16; ++i) sc[i] = lin[i];
    __builtin_amdgcn_sched_barrier(0);
#pragma unroll
    for (int h = 0; h < 8; ++h) {
        f32x16 nxt = cur;
        if (h < 7) { nxt = mfma32(k0, qi[h + 1][0], z); nxt = mfma32(k1, qi[h + 1][1], nxt); }
#pragma unroll
        for (int i = 0; i < 16; ++i) sc[i] = __builtin_fmaf(wh[h], __builtin_fabsf(cur[i]), sc[i]);
        cur = nxt;
        __builtin_amdgcn_sched_barrier(0);
    }
    asm volatile("" : "+v"(sc[0]), "+v"(sc[1]), "+v"(sc[2]), "+v"(sc[3]), "+v"(sc[4]), "+v"(sc[5]), "+v"(sc[6]), "+v"(sc[7]));
    asm volatile("" : "+v"(sc[8]), "+v"(sc[9]), "+v"(sc[10]), "+v"(sc[11]), "+v"(sc[12]), "+v"(sc[13]), "+v"(sc[14]), "+v"(sc[15]));
}

DI void dsa_select_unit(Frame& F, int b, int qt_, int l) {
    const bf16_t* PROJ = (const bf16_t*)(F.ws + opq(WS_PROJ)); const bf16_t* IK = (const bf16_t*)(F.ws + opq(WS_IK));
    const float* IW = (const float*)(F.ws + opq(WS_IW));
    const float* C16 = (const float*)(F.ws + opq(WS_ROPE16)); const float* S16 = C16 + (size_t)T * 16;
    const int tid = F.tid, lane = F.lane, r32 = lane & 31, hi = lane >> 5, w = F.wave;
    const int q0 = qt_ * 32, chunk = q0 >> 6, NK = 64 * (chunk + 1), nblk = NK >> 5;
    const size_t row = (size_t)b * SEQ + q0 + r32, krow0 = (size_t)b * SEQ;
    LAS unsigned char* L = F.lds + RING_OFF;
    LAS unsigned* HIST = (LAS unsigned*)(L + DS_HIST); LAS unsigned* BITS = (LAS unsigned*)(L + DS_BITS);
    volatile LAS unsigned* M = F.MISC;
    const float zz0 = zero_op();
    { unsigned z0 = 0u; asm volatile("" : "+v"(z0));
      for (int i = tid; i < (DS_BITS + 32768) / 16; i += NTHR) *(LAS u32x4*)(L + i * 16) = (u32x4){z0, z0, z0, z0}; }
    if (NK <= DS_TOPK) {
        __syncthreads();
        for (int i = tid; i < nblk * 32; i += NTHR) BITS[i] = 0xFFFFFFFFu;
        __syncthreads();
    } else {
        bf16x8 qi[8][2], qt[2]; float wh[8];
        float B = 0.f;
        { const bf16_t* qp = PROJ + row * NPROJ + C_IQ + 8 * hi;
          Rope8 rp; rope_load(rp, C16 + row * 16 + 8 * hi, S16 + row * 16 + 8 * hi);
          const f32x4 w0 = *(const f32x4*)(IW + row * 8), w1 = *(const f32x4*)(IW + row * 8 + 4);
          wh[0] = 0.5f * w0[0]; wh[1] = 0.5f * w0[1]; wh[2] = 0.5f * w0[2]; wh[3] = 0.5f * w0[3]; wh[4] = 0.5f * w1[0]; wh[5] = 0.5f * w1[1]; wh[6] = 0.5f * w1[2]; wh[7] = 0.5f * w1[3];
          float ql[2][8];
#pragma unroll
          for (int s = 0; s < 2; ++s)
#pragma unroll
              for (int j = 0; j < 8; ++j) ql[s][j] = zz0;
#pragma unroll
          for (int h = 0; h < 8; ++h) { qi[h][0] = *(const bf16x8*)(qp + 32 * h); qi[h][1] = *(const bf16x8*)(qp + 32 * h + 16); }
          __builtin_amdgcn_sched_barrier(0);
#pragma unroll
          for (int h = 0; h < 8; ++h) {
              rope_apply(qi[h][0], qi[h][1], rp, 1.0f);
              float n2 = 0.f;
#pragma unroll
              for (int s = 0; s < 2; ++s)
#pragma unroll
                  for (int j = 0; j < 8; ++j) { const float v = bf2f((unsigned short)qi[h][s][j]); n2 = __builtin_fmaf(v, v, n2); ql[s][j] = __builtin_fmaf(wh[h], v, ql[s][j]); }
              n2 += shx(n2, 32, lane); B += 2.0f * fabsf(wh[h]) * sqrtf(n2);
              __builtin_amdgcn_sched_barrier(0); }
#pragma unroll
          for (int s = 0; s < 2; ++s) { u32x4 p; p.x = pk2(ql[s][0], ql[s][1]); p.y = pk2(ql[s][2], ql[s][3]); p.z = pk2(ql[s][4], ql[s][5]); p.w = pk2(ql[s][6], ql[s][7]); asm volatile("" : "+v"(p)); qt[s] = __builtin_bit_cast(bf16x8, p); } }
        { const float kmax = sqrtf(__builtin_bit_cast(float, __hip_atomic_load(F.ctl + CW_KMAX + 64 * (l * 2 + b), RLX_AGENT)));
          B = fmaxf(B * kmax * 1.03f, 1e-20f);
          if (w == 0 && hi == 0) { ((LAS float*)(L + DL_INV))[r32] = 1024.0f / B; ((LAS float*)(L + DL_OFF))[r32] = 256.0f; M[DM_ABOVE + r32] = 0u; } }
        __syncthreads();
        const bf16_t* kbase = IK + (krow0 + r32) * 32 + 8 * hi;
#define DS_LOADK(K0_, K1_, kb_) do { const bf16_t* kp_ = kbase + (size_t)(kb_) * 32 * 32; K0_ = *(const bf16x8*)kp_; K1_ = *(const bf16x8*)(kp_ + 16); } while (0)
        int lev = 0;
        for (;;) {
            float pinv[3], poff[3]; int pbin[3];
#pragma unroll
            for (int v = 0; v < 3; ++v) { pinv[v] = ((LAS float*)(L + DL_INV))[v * 32 + r32]; poff[v] = ((LAS float*)(L + DL_OFF))[v * 32 + r32]; pbin[v] = ((LAS int*)(L + DL_BIN))[v * 32 + r32]; }
#ifdef DBG_REP_S1
            for (int rep_ = 0; rep_ < 2; ++rep_)
#endif
            {
#ifdef DBG_REP_S1
                if (rep_) { __syncthreads(); unsigned z0 = 0u; asm volatile("" : "+v"(z0)); for (int i = tid; i < 65536 / 16; i += NTHR) *(LAS u32x4*)(L + DS_HIST + i * 16) = (u32x4){z0, z0, z0, z0}; __syncthreads(); }
#endif
                bf16x8 c0, c1, n0, n1; c0 = c1 = n0 = n1 = qt[0];
                if (w < nblk) DS_LOADK(c0, c1, w);
                if (lev == 0) {
                    const float inv0 = pinv[0], off0 = poff[0];
                    for (int kb = w; kb < nblk; kb += NWAVES) {
                        if (kb + NWAVES < nblk) DS_LOADK(n0, n1, kb + NWAVES);
                        float sc[16]; ds_scores(sc, c0, c1, qt, qi, wh, zz0);
#pragma unroll
                        for (int i = 0; i < 16; ++i) { const int bin = ds_bin(sc[i], inv0, off0);
                            __hip_atomic_fetch_add((LAS unsigned*)((LAS unsigned char*)HIST + (bin << 7) + (r32 << 2)), 1u, __ATOMIC_RELAXED, __HIP_MEMORY_SCOPE_WORKGROUP); }
                        c0 = n0; c1 = n1;
                    }
                } else {
                    for (int kb = w; kb < nblk; kb += NWAVES) {
                        if (kb + NWAVES < nblk) DS_LOADK(n0, n1, kb + NWAVES);
                        float sc[16]; ds_scores(sc, c0, c1, qt, qi, wh, zz0);
#pragma unroll
                        for (int i = 0; i < 16; ++i) { int bin = ds_bin(sc[i], pinv[0], poff[0]); bool in = (bin == pbin[0]); bin = ds_bin(sc[i], pinv[1], poff[1]);
                            if (lev >= 2) { in = in && (bin == pbin[1]); bin = ds_bin(sc[i], pinv[2], poff[2]); }
                            if (in) __hip_atomic_fetch_add(HIST + bin * 32 + r32, 1u, __ATOMIC_RELAXED, __HIP_MEMORY_SCOPE_WORKGROUP); }
                        c0 = n0; c1 = n1;
                    }
                }
            }
            __syncthreads();
#pragma unroll 1
            for (int sq = 0; sq < 4; ++sq) {
                int lane = F.lane; asm volatile("" : "+v"(lane));
                const int q = 4 * w + sq; unsigned hw[8]; unsigned mysum = 0;
#pragma unroll
                for (int i = 0; i < 8; ++i) { hw[i] = HIST[(8 * lane + i) * 32 + q]; mysum += hw[i]; }
                unsigned suf = mysum;
#pragma unroll
                for (int o = 1; o < 64; o <<= 1) { const unsigned t = (unsigned)__builtin_amdgcn_ds_bpermute(((lane + o) & 63) << 2, (int)suf); if (lane + o < 64) suf += t; }
                const unsigned above0 = M[DM_ABOVE + q]; const unsigned need = DS_TOPK - above0;
                const unsigned long long bal = __ballot(suf >= need);
                const int Ls = 63 - __builtin_clzll(bal | 1ull);
                const unsigned sufL = (unsigned)__builtin_amdgcn_ds_bpermute(Ls << 2, (int)suf), sumL = (unsigned)__builtin_amdgcn_ds_bpermute(Ls << 2, (int)mysum);
                unsigned acc = sufL - sumL; int bstar = 8 * Ls; unsigned cstar = 0;
#pragma unroll
                for (int i = 7; i >= 0; --i) { const unsigned c = (unsigned)__builtin_amdgcn_ds_bpermute(Ls << 2, (int)hw[i]);
                    if (cstar == 0u) { if (acc + c >= need) { bstar = 8 * Ls + i; cstar = c; } else acc += c; } }
                if (lane == 0) { ((LAS int*)(L + DL_BIN))[lev * 32 + q] = bstar; M[DM_ABOVE + q] = above0 + acc; M[DM_CNT + q] = cstar; }
            }
            __syncthreads();
            unsigned mxc = 0;
#pragma unroll 1
            for (int q = 0; q < 32; ++q) { const unsigned c = M[DM_CNT + q]; mxc = c > mxc ? c : mxc; }
            if (mxc <= (unsigned)DS_CAP || lev == 2) break;
            if (w == 0 && hi == 0) { const float pinv_ = ((LAS float*)(L + DL_INV))[lev * 32 + r32], poff_ = ((LAS float*)(L + DL_OFF))[lev * 32 + r32]; const int pb_ = ((LAS int*)(L + DL_BIN))[lev * 32 + r32];
                ((LAS float*)(L + DL_INV))[(lev + 1) * 32 + r32] = pinv_ * 511.5f; ((LAS float*)(L + DL_OFF))[(lev + 1) * 32 + r32] = (poff_ - (float)pb_) * 511.5f; }
            { unsigned z0 = 0u; asm volatile("" : "+v"(z0));
              for (int i = tid; i < 65536 / 16; i += NTHR) *(LAS u32x4*)(L + DS_HIST + i * 16) = (u32x4){z0, z0, z0, z0}; }
            ++lev;
            __syncthreads();
        }
        __syncthreads();
        if (tid < 32) M[DM_CNT + tid] = 0u;
        __syncthreads();
        {
            float pinv[3], poff[3]; int pbin[3];
#pragma unroll
            for (int v = 0; v < 3; ++v) { pinv[v] = ((LAS float*)(L + DL_INV))[v * 32 + r32]; poff[v] = ((LAS float*)(L + DL_OFF))[v * 32 + r32]; pbin[v] = ((LAS int*)(L + DL_BIN))[v * 32 + r32]; }
            LAS unsigned long long* CAND = (LAS unsigned long long*)(L + DS_HIST);
#define DS_SELBLK(K0_, K1_, kb_) do { float sc[16]; ds_scores(sc, K0_, K1_, qt, qi, wh, zz0); \
            unsigned word = 0u; const unsigned kinv = 0xFFFFu - (unsigned)((kb_) * 32 + 4 * hi); \
            _Pragma("unroll") for (int i = 0; i < 16; ++i) { \
                int bin = ds_bin(sc[i], pinv[0], poff[0]); bool sel = bin > pbin[0], eq = bin == pbin[0]; \
                if (lev >= 1) { bin = ds_bin(sc[i], pinv[1], poff[1]); sel = sel || (eq && bin > pbin[1]); eq = eq && bin == pbin[1]; } \
                if (lev >= 2) { bin = ds_bin(sc[i], pinv[2], poff[2]); sel = sel || (eq && bin > pbin[2]); eq = eq && bin == pbin[2]; } \
                if (sel) word |= 1u << crow(i, 0); \
                if (eq) { const unsigned slot = __hip_atomic_fetch_add((LAS unsigned*)(M + DM_CNT + r32), 1u, __ATOMIC_RELAXED, __HIP_MEMORY_SCOPE_WORKGROUP); \
                    if (slot < (unsigned)DS_CAP) CAND[r32 * DS_CAP + slot] = ((unsigned long long)f_sortable(sc[i]) << 32) | (unsigned)(kinv - (unsigned)crow(i, 0)); } } \
            word <<= 4 * hi; \
            if (word) __hip_atomic_fetch_or(BITS + (kb_) * 32 + r32, word, __ATOMIC_RELAXED, __HIP_MEMORY_SCOPE_WORKGROUP); } while (0)
#ifdef DBG_REP_S2
            for (int rep_ = 0; rep_ < 2; ++rep_)
#endif
            {
#ifdef DBG_REP_S2
                if (rep_) { __syncthreads(); if (tid < 32) M[DM_CNT + tid] = 0u; __syncthreads(); }
#endif
                bf16x8 c0, c1, n0, n1; c0 = c1 = n0 = n1 = qt[0];
                if (w < nblk) DS_LOADK(c0, c1, w);
                if (lev == 0) {
                    const float inv0 = pinv[0], off0 = poff[0];
                    const float T1 = pbin[0] >= DS_NB - 1 ? INFINITY : (float)(pbin[0] + 1), T0 = pbin[0] <= 0 ? -INFINITY : (float)pbin[0];
                    for (int kb = w; kb < nblk; kb += NWAVES) {
                        if (kb + NWAVES < nblk) DS_LOADK(n0, n1, kb + NWAVES);
                        float sc[16]; ds_scores(sc, c0, c1, qt, qi, wh, zz0);
                        unsigned cb = 0u; const unsigned kinv = 0xFFFFu - (unsigned)(kb * 32 + 4 * hi);
#pragma unroll
                        for (int i = 15; i >= 0; --i) { const float t = __builtin_fmaf(sc[i], inv0, off0); const bool sel = t >= T1, eq = (t >= T0) && !sel;
                            cb = cb * 2u + (sel ? 1u : 0u);
                            if (eq) { const unsigned slot = __hip_atomic_fetch_add((LAS unsigned*)(M + DM_CNT + r32), 1u, __ATOMIC_RELAXED, __HIP_MEMORY_SCOPE_WORKGROUP);
                                if (slot < (unsigned)DS_CAP) CAND[r32 * DS_CAP + slot] = ((unsigned long long)f_sortable(sc[i]) << 32) | (unsigned)(kinv - (unsigned)crow(i, 0)); } }
                        unsigned word = (cb & 0xFu) | ((cb & 0xF0u) << 4) | ((cb & 0xF00u) << 8) | ((cb & 0xF000u) << 12);
                        word <<= 4 * hi;
                        if (word) __hip_atomic_fetch_or(BITS + kb * 32 + r32, word, __ATOMIC_RELAXED, __HIP_MEMORY_SCOPE_WORKGROUP);
                        c0 = n0; c1 = n1;
                    }
                } else
                for (int kb = w; kb < nblk; kb += NWAVES) {
                    if (kb + NWAVES < nblk) DS_LOADK(n0, n1, kb + NWAVES);
                    DS_SELBLK(c0, c1, kb);
                    c0 = n0; c1 = n1;
                }
            }
#undef DS_SELBLK
            __syncthreads();
#ifdef DBG_REP_RES
            for (int rep_ = 0; rep_ < 2; ++rep_)
#endif
#pragma unroll 1
            for (int sq = 0; sq < 4; ++sq) {
                int lane = F.lane; asm volatile("" : "+v"(lane));
                const int q = 4 * w + sq; unsigned cnt = M[DM_CNT + q]; cnt = cnt < (unsigned)DS_CAP ? cnt : (unsigned)DS_CAP;
                const unsigned need = DS_TOPK - M[DM_ABOVE + q];
                const unsigned cnt4 = cnt & ~3u;
                for (unsigned i = lane; i < cnt; i += 64) { const unsigned long long ki = CAND[q * DS_CAP + i]; unsigned rank = 0; unsigned j = 0;
                    for (; j < cnt4; j += 4) { const unsigned long long x0 = CAND[q * DS_CAP + j], x1 = CAND[q * DS_CAP + j + 1], x2 = CAND[q * DS_CAP + j + 2], x3 = CAND[q * DS_CAP + j + 3];
                        rank += (x0 > ki ? 1u : 0u) + (x1 > ki ? 1u : 0u) + (x2 > ki ? 1u : 0u) + (x3 > ki ? 1u : 0u); }
                    for (; j < cnt; ++j) rank += (CAND[q * DS_CAP + j] > ki) ? 1u : 0u;
                    if (rank < need) { const unsigned key = 0xFFFFu - (unsigned)(ki & 0xFFFFull); __hip_atomic_fetch_or(BITS + (key >> 5) * 32 + q, 1u << (key & 31), __ATOMIC_RELAXED, __HIP_MEMORY_SCOPE_WORKGROUP); } }
            }
            __syncthreads();
        }
#undef DS_LOADK
    }
    {
        unsigned* BM = (unsigned*)(F.ws + opq(WS_BM)) + (size_t)b * 256 * SEQ + q0;
        for (int i = tid; i < nblk * 32; i += NTHR) __hip_atomic_store(BM + (size_t)(i >> 5) * SEQ + (i & 31), BITS[i], RLX_AGENT);
        asm volatile("s_waitcnt vmcnt(0)" ::: "memory");
        __syncthreads();
        if (tid == 0) __hip_atomic_store(F.ctl + CW_SELF + b * 256 + qt_, (unsigned)(l + 1), RLX_AGENT);
    }
}

DI void dsa_attn_unit(Frame& F, int b, int hd, int qb, int l) {
    const bf16_t* PROJ = (const bf16_t*)(F.ws + opq(WS_PROJ)); const bf16_t* DK = (const bf16_t*)(F.ws + opq(WS_DK)); bf16_t* OUT = (bf16_t*)(F.ws + opq(WS_ODSA));
    const float* C32 = (const float*)(F.ws + opq(WS_ROPE32)); const float* S32 = C32 + (size_t)T * 32;
    const int tid = F.tid, lane = F.lane, r32 = lane & 31, hi = lane >> 5, w = F.wave;
    const int qw = qb * 256 + 32 * w; const size_t row = (size_t)b * SEQ + qw + r32;
    if (w == 0) { unsigned sp = 0;
        for (;;) { const unsigned fv = lane < 8 ? __hip_atomic_load(F.ctl + CW_SELF + b * 256 + 8 * qb + lane, RLX_AGENT) : (unsigned)(l + 1);
            if (__all(fv == (unsigned)(l + 1)) || ++sp > (1u << 22)) break; __builtin_amdgcn_s_sleep(2); }
        __builtin_amdgcn_fence(__ATOMIC_ACQUIRE, "agent"); }
    asm volatile("s_waitcnt vmcnt(0)" ::: "memory");
    __syncthreads();
    constexpr float QS = 0.125f * 1.4426950408889634f;
    bf16x8 qf[4];
    { const bf16_t* qp = PROJ + row * NPROJ + C_DQ + hd * 64 + 8 * hi;
#pragma unroll
      for (int s = 0; s < 4; ++s) qf[s] = *(const bf16x8*)(qp + 16 * s);
      rope8(qf[0], qf[2], C32 + row * 32 + 8 * hi, S32 + row * 32 + 8 * hi, QS); rope8(qf[1], qf[3], C32 + row * 32 + 16 + 8 * hi, S32 + row * 32 + 16 + 8 * hi, QS); }
    const int NT = 4 * (qb + 1), cw = 4 * qb + (w >> 1);
    const int kr = tid >> 3, c8 = tid & 7;
    const bf16_t* gk = DK + ((size_t)b * SEQ + kr) * 256 + hd * 64 + 8 * c8;
    const bf16_t* gv = PROJ + ((size_t)b * SEQ + kr) * NPROJ + C_DV + hd * 64 + 8 * c8;
    const unsigned* bm = (const unsigned*)(F.ws + opq(WS_BM)) + (size_t)b * 256 * SEQ + qw + r32;
    const int lk = kr * 144 + c8 * 16, lv = (c8 >> 2) * 4096 + kr * 64 + (c8 & 3) * 16;
    LAS unsigned char* L = F.lds + RING_OFF;
    constexpr int MK = 4 * AT_KS;
    u32x4 rkA, rvA, rkB, rvB; unsigned nA0, nA1, nB0, nB1;
#define DA_LOAD(t) do { rkA = *(const u32x4*)(gk + (size_t)(t) * 64 * 256); rvA = *(const u32x4*)(gv + (size_t)(t) * 64 * NPROJ); \
        rkB = *(const u32x4*)(gk + (size_t)((t) + 1) * 64 * 256); rvB = *(const u32x4*)(gv + (size_t)((t) + 1) * 64 * NPROJ); \
        nA0 = __hip_atomic_load(bm + (size_t)(2 * (t)) * SEQ, RLX_AGENT); nA1 = __hip_atomic_load(bm + (size_t)(2 * (t) + 1) * SEQ, RLX_AGENT); \
        nB0 = __hip_atomic_load(bm + (size_t)(2 * (t) + 2) * SEQ, RLX_AGENT); nB1 = __hip_atomic_load(bm + (size_t)(2 * (t) + 3) * SEQ, RLX_AGENT); } while (0)
#define DA_WRITE(bf) do { LAS unsigned char* k_ = L + (bf) * 2 * AT_KS; LAS unsigned char* v_ = L + MK + (bf) * 2 * AT_VS; \
        *(LAS u32x4*)(k_ + lk) = rkA; *(LAS u32x4*)(v_ + lv) = rvA; *(LAS u32x4*)(k_ + AT_KS + lk) = rkB; *(LAS u32x4*)(v_ + AT_VS + lv) = rvB; } while (0)
    DA_LOAD(0); DA_WRITE(0);
    unsigned cA0 = nA0, cA1 = nA1, cB0 = nB0, cB1 = nB1;
    __syncthreads();
    float m_ref = 0.f, l_run = 0.f; bool init = false; f32x16 o[2], negm; const float zz0 = zero_op();
#pragma unroll
    for (int i = 0; i < 16; ++i) { o[0][i] = zz0; o[1][i] = zz0; negm[i] = zz0; }
    for (int t = 0; t < NT; t += 2) {
        const int bf = (t >> 1) & 1;
        if (t + 2 < NT) DA_LOAD(t + 2);
#pragma unroll
        for (int u2 = 0; u2 < 2; ++u2) {
        if (t + u2 <= cw) {
            const unsigned wd0 = (u2 ? cB0 : cA0) >> (4 * hi), wd1 = (u2 ? cB1 : cA1) >> (4 * hi);
            f32x16 p0, p1;
            LAS const unsigned char* kb = L + (bf * 2 + u2) * AT_KS + r32 * 144 + hi * 16;
#pragma unroll
            for (int s = 0; s < 4; ++s) { const bf16x8 a0 = *(LAS const bf16x8*)(kb + 32 * s), a1 = *(LAS const bf16x8*)(kb + 32 * 144 + 32 * s); p0 = mfma32(a0, qf[s], s == 0 ? negm : p0); p1 = mfma32(a1, qf[s], s == 0 ? negm : p1); }
            asm volatile("s_nop 15\n\ts_nop 7" : "+v"(p0), "+v"(p1));
            const float mx = rowmax32(p0, p1);
            if (!init || __any(mx > 8.0f)) raise_ref(p0, p1, o, negm, m_ref, l_run, init, mx, lane);
            float ls0 = 0.f, one = 1.0f; asm volatile("" : "+v"(one));
#define DA_E(i) do { p0[i] = mask_bit<((i) & 3) + 8 * ((i) >> 2)>(__builtin_amdgcn_exp2f(p0[i]), wd0); p1[i] = mask_bit<((i) & 3) + 8 * ((i) >> 2)>(__builtin_amdgcn_exp2f(p1[i]), wd1); ls0 = __builtin_fmaf(p0[i], one, ls0); ls0 = __builtin_fmaf(p1[i], one, ls0); } while (0)
            DA_E(0); DA_E(1); DA_E(2); DA_E(3); DA_E(4); DA_E(5); DA_E(6); DA_E(7); DA_E(8); DA_E(9); DA_E(10); DA_E(11); DA_E(12); DA_E(13); DA_E(14); DA_E(15);
#undef DA_E
            l_run += ls0;
            LAS const unsigned char* vs = L + MK + (bf * 2 + u2) * AT_VS;
            pv_block<0>(o, p0, vs, lane); pv_block<1>(o, p1, vs, lane);
        }
        }
        if (t + 2 < NT) { DA_WRITE(bf ^ 1); cA0 = nA0; cA1 = nA1; cB0 = nB0; cB1 = nB1; }
        __syncthreads();
    }
#undef DA_LOAD
#undef DA_WRITE
    const float lt = l_run + shx(l_run, 32, lane);
    store_ot(OUT + row * 256 + hd * 64, o, 1.0f / lt, hi);
}
constexpr int N_SEL = T / 32, N_MLA = BATCH * 6 * 32, N_DSAA = BATCH * 4 * 32, N_SB = BATCH * 6 * 32, N_ATT = N_SEL + N_MLA + N_DSAA + N_SB;
DI void p_attention(Frame& F, ArgsP a, int l, int qslot) {
    for (;;) {
        __syncthreads();
        if (F.tid == 0) F.MISC[12] = __hip_atomic_fetch_add(F.ctl + CW_QATT + 64 * qslot, 1u, RLX_AGENT);
        __syncthreads();
        int u = (int)F.MISC[12];
        if (u >= N_ATT + N_CVT) break;
        { int t_ = threadIdx.x; asm volatile("" : "+v"(t_)); F.tid = t_; F.lane = t_ & 63; }
        if (u < 3 * N_CVT) { const int q3 = u / 3; if (u - 3 * q3 == 2) { cvt_unit(F, a, l, q3); continue; } u -= q3; } else u -= N_CVT;
        if (u < N_SEL) { const int qt = 255 - u / 2, b = u & 1; dsa_select_unit(F, b, qt, l); }
        else if (u < N_SEL + N_MLA + N_DSAA) {
            const int v = u - N_SEL, qb = 31 - v / 20, r = v % 20;
            if (r < 8) dsa_attn_unit(F, r / 4, r % 4, qb, l); else mla_unit(F, (r - 8) / 6, (r - 8) % 6, qb);
        }
        else { const int v = u - N_SEL - N_MLA - N_DSAA; const int qb = 31 - v / 12, bh = v % 12; sb_unit(F, bh / 6, bh % 6, qb); }
    }
}

constexpr int PH_PER_LAYER = 10, N_PHASES = 2 + DEPTH * PH_PER_LAYER;
__global__ void __launch_bounds__(NTHR, 2) mk_fwd(Args a_unused) {
    ArgsP a = (ArgsP)__builtin_amdgcn_kernarg_segment_ptr();
    extern __shared__ __attribute__((aligned(16))) unsigned char lds_raw[];
    Frame F;
    F.lds = (LAS unsigned char*)lds_raw; F.MISC = (volatile LAS unsigned*)(F.lds + MISC_OFF);
    F.tid = threadIdx.x; F.lane = F.tid & 63; F.wave = __builtin_amdgcn_readfirstlane(F.tid >> 6);
    F.G = gridDim.x; F.bx = blockIdx.x; F.gw = blockIdx.x * NWAVES + F.wave; F.NGW = F.G * NWAVES; F.ws = (unsigned char*)a->ws; F.ctl = (gu32*)((unsigned char*)a->ws + WS_CTL);
    for (int u = F.tid; u < 256; u += NTHR) F.MISC[u] = 0u;
    __syncthreads();
    const int lo = a->ph_lo, hi = a->ph_hi;
    const bool one = (hi - lo) > 1;
    XcdBarrier bar; bar.bar = (unsigned*)(F.ctl + CW_BAR); bar.x = 0; bar.st = nullptr;
    if (one) bar = xcd_barrier_post((unsigned*)(F.ctl + CW_BAR), F.MISC + 8);
#define IN(k) (lo <= (k) && (k) < hi)
#define XN ((bf16_t*)(F.ws + opq(WS_XN)))
#define PROJ ((bf16_t*)(F.ws + opq(WS_PROJ)))
#define REFRESH() do { int t_ = threadIdx.x; asm volatile("" : "+v"(t_)); F.tid = t_; F.lane = t_ & 63; size_t z_ = 0; asm volatile("" : "+s"(z_)); a = (ArgsP)__builtin_amdgcn_kernarg_segment_ptr(); asm volatile("" : "+s"(a)); F.ws = (unsigned char*)a->ws + z_; F.ctl = (gu32*)(F.ws + opq(WS_CTL)); { LAS unsigned char* l_ = (LAS unsigned char*)lds_raw; asm volatile("" : "+s"(l_)); F.lds = l_; F.MISC = (volatile LAS unsigned*)(l_ + MISC_OFF); } \
    int b_ = blockIdx.x; asm volatile("" : "+s"(b_)); F.bx = b_; F.gw = b_ * NWAVES + F.wave; } while (0)
#ifdef DBG_DOUBLE_BAR
#define SEAM(k) do { if (IN(k) && IN((k) + 1)) { XcdBarrier b2_ = bar; size_t z_ = 0; asm volatile("" : "+s"(z_)); b2_.bar = (unsigned*)((unsigned char*)a->ws + z_ + WS_CTL) + CW_BAR; xcd_barrier(b2_); xcd_barrier(b2_); } } while (0)
#else
#define SEAM(k) do { if (IN(k) && IN((k) + 1)) { XcdBarrier b2_ = bar; size_t z_ = 0; asm volatile("" : "+s"(z_)); b2_.bar = (unsigned*)((unsigned char*)a->ws + z_ + WS_CTL) + CW_BAR; xcd_barrier(b2_); } } while (0)
#endif

    if (IN(0)) { REFRESH(); p0_mod(F, a); p0_rope(F, a); p0_convert(F, a); p0_convert_up(F, a);
#ifdef DBG_DOUBLE_P0
        p0_convert(F, a);
#endif
    } SEAM(0);
    if (IN(1)) { REFRESH(); p_norm_first(F, a); } SEAM(1);

    for (int l = 0; l < DEPTH; ++l) {
        const int pb = 2 + l * PH_PER_LAYER;
#ifndef DBG_SKIP_MIXER
        if (IN(pb + 0)) { REFRESH();
#ifdef DBG_REP_GIN
            for (int rep_ = 0; rep_ < 2; ++rep_) {
#else
            {
#endif

            pg8::DenseSched S; S.init(XN, (const bf16_t*)(F.ws + opq(WS_WIN)) + (size_t)l * NPROJ * DM, T, NPROJ, DM, F.G, F.bx);
            pg8::EpiStore E{PROJ, NPROJ};
            pg8::gemm_phase<pg8::EpiStore, pg8::DenseSched, false>(F.lds + RING_OFF, S, E);
                    }
        } SEAM(pb + 0);
        if (IN(pb + 2)) { REFRESH();
            p_post1(F, a, l);
            LAS float* tabq = (LAS float*)(F.lds + MISC_OFF + 1024); LAS float* tabkv = tabq + 256;
            { pg8::DenseSched S; S.init(PROJ + C_CQ, (const bf16_t*)(F.ws + opq(WS_WUQ)) + (size_t)l * 768 * 256, T, 768, 256, F.G, F.bx, NPROJ);
              pg8::Unit u0; if (S.next(0, u0)) rs_table<256>(F, PROJ + (size_t)u0.pm * 256 * NPROJ + C_CQ, tabq);
              __syncthreads();
              pg8::EpiStoreRS E{(bf16_t*)(F.ws + opq(WS_QM)), 768, tabq}; pg8::gemm_phase<pg8::EpiStoreRS, pg8::DenseSched, false>(F.lds + RING_OFF, S, E); }
            REFRESH();
            { pg8::DenseSched S; S.init(PROJ + C_CKV, (const bf16_t*)(F.ws + opq(WS_WUKV)) + (size_t)l * 768 * 128, T, 768, 128, F.G, (F.bx + 128) % F.G, NPROJ);
              pg8::Unit u0; if (S.next(0, u0)) rs_table<128>(F, PROJ + (size_t)u0.pm * 256 * NPROJ + C_CKV, tabkv);
              __syncthreads();
              pg8::EpiStoreRS E{(bf16_t*)(F.ws + opq(WS_KVM)), 768, tabkv}; pg8::gemm_phase<pg8::EpiStoreRS, pg8::DenseSched, false>(F.lds + RING_OFF, S, E); }
        } SEAM(pb + 2);
        if (IN(pb + 3)) { REFRESH(); p_attention(F, a, l, l);
#ifdef DBG_DOUBLE_ATT
            p_attention(F, a, l, l + 4);
#endif
        } SEAM(pb + 3);
        if (IN(pb + 4)) { REFRESH();
#ifdef DBG_REP_SMALL
            for (int rep_ = 0; rep_ < 2; ++rep_) {
#else
            {
#endif

            for (int s = 0; s < 3; ++s) {
                const bf16_t* A = (const bf16_t*)(F.ws + (s == 0 ? WS_OSB : s == 1 ? WS_OMLA : WS_ODSA));
                const bf16_t* B = (const bf16_t*)(F.ws + (s == 0 ? WS_WSB : s == 1 ? WS_WMLA : WS_WDSA)) + (size_t)l * DM * (s == 2 ? 256 : 384);
                pg8::DenseSched S; S.init(A, B, T, DM, s == 2 ? 256 : 384, F.G, F.bx);
                pg8::EpiBranch E{(bf16_t*)(F.ws + opq(WS_MRG)), PROJ, C_GATE + s * DM, s == 0};
                pg8::gemm_phase<pg8::EpiBranch, pg8::DenseSched, false>(F.lds + RING_OFF, S, E);
            }
                    }
        } SEAM(pb + 4);
        if (IN(pb + 5)) { REFRESH();
            pg8::DenseSched S; S.init((const bf16_t*)(F.ws + opq(WS_MRG)), (const bf16_t*)(F.ws + opq(WS_WOUT)) + (size_t)l * DM * DM, T, DM, DM, F.G, F.bx);
            pg8::EpiResid E{(float*)(F.ws + opq(WS_X)), (const float*)(F.ws + opq(WS_MOD)) + (size_t)l * 2 * 6 * DM + 2 * DM, 0};
            pg8::gemm_phase<pg8::EpiResid, pg8::DenseSched, false>(F.lds + RING_OFF, S, E);
#ifdef DBG_REP_OUT
            { pg8::EpiResid E2 = E; E2.dofs = (size_t)1600 * MiB; pg8::gemm_phase<pg8::EpiResid, pg8::DenseSched, false>(F.lds + RING_OFF, S, E2); }
#endif
        } SEAM(pb + 5);
#endif
        if (IN(pb + 6)) { REFRESH(); p_norm2_router(F, a, l);
#ifdef DBG_REP_ROUTER
            p_norm2_router(F, a, l, (size_t)1600 * MiB, 64 + l);
#endif
        } SEAM(pb + 6);
#ifndef DBG_SKIP_MOE
        if (IN(pb + 7)) { REFRESH();
#ifdef DBG_REP_MOE
            for (int rep_ = 0; rep_ < 2; ++rep_) {
#else
            {
#endif

            const pg8::MoeTab tb = moe_tables(F, l);
            pg8::MoeSched<true, 8> S{XN, (const bf16_t*)(F.ws + opq(WS_WGU)) + (size_t)l * NEXP * 2048 * DM, (const int*)(F.ws + opq(WS_LIST)), tb, DM, F.G, F.bx, (LAS unsigned*)(F.lds + MISC_OFF + 1024)};
            pg8::EpiSwiglu E{(bf16_t*)(F.ws + opq(WS_ACT)), ((const float*)a->b_gu) + (size_t)l * NEXP * 2048, (LAS float*)(F.lds + MISC_OFF + 3072)};
            pg8::gemm_phase<pg8::EpiSwiglu, pg8::MoeSched<true, 8>, false>(F.lds + RING_OFF, S, E);
                    }
        } SEAM(pb + 7);
        if (IN(pb + 8)) { REFRESH();
#ifdef DBG_REP_MOE
            for (int rep_ = 0; rep_ < 2; ++rep_) {
#else
            {
#endif

            const pg8::MoeTab tb = moe_tables_again(F);
            pg8::MoeSched<false, 4> S{(const bf16_t*)(F.ws + opq(WS_ACT)), (const bf16_t*)(F.ws + opq(WS_WDN)) + (size_t)l * NEXP * DM * DM, nullptr, tb, DM, F.G, F.bx, (LAS unsigned*)(F.lds + MISC_OFF + 1024)};
            pg8::EpiDown E{(bf16_t*)(F.ws + opq(WS_EOUT)), ((const float*)a->b_dn) + (size_t)l * NEXP * DM, (const float*)(F.ws + opq(WS_LISTW)), (LAS float*)(F.lds + MISC_OFF + 3072)};
            pg8::gemm_phase<pg8::EpiDown, pg8::MoeSched<false, 4>, false>(F.lds + RING_OFF, S, E);
                    }
        } SEAM(pb + 8);
#endif
        if (IN(pb + 9)) { REFRESH(); const pg8::MoeTab tb = moe_tables_again(F);
#ifdef DBG_REP_COMBINE
            p_combine(F, a, l, tb, (size_t)1600 * MiB);
#endif
            p_combine(F, a, l, tb); } SEAM(pb + 9);
    }
#undef IN
#undef SEAM
#undef XN
#undef PROJ
}

#ifndef MK_MULTI
#define MK_MULTI 0
#endif
extern "C" void kernel_launch(void* const* d_in, const int* in_sizes, int n_in, void* d_out, int out_size, void* d_ws, size_t ws_size, hipStream_t stream) {
    static int grid = 0;
    if (grid == 0) {
        if (n_in != 23 || in_sizes[0] != T * DM || out_size != T * DM || ws_size < WS_END) { fprintf(stderr, "kernel_launch: unexpected shapes (n_in %d, ws %zu); nothing launched\n", n_in, ws_size); grid = -1; return; }
        int dev = 0, cus = 0, per_cu = 0;
        if (hipGetDevice(&dev) != hipSuccess || hipDeviceGetAttribute(&cus, hipDeviceAttributeMultiprocessorCount, dev) != hipSuccess) { grid = -1; return; }
        if (hipFuncSetAttribute((const void*)mk_fwd, hipFuncAttributeMaxDynamicSharedMemorySize, LDS_BYTES) != hipSuccess) { fprintf(stderr, "kernel_launch: hipFuncSetAttribute failed\n"); grid = -1; return; }
        if (hipOccupancyMaxActiveBlocksPerMultiprocessor(&per_cu, (const void*)mk_fwd, NTHR, LDS_BYTES) != hipSuccess || per_cu < 1) { fprintf(stderr, "kernel_launch: note: occupancy query says %d\n", per_cu); (void)hipGetLastError(); }
        grid = cus;
    }
    if (grid < 0) return;
    if (hipMemsetAsync((char*)d_ws + WS_CTL, 0, CTL_ZERO_BYTES, stream) != hipSuccess) return;
    Args a{};
    a.x = (gcf)d_in[0]; a.c = (gcf)d_in[1]; a.pos = (gci)d_in[2];
    a.ada_w = (gcf)d_in[3]; a.ada_b = (gcf)d_in[4]; a.norm_mix_g = (gcf)d_in[5]; a.w_in = (gcf)d_in[6];
    a.q_norm_g = (gcf)d_in[7]; a.kv_norm_g = (gcf)d_in[8]; a.w_uq = (gcf)d_in[9]; a.w_ukv = (gcf)d_in[10];
    a.w_sb_out = (gcf)d_in[11]; a.w_mla_out = (gcf)d_in[12]; a.w_dsa_out = (gcf)d_in[13]; a.w_out = (gcf)d_in[14];
    a.norm_ffn_g = (gcf)d_in[15]; a.router_w = (gcf)d_in[16]; a.router_b = (gcf)d_in[17];
    a.w_gu = (gcf)d_in[18]; a.b_gu = (gcf)d_in[19]; a.w_dn = (gcf)d_in[20]; a.b_dn = (gcf)d_in[21]; a.final_g = (gcf)d_in[22];
    a.out = (GAS float*)d_out; a.ws = (GAS unsigned char*)d_ws;
#if MK_MULTI
    for (int p = 0; p < N_PHASES; ++p) { a.ph_lo = p; a.ph_hi = p + 1; hipLaunchKernelGGL(mk_fwd, dim3(grid), dim3(NTHR), LDS_BYTES, stream, a); }
#else
    a.ph_lo = 0; a.ph_hi = N_PHASES; hipLaunchKernelGGL(mk_fwd, dim3(grid), dim3(NTHR), LDS_BYTES, stream, a);
#endif
}
```

```cpp
#include <hip/hip_runtime.h>
#include <cstdio>
#include <cstdint>

#define LAS __attribute__((address_space(3)))
#define GAS __attribute__((address_space(1)))
typedef unsigned short bf16_t;
typedef short bf16x8 __attribute__((ext_vector_type(8)));
typedef short s16x4 __attribute__((ext_vector_type(4)));
typedef float f32x2 __attribute__((ext_vector_type(2)));
typedef float f32x4 __attribute__((ext_vector_type(4)));
typedef float f32x16 __attribute__((ext_vector_type(16)));
typedef unsigned u32x2 __attribute__((ext_vector_type(2)));
typedef unsigned u32x4 __attribute__((ext_vector_type(4)));
typedef GAS unsigned gu32;
#define RLX_AGENT __ATOMIC_RELAXED, __HIP_MEMORY_SCOPE_AGENT
#define DI __device__ __forceinline__

constexpr int BATCH = 2, SEQ = 8192, DM = 1024, DEPTH = 4, T = BATCH * SEQ;
constexpr int D_IN = 5704, NPROJ = 5888;
constexpr int C_SBQ = 0, C_SBK = 384, C_SBV = 768, C_CQ = 1152, C_CKV = 1408, C_KR = 1536, C_DQ = 1568, C_DK = 1824, C_DV = 2080,
              C_IQ = 2336, C_IK = 2592, C_IW = 2624, C_GATE = 2632;
constexpr int NEXP = 32, ECAP = T;
constexpr float NORM_EPS = 1e-6f;
constexpr int NWAVES = 8, NTHR = 512;

DI unsigned f2bf(float f) { unsigned u = __builtin_bit_cast(unsigned, f); return (u + 0x7fffu + ((u >> 16) & 1u)) >> 16; }
DI unsigned pk2(float lo, float hi) { return f2bf(lo) | (f2bf(hi) << 16); }
DI float bf2f(unsigned short h) { return __builtin_bit_cast(float, (unsigned)h << 16); }
DI float bflo(unsigned w) { return __builtin_bit_cast(float, w << 16); }
DI float bfhi(unsigned w) { return __builtin_bit_cast(float, w & 0xffff0000u); }
DI unsigned cvt_pk_bf16(float lo, float hi) { unsigned r; asm volatile("v_cvt_pk_bf16_f32 %0, %1, %2" : "=v"(r) : "v"(lo), "v"(hi)); return r; }
DI float shx(float v, int o, int lane) { return __builtin_bit_cast(float, __builtin_amdgcn_ds_bpermute((lane ^ o) << 2, __builtin_bit_cast(int, v))); }
DI float shl(float v, int src) { return __builtin_bit_cast(float, __builtin_amdgcn_ds_bpermute(src << 2, __builtin_bit_cast(int, v))); }
DI unsigned long long shx64(unsigned long long v, int o, int lane) {
    const unsigned lo = (unsigned)__builtin_amdgcn_ds_bpermute((lane ^ o) << 2, (int)(unsigned)v), hi = (unsigned)__builtin_amdgcn_ds_bpermute((lane ^ o) << 2, (int)(unsigned)(v >> 32));
    return ((unsigned long long)hi << 32) | lo; }
DI float wave_sum(float v, int lane) {
#pragma unroll
    for (int o = 1; o < 64; o <<= 1) v += shx(v, o, lane);
    return v;
}
DI float zero_op() { float z = 0.f; asm volatile("" : "+v"(z)); return z; }
DI size_t opq(size_t v) { asm volatile("" : "+s"(v)); return v; }
DI float fast_sigmoid(float x) { return __builtin_amdgcn_rcpf(1.0f + __builtin_amdgcn_exp2f(-1.4426950408889634f * x)); }

namespace pg8 {
constexpr int BM = 256, BK = 64, HALF = 128, HTB = HALF * BK * 2, STAGE_BYTES = 8 * HTB, NXCD = 8, WGM = 8;
__host__ __device__ __forceinline__ int lds_byte(int r, int c) { const int st = (r >> 4) * 2 + (c >> 5), rr = r & 15, cc = c & 31, ob = rr * 64 + cc * 2; return st * 1024 + (ob ^ (((ob >> 9) & 1) << 5)); }
__host__ __device__ __forceinline__ void stage_rc(int b, int& R, int& C) { const int st = b / 1024, sb = b % 1024, swz = sb ^ (((sb >> 9) & 1) << 5); R = (st >> 1) * 16 + swz / 64; C = (st & 1) * 32 + (swz % 64) / 2; }
__host__ __device__ __forceinline__ int perm32(int rho) { const int n = rho >> 4, i = rho & 15; return 8 * (i >> 2) + 4 * n + (i & 3); }

struct Unit { int pm, pn, e, row0, nrows, par; };

struct DenseSched {
    const bf16_t* A; const bf16_t* Bt; int K; int nM, nN, nwg, G, c, lda;
    DI void init(const bf16_t* A_, const bf16_t* Bt_, int M, int N, int K_, int G_, int c_, int lda_ = 0) { A = A_; Bt = Bt_; K = K_; nM = M / BM; nN = N / BM; nwg = nM * nN; G = G_; c = c_; lda = lda_ ? lda_ : K_; }
    DI bool next(int i, Unit& u) const {
        const long L = (long)i * G + c; if (L >= nwg) return false;
        int wgid = (int)L; { const int q = nwg / NXCD, r = nwg % NXCD, xcd = wgid % NXCD, off = wgid / NXCD; wgid = (xcd < r ? xcd * (q + 1) : r * (q + 1) + (xcd - r) * q) + off; }
        const int nig = WGM * nN, gid = wgid / nig, fm = gid * WGM, gsz = (nM - fm) < WGM ? (nM - fm) : WGM;
        u.pm = fm + ((wgid % nig) % gsz); u.pn = (wgid % nig) / gsz; u.e = 0; u.row0 = u.pm * BM; u.nrows = BM; return true;
    }
    DI const char* abase(const Unit& u) const { return (const char*)A + (size_t)u.pm * BM * lda * 2; }
    DI const char* bbase(const Unit& u) const { return (const char*)Bt + (size_t)u.pn * BM * K * 2; }
    DI void aoffs(const Unit&, int R, int C, unsigned (&v)[4]) const {
#pragma unroll
        for (int m = 0; m < 4; ++m) v[m] = (unsigned)((R + 64 * m) * lda + C) * 2u;
    }
    DI void prefetch(const Unit&, int, int) const {}
    DI void aoffs_next(const Unit& u, int R, int C, unsigned (&v)[4], int) const { aoffs(u, R, C, v); }
};

template <class Epi, class Sched, bool ALIGN_EPI>
DI void gemm_phase(LAS unsigned char* lds, const Sched& S, const Epi& E) {
    int tid = threadIdx.x; asm volatile("" : "+v"(tid));
    const int wid = __builtin_amdgcn_readfirstlane(tid >> 6), lane = tid & 63, wr = wid >> 2, wc = wid & 3, fr = lane & 15, fq = lane >> 4;
    const int K = S.K, nt = K / BK;
    int sR, sC; stage_rc(tid * 16, sR, sC);
    unsigned voffB[2];
#pragma unroll
    for (int i = 0; i < 2; ++i) { const int R = sR + 64 * i; const int Rb = Epi::PERM ? ((R & ~31) + perm32(R & 31)) : R; voffB[i] = (unsigned)(Rb * K + sC) * 2u; }
    const size_t kstep = (size_t)(BK * 2);
    const size_t hstep = (size_t)HALF * K * 2;
    const unsigned ldsw = (unsigned)wid * 1024u;
    const int aoff = lds_byte(wr * 64 + fr, fq * 8), boff = lds_byte(wc * 32 + fr, fq * 8);
#define PG8_SA(b, h) (((b) * 2 + (h)) * HTB)
#define PG8_SB(b, h) ((4 + (b) * 2 + (h)) * HTB)
#define PG8_STAGEB(bufoff, gbase) do { _Pragma("unroll") for (int _i = 0; _i < 2; ++_i) \
        __builtin_amdgcn_global_load_lds((const unsigned*)((const char*)(gbase) + voffB[_i]), (LAS unsigned*)(lds + (bufoff) + ldsw + _i * 8192), 16, 0, 0); } while (0)
#define PG8_STAGEA(bufoff, gbase, v0, v1) do { \
        __builtin_amdgcn_global_load_lds((const unsigned*)((const char*)(gbase) + (v0)), (LAS unsigned*)(lds + (bufoff) + ldsw), 16, 0, 0); \
        __builtin_amdgcn_global_load_lds((const unsigned*)((const char*)(gbase) + (v1)), (LAS unsigned*)(lds + (bufoff) + ldsw + 8192), 16, 0, 0); } while (0)
#define PG8_LDA(dst, b, h) do { _Pragma("unroll") for (int m = 0; m < 4; ++m) _Pragma("unroll") for (int k = 0; k < 2; ++k) dst[m][k] = *(const LAS bf16x8*)(lds + PG8_SA(b, h) + aoff + m * 2048 + k * 1024); } while (0)
#define PG8_LDB(dst, b, h) do { _Pragma("unroll") for (int n = 0; n < 2; ++n) _Pragma("unroll") for (int k = 0; k < 2; ++k) dst[n][k] = *(const LAS bf16x8*)(lds + PG8_SB(b, h) + boff + n * 2048 + k * 1024); } while (0)
#define PG8_MMA(ai, bj, At, Bt) do { __builtin_amdgcn_s_setprio(1); _Pragma("unroll") for (int m = 0; m < 4; ++m) _Pragma("unroll") for (int n = 0; n < 2; ++n) _Pragma("unroll") for (int k = 0; k < 2; ++k) \
        acc[ai][bj][m][n] = __builtin_amdgcn_mfma_f32_16x16x32_bf16(Bt[n][k], At[m][k], acc[ai][bj][m][n], 0, 0, 0); __builtin_amdgcn_s_setprio(0); } while (0)
#define PG8_WAIT_V(n) asm volatile("s_waitcnt vmcnt(" #n ")" ::: "memory")
#define PG8_WAIT_L(n) asm volatile("s_waitcnt lgkmcnt(" #n ")" ::: "memory")
#define PG8_BAR __builtin_amdgcn_s_barrier()
#define PG8_SCHED __builtin_amdgcn_sched_barrier(0)
    Unit cur, nxt; int ui = 0;
    if (!S.next(0, cur)) return;
    f32x4 acc[2][2][4][2];
    float zz = 0.f; asm volatile("" : "+v"(zz));
#pragma unroll
    for (int a = 0; a < 2; ++a)
#pragma unroll
        for (int b = 0; b < 2; ++b)
#pragma unroll
            for (int m = 0; m < 4; ++m)
#pragma unroll
                for (int n = 0; n < 2; ++n) acc[a][b][m][n] = (f32x4){zz, zz, zz, zz};
    bf16x8 At[4][2], B0[2][2], B1[2][2];
    const char* cA = S.abase(cur); const char* cB = S.bbase(cur);
    unsigned cv[4];
    S.aoffs(cur, sR, sC, cv);
    PG8_STAGEB(PG8_SB(0, 0), cB); PG8_STAGEB(PG8_SB(0, 1), cB + hstep); PG8_STAGEA(PG8_SA(0, 0), cA, cv[0], cv[1]); PG8_STAGEA(PG8_SA(0, 1), cA, cv[2], cv[3]);
    if (wr == 1) PG8_BAR;
    PG8_WAIT_V(2); PG8_BAR;
    PG8_STAGEB(PG8_SB(1, 0), cB + kstep); PG8_STAGEA(PG8_SA(1, 0), cA + kstep, cv[0], cv[1]); PG8_STAGEB(PG8_SB(1, 1), cB + hstep + kstep);
    PG8_WAIT_V(6); PG8_BAR;
    for (;;) {
        const bool has_next = S.next(ui + 1, nxt);
        cur.par = ui & 1;
        { int t2 = threadIdx.x; asm volatile("" : "+v"(t2)); E.prefetch(cur, t2); }
        const char* nA = cA; const char* nB = cB;
        if (has_next) { nA = S.abase(nxt); nB = S.bbase(nxt); int t2 = threadIdx.x; asm volatile("" : "+v"(t2)); S.prefetch(nxt, t2, (ui + 1) & 1); }
        for (int t = 0; t < nt; t += 2) {
            const bool last = (t == nt - 2);
            const char* a1 = cA + (size_t)(t + 1) * kstep;
            const char* a2 = last ? nA : cA + (size_t)(t + 2) * kstep; const char* b2 = last ? nB : cB + (size_t)(t + 2) * kstep;
            const char* a3 = a2 + kstep; const char* b3 = b2 + kstep;
            unsigned wv[4];
#pragma unroll
            for (int m = 0; m < 4; ++m) wv[m] = cv[m];
            if (last && has_next) { int t2 = threadIdx.x; asm volatile("" : "+v"(t2)); int R2, C2; stage_rc(t2 * 16, R2, C2); S.aoffs_next(nxt, R2, C2, wv, (ui + 1) & 1); }
            const unsigned w0 = wv[0], w1 = wv[1], w2 = wv[2], w3 = wv[3];
            PG8_LDB(B0, 0, 0); PG8_LDB(B1, 0, 1); PG8_SCHED; PG8_LDA(At, 0, 0); PG8_STAGEA(PG8_SA(1, 1), a1, cv[2], cv[3]);
            PG8_WAIT_V(8); PG8_WAIT_L(0); PG8_BAR; PG8_MMA(0, 0, At, B0); PG8_MMA(0, 1, At, B1); PG8_BAR; PG8_SCHED;
            PG8_LDA(At, 0, 1); PG8_STAGEB(PG8_SB(0, 0), b2); PG8_STAGEB(PG8_SB(0, 1), b2 + hstep); PG8_STAGEA(PG8_SA(0, 0), a2, w0, w1);
            PG8_WAIT_V(8); PG8_WAIT_L(0); PG8_BAR; PG8_MMA(1, 0, At, B0); PG8_MMA(1, 1, At, B1); PG8_BAR; PG8_SCHED;
            PG8_LDB(B0, 1, 0); PG8_LDB(B1, 1, 1); PG8_SCHED; PG8_LDA(At, 1, 0); PG8_STAGEA(PG8_SA(0, 1), a2, w2, w3);
            PG8_WAIT_V(8); PG8_WAIT_L(0); PG8_BAR; PG8_MMA(0, 0, At, B0); PG8_MMA(0, 1, At, B1); PG8_BAR; PG8_SCHED;
            PG8_LDA(At, 1, 1); PG8_STAGEB(PG8_SB(1, 0), b3); PG8_STAGEB(PG8_SB(1, 1), b3 + hstep); PG8_STAGEA(PG8_SA(1, 0), a3, w0, w1);
            PG8_WAIT_V(8); PG8_WAIT_L(0); PG8_BAR; PG8_MMA(1, 0, At, B0); PG8_MMA(1, 1, At, B1); PG8_BAR; PG8_SCHED;
        }
        if constexpr (ALIGN_EPI) { if (wr == 0) PG8_BAR; }
        { int t2 = threadIdx.x; asm volatile("" : "+v"(t2)); const int l2 = t2 & 63; E(acc, cur, wr, wc, l2 & 15, l2 >> 4); }
        if (!has_next) break;
#pragma unroll
        for (int a = 0; a < 2; ++a)
#pragma unroll
            for (int b = 0; b < 2; ++b)
#pragma unroll
                for (int m = 0; m < 4; ++m)
#pragma unroll
                    for (int n = 0; n < 2; ++n) acc[a][b][m][n] = (f32x4){zz, zz, zz, zz};
        cur = nxt; cA = nA; cB = nB; ++ui;
        { int t2 = threadIdx.x; asm volatile("" : "+v"(t2)); int R2, C2; stage_rc(t2 * 16, R2, C2); S.aoffs_next(cur, R2, C2, cv, ui & 1); }
        if constexpr (ALIGN_EPI) { if (wr == 1) PG8_BAR; }
    }
    PG8_WAIT_V(0);
    if constexpr (!ALIGN_EPI) { if (wr == 0) PG8_BAR; }
    PG8_BAR;
#undef PG8_SA
#undef PG8_SB
#undef PG8_STAGEA
#undef PG8_STAGEB
#undef PG8_LDA
#undef PG8_LDB
#undef PG8_MMA
#undef PG8_WAIT_V
#undef PG8_WAIT_L
#undef PG8_BAR
#undef PG8_SCHED
}
}
constexpr size_t MiB = 1u << 20;
constexpr size_t WS_CTL = 0, CTL_ZERO_BYTES = 1 * MiB;
constexpr size_t WS_MOD   = 1 * MiB;
constexpr size_t WS_ROPE32 = 2 * MiB;
constexpr size_t WS_ROPE16 = 6 * MiB;
constexpr size_t WS_WIN   = 8 * MiB;
constexpr size_t WS_WUQ   = 56 * MiB;
constexpr size_t WS_WUKV  = 58 * MiB;
constexpr size_t WS_WSB   = 60 * MiB;
constexpr size_t WS_WMLA  = 64 * MiB;
constexpr size_t WS_WDSA  = 68 * MiB;
constexpr size_t WS_WOUT  = 72 * MiB;
constexpr size_t WS_WGU   = 80 * MiB;
constexpr size_t WS_WDN   = 592 * MiB;
constexpr size_t WS_X     = 848 * MiB;
constexpr size_t WS_XN    = 912 * MiB;
constexpr size_t WS_PROJ  = 944 * MiB;
constexpr size_t WS_CQN   = 1128 * MiB;
constexpr size_t WS_CKVN  = 1136 * MiB;
constexpr size_t WS_KR    = 1140 * MiB;
constexpr size_t WS_DK    = 1141 * MiB;
constexpr size_t WS_IK    = 1149 * MiB;
constexpr size_t WS_IW    = 1150 * MiB;
constexpr size_t WS_QM    = 1152 * MiB;
constexpr size_t WS_KVM   = 1176 * MiB;
constexpr size_t WS_OSB   = 1200 * MiB;
constexpr size_t WS_OMLA  = 1212 * MiB;
constexpr size_t WS_ODSA  = 1224 * MiB;
constexpr size_t WS_MRG   = 1232 * MiB;
constexpr size_t WS_LIST  = 1264 * MiB;
constexpr size_t WS_LISTW = 1266 * MiB;
constexpr size_t WS_TOKE  = 1268 * MiB;
constexpr size_t WS_ACT   = 1272 * MiB;
constexpr size_t WS_EOUT  = 1402 * MiB;
constexpr size_t WS_BM    = 1532 * MiB;
constexpr size_t WS_END   = 1548 * MiB;
constexpr int CW_BAR = 4096;
constexpr int CW_CNT = 8192;
constexpr int CW_QATT = 8192 + 256;
constexpr int CW_SELF = 16384;
constexpr int CW_KMAX = 8192 + 1024;

constexpr int RING_OFF = 0, RING_BYTES = 131072;
constexpr int MISC_OFF = RING_BYTES;
constexpr int LDS_BYTES = 147456;

#define XB_TMO      128
#define XB_XCNT(j)  (256  + 64 * (j))
#define XB_XSUB(j)  (1280 + 64 * (j))
#define XB_XGEN(j)  (2304 + 64 * (j))
#define XB_TOP      3328
#define XB_TOPGEN   3392
#define XCD_BAR_WORDS 3456
#define XB_SPIN_CAP (1u << 18)

__device__ __forceinline__ unsigned xb_ld(unsigned* p)              { return __hip_atomic_load(p, __ATOMIC_RELAXED, __HIP_MEMORY_SCOPE_AGENT); }
__device__ __forceinline__ unsigned xb_add(unsigned* p, unsigned v) { return __hip_atomic_fetch_add(p, v, __ATOMIC_RELAXED, __HIP_MEMORY_SCOPE_AGENT); }
__device__ __forceinline__ unsigned xb_xcc_id() { return (unsigned)__builtin_amdgcn_s_getreg((3 << 11) | 20) & 0xFu; }
#define XB_SPIN(cond, bar) do { unsigned _sp = 0; while (cond) { __builtin_amdgcn_s_sleep(1); \
    if ((++_sp & 255u) == 0u) { if (xb_ld(&(bar)[XB_TMO])) break; if (_sp > XB_SPIN_CAP) { atomicAdd(&(bar)[XB_TMO], 1u); break; } } } } while (0)

struct XcdBarrier { unsigned* bar; unsigned x; volatile LAS unsigned* st; };

__device__ __forceinline__ XcdBarrier xcd_barrier_post(unsigned* bar, volatile LAS unsigned* st) {
    XcdBarrier b; b.bar = bar; b.x = xb_xcc_id(); b.st = st;
    if (threadIdx.x == 0) (void)xb_add(&bar[XB_XCNT(b.x)], 1u);
    return b;
}
__device__ __forceinline__ void xcd_barrier_complete(unsigned* bar, unsigned x, unsigned& nloc, unsigned& nx) {
    const unsigned G = gridDim.x * gridDim.y * gridDim.z;
    unsigned sum, cnt, mine, sp = 0u;
    for (;;) {
        sum = 0u; cnt = 0u; mine = 0u;
#pragma unroll
        for (unsigned j = 0; j < 16; ++j) { const unsigned c = xb_ld(&bar[XB_XCNT(j)]); sum += c; cnt += (c > 0u) ? 1u : 0u; mine = (j == x) ? c : mine; }
        if (sum == G) break;
        __builtin_amdgcn_s_sleep(1);
        if ((++sp & 255u) == 0u) { if (xb_ld(&bar[XB_TMO])) break; if (sp > XB_SPIN_CAP) { atomicAdd(&bar[XB_TMO], 1u); break; } }
    }
    nloc = mine > 0u ? mine : 1u; nx = cnt > 0u ? cnt : 1u;
}
__device__ __forceinline__ void xcd_barrier(const XcdBarrier& b) {
    asm volatile("s_waitcnt vmcnt(0)" ::: "memory");
    __syncthreads();
    if (threadIdx.x == 0) {
        unsigned* bar = b.bar;
        __builtin_amdgcn_s_waitcnt(0);
        unsigned nloc = b.st[0], nx = b.st[1];
        if (nloc == 0u) { xcd_barrier_complete(bar, b.x, nloc, nx); b.st[0] = nloc; b.st[1] = nx; }
        const unsigned old = xb_add(&bar[XB_XSUB(b.x)], 1u);
        const unsigned gen = old / nloc;
        if (old + 1u == (gen + 1u) * nloc) {
            __builtin_amdgcn_fence(__ATOMIC_RELEASE, "agent");
            asm volatile("s_waitcnt vmcnt(0)" ::: "memory");
            const unsigned og = xb_add(&bar[XB_TOP], 1u);
            const unsigned tg = og / nx;
            if (og + 1u == (tg + 1u) * nx) xb_add(&bar[XB_TOPGEN], 1u);
            else XB_SPIN(xb_ld(&bar[XB_TOPGEN]) == tg, bar);
            __builtin_amdgcn_fence(__ATOMIC_ACQUIRE, "agent");
            xb_add(&bar[XB_XGEN(b.x)], 1u);
            asm volatile("s_waitcnt vmcnt(0)" ::: "memory");
        } else {
            XB_SPIN(xb_ld(&bar[XB_XGEN(b.x)]) == gen, bar);
            __builtin_amdgcn_fence(__ATOMIC_ACQUIRE, "agent");
            asm volatile("s_waitcnt vmcnt(0)" ::: "memory");
        }
    }
    __syncthreads();
}

typedef const GAS float* gcf; typedef const GAS int* gci;
struct Args {
    gcf x, c; gci pos;
    gcf ada_w, ada_b, norm_mix_g, w_in, q_norm_g, kv_norm_g, w_uq, w_ukv, w_sb_out, w_mla_out, w_dsa_out, w_out,
        norm_ffn_g, router_w, router_b, w_gu, b_gu, w_dn, b_dn, final_g;
    GAS float* out; GAS unsigned char* ws;
    int ph_lo, ph_hi;
};
typedef const __attribute__((address_space(4))) Args* ArgsP;
struct Frame {
    LAS unsigned char* lds;
    volatile LAS unsigned* MISC;
    gu32* ctl;
    int tid, lane, wave, G, gw, NGW, bx;
    unsigned char* ws;
};
__constant__ float INVF32[32] = {1.f, 0.749894261f, 0.562341332f, 0.421696514f, 0.316227764f, 0.237137377f, 0.177827939f, 0.133352131f, 0.100000001f, 0.0749894157f, 0.0562341325f, 0.0421696529f, 0.0316227749f, 0.0237137377f, 0.0177827943f, 0.0133352149f, 0.00999999978f, 0.00749894185f, 0.00562341325f, 0.00421696482f, 0.00316227763f, 0.00237137359f, 0.00177827943f, 0.00133352145f, 0.00100000005f, 0.000749894243f, 0.000562341302f, 0.000421696517f, 0.000316227757f, 0.00023713737f, 0.00017782794f, 0.00013335215f};
__constant__ float INVF16[16] = {1.f, 0.562341332f, 0.316227764f, 0.177827939f, 0.100000001f, 0.0562341325f, 0.0316227749f, 0.0177827943f, 0.00999999978f, 0.00562341325f, 0.00316227763f, 0.00177827943f, 0.00100000005f, 0.000562341302f, 0.000316227757f, 0.00017782794f};

DI void p0_mod(Frame& F, ArgsP a) {
    LAS float* sc = (LAS float*)(F.lds + RING_OFF);
    LAS float* part = sc + 2048;
    for (int i = F.tid; i < 2048; i += NTHR) { const float v = ((const float*)a->c)[i]; sc[i] = v * fast_sigmoid(v); }
    __syncthreads();
    float* MOD = (float*)(F.ws + opq(WS_MOD));
    for (int task = F.bx; task < DEPTH * 96; task += F.G) {
        const int l = task / 96, n = (task % 96) * 64 + F.lane;
        const float* W = ((const float*)a->ada_w) + (size_t)l * DM * 6 * DM + n;
        float a0 = 0.f, a1 = 0.f; const int kb = F.wave * 128;
#pragma unroll 8
        for (int k = 0; k < 128; ++k) { const float w = W[(size_t)(kb + k) * (6 * DM)]; a0 = __builtin_fmaf(sc[kb + k], w, a0); a1 = __builtin_fmaf(sc[1024 + kb + k], w, a1); }
        part[(F.wave * 2 + 0) * 64 + F.lane] = a0; part[(F.wave * 2 + 1) * 64 + F.lane] = a1;
        __syncthreads();
        if (F.wave < 2) { float s = ((const float*)a->ada_b)[l * 6 * DM + n];
#pragma unroll
            for (int w = 0; w < 8; ++w) s += part[(w * 2 + F.wave) * 64 + F.lane];
            MOD[(size_t)(l * 2 + F.wave) * 6 * DM + n] = s; }
        __syncthreads();
    }
}
DI void p0_rope(Frame& F, ArgsP a) {
    float* R32 = (float*)(F.ws + opq(WS_ROPE32)); float* R16 = (float*)(F.ws + opq(WS_ROPE16));
    const int gt = F.bx * NTHR + F.tid, NT = F.G * NTHR;
    for (int i = gt; i < T * 32; i += NT) { const int t = i >> 5, f = i & 31; const float ang = (float)((const int*)a->pos)[t] * INVF32[f]; R32[i] = cosf(ang); R32[T * 32 + i] = sinf(ang); }
    for (int i = gt; i < T * 16; i += NT) { const int t = i >> 4, f = i & 15; const float ang = (float)((const int*)a->pos)[t] * INVF16[f]; R16[i] = cosf(ang); R16[T * 16 + i] = sinf(ang); }
}
struct CvtItem { const float* W; bf16_t* WT; int ld, nvalid, K, Ndst, mode, item; };
constexpr int CV_IN = (NPROJ / 32) * 16, CV_UQ = 0, CV_UKV = 0, CV_SB = 32 * 6, CV_MLA = 32 * 6, CV_DSA = 32 * 4, CV_OUT = 32 * 16, CV_GU = 64 * 16, CV_DN = 32 * 16;
constexpr int CV_SMALL = CV_IN + CV_UQ + CV_UKV + CV_SB + CV_MLA + CV_DSA + CV_OUT, CV_EXP = NEXP * (CV_GU + CV_DN);
constexpr int CV_UNIT = 96, N_CVT = CV_EXP / CV_UNIT;
DI void cvt_decode_small(CvtItem& c, Frame& F, ArgsP a, int it) {
    const int l = it / CV_SMALL; int r = it % CV_SMALL;
    if (r < CV_IN)  { c = CvtItem{((const float*)a->w_in) + (size_t)l * DM * D_IN, (bf16_t*)(F.ws + opq(WS_WIN)) + (size_t)l * NPROJ * DM, D_IN, D_IN, DM, NPROJ, 0, r}; return; } r -= CV_IN;
    if (r < CV_UQ)  { c = CvtItem{((const float*)a->w_uq) + (size_t)l * 256 * 576, (bf16_t*)(F.ws + opq(WS_WUQ)) + (size_t)l * 768 * 256, 576, 576, 256, 768, 0, r}; return; } r -= CV_UQ;
    if (r < CV_UKV) { c = CvtItem{((const float*)a->w_ukv) + (size_t)l * 128 * 768, (bf16_t*)(F.ws + opq(WS_WUKV)) + (size_t)l * 768 * 128, 768, 768, 128, 768, 0, r}; return; } r -= CV_UKV;
    if (r < CV_SB)  { c = CvtItem{((const float*)a->w_sb_out) + (size_t)l * 384 * DM, (bf16_t*)(F.ws + opq(WS_WSB)) + (size_t)l * DM * 384, DM, DM, 384, DM, 0, r}; return; } r -= CV_SB;
    if (r < CV_MLA) { c = CvtItem{((const float*)a->w_mla_out) + (size_t)l * 384 * DM, (bf16_t*)(F.ws + opq(WS_WMLA)) + (size_t)l * DM * 384, DM, DM, 384, DM, 0, r}; return; } r -= CV_MLA;
    if (r < CV_DSA) { c = CvtItem{((const float*)a->w_dsa_out) + (size_t)l * 256 * DM, (bf16_t*)(F.ws + opq(WS_WDSA)) + (size_t)l * DM * 256, DM, DM, 256, DM, 0, r}; return; } r -= CV_DSA;
    c = CvtItem{((const float*)a->w_out) + (size_t)l * DM * DM, (bf16_t*)(F.ws + opq(WS_WOUT)) + (size_t)l * DM * DM, DM, DM, DM, DM, 0, r};
}
DI void cvt_decode_expert(CvtItem& c, Frame& F, ArgsP a, int l, int r) {
    if (r < NEXP * CV_GU) { const int e = r / CV_GU; c = CvtItem{((const float*)a->w_gu) + (size_t)(l * NEXP + e) * DM * 2048, (bf16_t*)(F.ws + opq(WS_WGU)) + (size_t)(l * NEXP + e) * 2048 * DM, 2048, 2048, DM, 2048, 1, r % CV_GU}; return; } r -= NEXP * CV_GU;
    { const int e = r / CV_DN; c = CvtItem{((const float*)a->w_dn) + (size_t)(l * NEXP + e) * DM * DM, (bf16_t*)(F.ws + opq(WS_WDN)) + (size_t)(l * NEXP + e) * DM * DM, DM, DM, DM, DM, 0, r % CV_DN}; }
}
DI void cvt_load(f32x4 (&v)[8], const CvtItem& c, int lane) {
    const int nblk = c.Ndst / 32, kb = c.item / nblk, nb = c.item % nblk, k0 = 64 * kb, n0 = 32 * nb, quad = lane & 7;
    int col; if (c.mode == 0) col = n0 + 4 * quad; else col = (quad < 4) ? (n0 / 2 + 4 * quad) : (1024 + n0 / 2 + 4 * (quad - 4));
    const bool ok = (c.mode != 0) || (col < c.nvalid);
#pragma unroll
    for (int i = 0; i < 8; ++i) { const int row = (lane >> 3) + 8 * i; const float z0 = zero_op(); v[i] = (f32x4){z0, z0, z0, z0}; if (ok) v[i] = *(const f32x4*)(c.W + (size_t)(k0 + row) * c.ld + col); }
}
DI void cvt_store(const f32x4 (&v)[8], const CvtItem& c, LAS float* scr, int lane) {
    const int nblk = c.Ndst / 32, kb = c.item / nblk, nb = c.item % nblk, k0 = 64 * kb, n0 = 32 * nb, quad = lane & 7;
#pragma unroll
    for (int i = 0; i < 8; ++i) { const int row = (lane >> 3) + 8 * i; LAS float* d = scr + row * 33 + 4 * quad; d[0] = v[i][0]; d[1] = v[i][1]; d[2] = v[i][2]; d[3] = v[i][3]; }
    asm volatile("s_waitcnt lgkmcnt(0)" ::: "memory");
    const int cc = lane & 7;
#pragma unroll
    for (int j = 0; j < 4; ++j) { const int nn = (lane >> 3) + 8 * j; const int slot = (c.mode == 0) ? nn : ((nn & 1) * 16 + (nn >> 1)); const LAS float* s = scr + (8 * cc) * 33 + slot;
        u32x4 o; o.x = pk2(s[0 * 33], s[1 * 33]); o.y = pk2(s[2 * 33], s[3 * 33]); o.z = pk2(s[4 * 33], s[5 * 33]); o.w = pk2(s[6 * 33], s[7 * 33]);
        *(u32x4*)(c.WT + (size_t)(n0 + nn) * c.K + k0 + 8 * cc) = o; }
    asm volatile("s_waitcnt lgkmcnt(0)" ::: "memory");
}
DI void p0_convert_up(Frame& F, ArgsP a) {
    const int gt = F.bx * NTHR + F.tid, NT_ = F.G * NTHR;
    bf16_t* WUQ = (bf16_t*)(F.ws + opq(WS_WUQ)); bf16_t* WUKV = (bf16_t*)(F.ws + opq(WS_WUKV));
    for (int i = gt; i < DEPTH * 256 * 768; i += NT_) { const int n = i % 768, k = (i / 768) % 256, l = i / (768 * 256);
        const float v = n < 576 ? ((const float*)a->w_uq)[((size_t)l * 256 + k) * 576 + n] * ((const float*)a->q_norm_g)[l * 256 + k] : 0.f;
        WUQ[((size_t)l * 768 + n) * 256 + k] = (bf16_t)f2bf(v); }
    for (int i = gt; i < DEPTH * 128 * 768; i += NT_) { const int n = i % 768, k = (i / 768) % 128, l = i / (768 * 128);
        const float v = ((const float*)a->w_ukv)[((size_t)l * 128 + k) * 768 + n] * ((const float*)a->kv_norm_g)[l * 128 + k];
        WUKV[((size_t)l * 768 + n) * 128 + k] = (bf16_t)f2bf(v); }
}
DI void p0_convert(Frame& F, ArgsP a) {
    LAS float* scr = (LAS float*)(F.lds + RING_OFF + 16384 + F.wave * 12288);
    constexpr int NIT = DEPTH * CV_SMALL;
    f32x4 va[8], vb[8]; CvtItem ca, cb;
    int it = F.gw;
    if (it < NIT) { cvt_decode_small(ca, F, a, it); cvt_load(va, ca, F.lane); }
    while (it < NIT) {
        const int it1 = it + F.NGW;
        if (it1 < NIT) { cvt_decode_small(cb, F, a, it1); cvt_load(vb, cb, F.lane); }
        cvt_store(va, ca, scr, F.lane);
        if (it1 >= NIT) break;
        const int it2 = it1 + F.NGW;
        if (it2 < NIT) { cvt_decode_small(ca, F, a, it2); cvt_load(va, ca, F.lane); }
        cvt_store(vb, cb, scr, F.lane);
        it = it2;
    }
}
DI void cvt_unit(Frame& F, ArgsP a, int l, int cu) {
    LAS float* scr = (LAS float*)(F.lds + RING_OFF + F.wave * 12288);
    const int base = cu * CV_UNIT + F.wave; constexpr int NK = CV_UNIT / NWAVES;
    f32x4 va[8], vb[8], vc[8], vd[8]; CvtItem ca, cb, cc, cd;
    cvt_decode_expert(ca, F, a, l, base); cvt_load(va, ca, F.lane);
    cvt_decode_expert(cb, F, a, l, base + 8); cvt_load(vb, cb, F.lane);
    cvt_decode_expert(cc, F, a, l, base + 16); cvt_load(vc, cc, F.lane);
#pragma unroll 1
    for (int k = 0; k < NK; k += 4) {
        cvt_decode_expert(cd, F, a, l, base + 8 * (k + 3)); cvt_load(vd, cd, F.lane);
        cvt_store(va, ca, scr, F.lane);
        if (k + 4 < NK) { cvt_decode_expert(ca, F, a, l, base + 8 * (k + 4)); cvt_load(va, ca, F.lane); }
        cvt_store(vb, cb, scr, F.lane);
        if (k + 4 < NK) { cvt_decode_expert(cb, F, a, l, base + 8 * (k + 5)); cvt_load(vb, cb, F.lane); }
        cvt_store(vc, cc, scr, F.lane);
        if (k + 4 < NK) { cvt_decode_expert(cc, F, a, l, base + 8 * (k + 6)); cvt_load(vc, cc, F.lane); }
        cvt_store(vd, cd, scr, F.lane);
    }
}

struct RowCoef { f32x4 a[4], b[4]; };
DI void load_coef(RowCoef& c, const float* g, const float* sh, const float* sc, int lane) {
    f32x4 gg[4], ss[4];
#pragma unroll
    for (int j = 0; j < 4; ++j) { const int o = 4 * lane + 256 * j; gg[j] = *(const f32x4*)(g + o); ss[j] = *(const f32x4*)(sc + o); c.b[j] = *(const f32x4*)(sh + o); }
    __builtin_amdgcn_sched_barrier(0);
#pragma unroll
    for (int j = 0; j < 4; ++j) c.a[j] = gg[j] * (ss[j] + 1.0f);
}
DI float row_rstd(const f32x4 (&v)[4], int lane) {
    float s = 0.f;
#pragma unroll
    for (int j = 0; j < 4; ++j) s += (v[j].x * v[j].x + v[j].y * v[j].y) + (v[j].z * v[j].z + v[j].w * v[j].w);
    return 1.0f / sqrtf(wave_sum(s, lane) * (1.0f / DM) + NORM_EPS);
}
DI void store_xn(bf16_t* xn_row, const f32x4 (&h)[4], int lane) {
#pragma unroll
    for (int j = 0; j < 4; ++j) { u32x2 w; w.x = pk2(h[j].x, h[j].y); w.y = pk2(h[j].z, h[j].w); *(u32x2*)(xn_row + 4 * lane + 256 * j) = w; }
}
DI void p_norm_first(Frame& F, ArgsP a) {
    const float* MOD = (const float*)(F.ws + opq(WS_MOD)); float* X = (float*)(F.ws + opq(WS_X)); bf16_t* XN = (bf16_t*)(F.ws + opq(WS_XN));
    constexpr int RPW = 8;
    for (int r0 = F.gw * RPW; r0 < T; r0 += F.NGW * RPW) {
        const int b = r0 / SEQ; const float* mod = MOD + (size_t)(0 * 2 + b) * 6 * DM;
        RowCoef c; load_coef(c, ((const float*)a->norm_mix_g), mod + 0 * DM, mod + 1 * DM, F.lane);
        for (int r = r0; r < r0 + RPW; ++r) {
            f32x4 v[4];
#pragma unroll
            for (int j = 0; j < 4; ++j) v[j] = *(const f32x4*)(((const float*)a->x) + (size_t)r * DM + 4 * F.lane + 256 * j);
            const float rstd = row_rstd(v, F.lane);
            f32x4 h[4];
#pragma unroll
            for (int j = 0; j < 4; ++j) { *(f32x4*)(X + (size_t)r * DM + 4 * F.lane + 256 * j) = v[j]; h[j] = v[j] * rstd * c.a[j] + c.b[j]; }
            store_xn(XN + (size_t)r * DM, h, F.lane);
        }
    }
}
template <int NC> DI void rs_table(Frame& F, const bf16_t* src, LAS float* tab) {
    constexpr int LPR = NC / 8, RPI = 64 / LPR, NI = 32 / RPI;
    const int lane = F.lane, sub = lane / LPR, cl = lane % LPR;
    u32x4 v[NI];
#pragma unroll
    for (int j = 0; j < NI; ++j) v[j] = *(const u32x4*)(src + (size_t)(32 * F.wave + RPI * j + sub) * NPROJ + 8 * cl);
#pragma unroll
    for (int j = 0; j < NI; ++j) { float s = 0.f;
#pragma unroll
        for (int p = 0; p < 4; ++p) { const float x0 = bflo(v[j][p]), x1 = bfhi(v[j][p]); s = __builtin_fmaf(x0, x0, s); s = __builtin_fmaf(x1, x1, s); }
#pragma unroll
        for (int o = 1; o < LPR; o <<= 1) s += shx(s, o, lane);
        if (cl == 0) tab[32 * F.wave + RPI * j + sub] = 1.0f / sqrtf(s * (1.0f / NC) + NORM_EPS); }
}
DI void p_post1(Frame& F, ArgsP a, int l) {
    const bf16_t* PROJ = (const bf16_t*)(F.ws + opq(WS_PROJ));
    bf16_t* KR = (bf16_t*)(F.ws + opq(WS_KR));
    bf16_t* DK = (bf16_t*)(F.ws + opq(WS_DK)); bf16_t* IK = (bf16_t*)(F.ws + opq(WS_IK)); float* IW = (float*)(F.ws + opq(WS_IW));
    const float* C32 = (const float*)(F.ws + opq(WS_ROPE32)); const float* S32 = C32 + (size_t)T * 32;
    const float* C16 = (const float*)(F.ws + opq(WS_ROPE16)); const float* S16 = C16 + (size_t)T * 16;
    const int lane = F.lane;
    float kmx0 = 0.f, kmx1 = 0.f;
    const int hd = lane >> 4, i2 = 2 * (lane & 15), i1 = lane & 15; const bool second = lane >= 16;
    constexpr int RB = 8;
    for (int r0 = F.gw; r0 < T; r0 += RB * F.NGW) {
        unsigned w1[RB], w2[RB]; f32x2 cs[RB], sn[RB]; float x1[RB], x2[RB], c16[RB], s16[RB], iw[RB];
#pragma unroll
        for (int j = 0; j < RB; ++j) { const int r = r0 + j * F.NGW; const float z0 = zero_op();
            w1[j] = 0u; w2[j] = 0u; cs[j] = (f32x2){z0, z0}; sn[j] = (f32x2){z0, z0}; x1[j] = z0; x2[j] = z0; c16[j] = z0; s16[j] = z0; iw[j] = z0;
            if (r < T) { const bf16_t* p = PROJ + (size_t)r * NPROJ;
                { const bf16_t* q = p + C_DK + hd * 64; w1[j] = *(const unsigned*)(q + i2); w2[j] = *(const unsigned*)(q + 32 + i2); }
                cs[j] = *(const f32x2*)(C32 + (size_t)r * 32 + i2); sn[j] = *(const f32x2*)(S32 + (size_t)r * 32 + i2);
                if (lane < 32) { const bf16_t* q = p + (second ? C_IK : C_KR); x1[j] = bf2f(q[i1]); x2[j] = bf2f(q[i1 + 16]); c16[j] = C16[(size_t)r * 16 + i1]; s16[j] = S16[(size_t)r * 16 + i1]; }
                if (lane < 8) iw[j] = bf2f(p[C_IW + lane]); } }
#pragma unroll
        for (int j = 0; j < RB; ++j) { const int r = r0 + j * F.NGW;
            if (r < T) {
            { const float a0 = bflo(w1[j]), a1 = bfhi(w1[j]), b0 = bflo(w2[j]), b1 = bfhi(w2[j]);
              bf16_t* o = DK + (size_t)r * 256 + hd * 64;
              *(unsigned*)(o + i2) = pk2(a0 * cs[j].x - b0 * sn[j].x, a1 * cs[j].y - b1 * sn[j].y); *(unsigned*)(o + 32 + i2) = pk2(b0 * cs[j].x + a0 * sn[j].x, b1 * cs[j].y + a1 * sn[j].y); }
            float kn2 = 0.f;
            if (lane < 32) { bf16_t* o = (second ? IK : KR) + (size_t)r * 32; o[i1] = (bf16_t)f2bf(x1[j] * c16[j] - x2[j] * s16[j]); o[i1 + 16] = (bf16_t)f2bf(x2[j] * c16[j] + x1[j] * s16[j]);
              kn2 = second ? (x1[j] * x1[j] + x2[j] * x2[j]) : 0.f; }
            kn2 = wave_sum(kn2, lane);
            if (r < SEQ) kmx0 = fmaxf(kmx0, kn2); else kmx1 = fmaxf(kmx1, kn2);
            if (lane < 8) IW[(size_t)r * 8 + lane] = iw[j] * 0.0625f;
            } }
    }
    if (lane == 0) { F.MISC[32 + F.wave] = __builtin_bit_cast(unsigned, kmx0); F.MISC[40 + F.wave] = __builtin_bit_cast(unsigned, kmx1); }
    __syncthreads();
    if (F.tid < 2) { unsigned m = 0u; for (int w = 0; w < NWAVES; ++w) { const unsigned v = F.MISC[32 + 8 * F.tid + w]; m = v > m ? v : m; }
        atomicMax((unsigned*)(F.ctl + CW_KMAX + 64 * (l * 2 + F.tid)), m); }
}
namespace pg8 {
struct EpiStore {
    static constexpr bool PERM = true;
    DI void prefetch(const Unit&, int) const {}
    bf16_t* O; int ld;
    DI void operator()(const f32x4 (&acc)[2][2][4][2], const Unit& u, int wr, int wc, int fr, int fq) const {
        const int row0 = u.pm * BM + wr * 64 + fr, col0 = u.pn * BM + wc * 32 + 8 * fq;
#pragma unroll
        for (int ai = 0; ai < 2; ++ai)
#pragma unroll
            for (int m = 0; m < 4; ++m) { bf16_t* rowp = O + (size_t)(row0 + ai * HALF + m * 16) * ld + col0;
#pragma unroll
                for (int bj = 0; bj < 2; ++bj) { const f32x4 v0 = acc[ai][bj][m][0], v1 = acc[ai][bj][m][1];
                    u32x4 w; w.x = cvt_pk_bf16(v0[0], v0[1]); w.y = cvt_pk_bf16(v0[2], v0[3]); w.z = cvt_pk_bf16(v1[0], v1[1]); w.w = cvt_pk_bf16(v1[2], v1[3]);
                    *(u32x4*)(rowp + bj * HALF) = w; } }
    }
};
struct EpiStoreRS {
    static constexpr bool PERM = true;
    DI void prefetch(const Unit&, int) const {}
    bf16_t* O; int ld; LAS const float* rs;
    DI void operator()(const f32x4 (&acc)[2][2][4][2], const Unit& u, int wr, int wc, int fr, int fq) const {
        const int row0 = u.pm * BM + wr * 64 + fr, col0 = u.pn * BM + wc * 32 + 8 * fq;
#pragma unroll
        for (int ai = 0; ai < 2; ++ai)
#pragma unroll
            for (int m = 0; m < 4; ++m) { bf16_t* rowp = O + (size_t)(row0 + ai * HALF + m * 16) * ld + col0; const float s = rs[wr * 64 + fr + ai * HALF + m * 16];
#pragma unroll
                for (int bj = 0; bj < 2; ++bj) { const f32x4 v0 = acc[ai][bj][m][0] * s, v1 = acc[ai][bj][m][1] * s;
                    u32x4 w; w.x = cvt_pk_bf16(v0[0], v0[1]); w.y = cvt_pk_bf16(v0[2], v0[3]); w.z = cvt_pk_bf16(v1[0], v1[1]); w.w = cvt_pk_bf16(v1[2], v1[3]);
                    *(u32x4*)(rowp + bj * HALF) = w; } }
    }
};
struct EpiBranch {
    static constexpr bool PERM = true;
    DI void prefetch(const Unit&, int) const {}
    bf16_t* MRG; const bf16_t* PROJ; int gate0; int first;
    DI void operator()(const f32x4 (&acc)[2][2][4][2], const Unit& u, int wr, int wc, int fr, int fq) const {
        const int row0 = u.pm * BM + wr * 64 + fr, col0 = u.pn * BM + wc * 32 + 8 * fq;
#pragma unroll
        for (int ai = 0; ai < 2; ++ai) {
                u32x4 gl[4][2], pv[4][2];
#pragma unroll
                for (int m = 0; m < 4; ++m) { const size_t row = (size_t)(row0 + ai * HALF + m * 16);
#pragma unroll
                    for (int bj = 0; bj < 2; ++bj) { gl[m][bj] = *(const u32x4*)(PROJ + row * NPROJ + gate0 + col0 + bj * HALF);
                        if (!first) pv[m][bj] = *(const u32x4*)(MRG + row * DM + col0 + bj * HALF); else pv[m][bj] = (u32x4){0u, 0u, 0u, 0u}; } }
                __builtin_amdgcn_sched_barrier(0);
#pragma unroll
                for (int m = 0; m < 4; ++m) { const size_t row = (size_t)(row0 + ai * HALF + m * 16);
#pragma unroll
                    for (int bj = 0; bj < 2; ++bj) { const f32x4 v0 = acc[ai][bj][m][0], v1 = acc[ai][bj][m][1]; const u32x4 g_ = gl[m][bj], p_ = pv[m][bj];
                        bf16_t* mp_ = MRG + row * DM + col0 + bj * HALF;
                        float o[8];
                        o[0] = fast_sigmoid(bflo(g_.x)) * v0[0]; o[1] = fast_sigmoid(bfhi(g_.x)) * v0[1]; o[2] = fast_sigmoid(bflo(g_.y)) * v0[2]; o[3] = fast_sigmoid(bfhi(g_.y)) * v0[3];
                        o[4] = fast_sigmoid(bflo(g_.z)) * v1[0]; o[5] = fast_sigmoid(bfhi(g_.z)) * v1[1]; o[6] = fast_sigmoid(bflo(g_.w)) * v1[2]; o[7] = fast_sigmoid(bfhi(g_.w)) * v1[3];
                        if (!first) { o[0] += bflo(p_.x); o[1] += bfhi(p_.x); o[2] += bflo(p_.y); o[3] += bfhi(p_.y); o[4] += bflo(p_.z); o[5] += bfhi(p_.z); o[6] += bflo(p_.w); o[7] += bfhi(p_.w); }
                        u32x4 w; w.x = cvt_pk_bf16(o[0], o[1]); w.y = cvt_pk_bf16(o[2], o[3]); w.z = cvt_pk_bf16(o[4], o[5]); w.w = cvt_pk_bf16(o[6], o[7]);
                        *(u32x4*)mp_ = w; } }
            }
    }
};
struct EpiResid {
    static constexpr bool PERM = false;
    DI void prefetch(const Unit&, int) const {}
    float* X; const float* gvec; size_t dofs;
    DI void operator()(const f32x4 (&acc)[2][2][4][2], const Unit& u, int wr, int wc, int fr, int fq) const {
        const int row0 = u.pm * BM + wr * 64 + fr, col0 = u.pn * BM + wc * 32 + 4 * fq; const float* g = gvec + (size_t)((u.pm * BM) / SEQ) * 6 * DM;
#pragma unroll
        for (int bj = 0; bj < 2; ++bj) { f32x4 gv[2];
#pragma unroll
            for (int n = 0; n < 2; ++n) gv[n] = *(const f32x4*)(g + col0 + bj * HALF + n * 16);
            f32x4 xv[2][4][2];
#pragma unroll
            for (int ai = 0; ai < 2; ++ai)
#pragma unroll
                for (int m = 0; m < 4; ++m)
#pragma unroll
                    for (int n = 0; n < 2; ++n) xv[ai][m][n] = *(const f32x4*)(X + (size_t)(row0 + ai * HALF + m * 16) * DM + col0 + bj * HALF + n * 16);
            __builtin_amdgcn_sched_barrier(0);
#pragma unroll
            for (int ai = 0; ai < 2; ++ai)
#pragma unroll
                for (int m = 0; m < 4; ++m)
#pragma unroll
                    for (int n = 0; n < 2; ++n) { float* xp = X + (size_t)(row0 + ai * HALF + m * 16) * DM + col0 + bj * HALF + n * 16;
                        *(f32x4*)((char*)xp + dofs) = xv[ai][m][n] + gv[n] * acc[ai][bj][m][n]; } }
    }
};
struct MoeTab { LAS const int* cnt; LAS const int* tpre; LAS const int* off; LAS const int* xe; LAS const int* xt; };
template <bool GATHER, int NCOLT> struct MoeSched {
    const bf16_t* A; const bf16_t* Bt; const int* list; MoeTab tb; int K, G, c; LAS unsigned* ltab;
    DI bool next(int i, Unit& u) const {
        const int GX = G >> 3, x = c & 7, j = c >> 3; if (j >= GX) return false;
        LAS const int* xt = tb.xt + x * 5;
        const int L = i * GX + j; if (L >= __builtin_amdgcn_readfirstlane(xt[4]) * NCOLT) return false;
        const int tile = L / NCOLT; u.pn = L % NCOLT; int k = 0; while (__builtin_amdgcn_readfirstlane(xt[k + 1]) <= tile) ++k;
        const int e = __builtin_amdgcn_readfirstlane(tb.xe[x * 4 + k]), tp = __builtin_amdgcn_readfirstlane(xt[k]);
        const int of = __builtin_amdgcn_readfirstlane(tb.off[e]), cn = __builtin_amdgcn_readfirstlane(tb.cnt[e]);
        u.e = e; u.pm = (tile - tp) * BM; u.row0 = of + u.pm; const int left = cn - u.pm; u.nrows = left < BM ? left : BM; return true;
    }
    DI const char* abase(const Unit& u) const { return GATHER ? (const char*)A : (const char*)A + (size_t)u.row0 * K * 2; }
    DI const char* bbase(const Unit& u) const { return (const char*)Bt + ((size_t)u.e * NCOLT * BM + (size_t)u.pn * BM) * K * 2; }
    DI void aoffs(const Unit& u, int R, int C, unsigned (&v)[4]) const {
#pragma unroll
        for (int m = 0; m < 4; ++m) { int rr = R + 64 * m;
            if (GATHER) { rr = rr < u.nrows ? rr : 0; rr = list[u.e * ECAP + u.pm + rr]; }
            v[m] = (unsigned)(rr * K + C) * 2u; }
    }
    DI void prefetch(const Unit& u, int tid, int par) const {
        if (GATHER) { if (tid < 256) { const int rr = tid < u.nrows ? tid : 0;
            __builtin_amdgcn_global_load_lds((const unsigned*)(list + u.e * ECAP + u.pm + rr), (LAS unsigned*)(ltab + par * 256 + (tid & ~63)), 4, 0, 0); } }
    }
    DI void aoffs_next(const Unit& u, int R, int C, unsigned (&v)[4], int par) const {
        if (GATHER) {
#pragma unroll
            for (int m = 0; m < 4; ++m) v[m] = (unsigned)((int)ltab[par * 256 + R + 64 * m] * K + C) * 2u;
        } else aoffs(u, R, C, v);
    }
};
struct EpiSwiglu {
    static constexpr bool PERM = true;
    bf16_t* ACT; const float* bgu; LAS float* etab;
    DI void prefetch(const Unit& u, int tid) const {
        if (tid < 64) { const float* bg = bgu + (size_t)u.e * 2048 + u.pn * 128 + (tid < 32 ? 4 * tid : 1024 + 4 * (tid - 32));
            __builtin_amdgcn_global_load_lds((const unsigned*)bg, (LAS unsigned*)(etab + u.par * 256), 16, 0, 0); }
    }
    DI void operator()(const f32x4 (&acc)[2][2][4][2], const Unit& u, int wr, int wc, int fr, int fq) const {
        const int r0 = wr * 64 + fr, c0 = u.pn * BM + wc * 32 + 8 * fq; LAS const float* tb_ = etab + u.par * 256;
        f32x4 bgate[2], bup[2];
#pragma unroll
        for (int bj = 0; bj < 2; ++bj) { const int jj = wc * 16 + 4 * fq + bj * 64; bgate[bj] = *(LAS const f32x4*)(tb_ + jj); bup[bj] = *(LAS const f32x4*)(tb_ + 128 + jj); }
#pragma unroll
        for (int bj = 0; bj < 2; ++bj) { const int j0 = (c0 + bj * HALF) >> 1;
#pragma unroll
            for (int ai = 0; ai < 2; ++ai)
#pragma unroll
                for (int m = 0; m < 4; ++m) { const int r = r0 + ai * HALF + m * 16; const f32x4 v0 = acc[ai][bj][m][0], v1 = acc[ai][bj][m][1];
                    float g[4] = {v0[0] + bgate[bj][0], v0[2] + bgate[bj][1], v1[0] + bgate[bj][2], v1[2] + bgate[bj][3]};
                    float p[4] = {v0[1] + bup[bj][0], v0[3] + bup[bj][1], v1[1] + bup[bj][2], v1[3] + bup[bj][3]};
                    float o[4];
#pragma unroll
                    for (int k = 0; k < 4; ++k) { const float gg = fminf(g[k], 7.0f), uu = fminf(fmaxf(p[k], -7.0f), 7.0f); o[k] = (uu + 1.0f) * (gg * fast_sigmoid(1.702f * gg)); }
                    if (r < u.nrows) { u32x2 w; w.x = cvt_pk_bf16(o[0], o[1]); w.y = cvt_pk_bf16(o[2], o[3]); *(u32x2*)(ACT + (size_t)(u.row0 + r) * DM + j0) = w; } } }
    }
};
struct EpiDown {
    static constexpr bool PERM = true;
    bf16_t* EOUT; const float* bdn; const float* listw; LAS float* etab;
    DI void prefetch(const Unit& u, int tid) const {
        if (tid < 128) { const float* src = tid < 64 ? bdn + (size_t)u.e * DM + u.pn * BM + 4 * tid : listw + (size_t)u.e * ECAP + u.pm + 4 * (tid - 64);
            __builtin_amdgcn_global_load_lds((const unsigned*)src, (LAS unsigned*)(etab + u.par * 512 + (tid & 64) * 4), 16, 0, 0); }
    }
    DI void operator()(const f32x4 (&acc)[2][2][4][2], const Unit& u, int wr, int wc, int fr, int fq) const {
        const int r0 = wr * 64 + fr, c0 = u.pn * BM + wc * 32 + 8 * fq; LAS const float* tb_ = etab + u.par * 512;
        f32x4 b0[2], b1[2]; float cw[2][4];
#pragma unroll
        for (int bj = 0; bj < 2; ++bj) { const int cc = wc * 32 + 8 * fq + bj * HALF; b0[bj] = *(LAS const f32x4*)(tb_ + cc); b1[bj] = *(LAS const f32x4*)(tb_ + cc + 4); }
#pragma unroll
        for (int ai = 0; ai < 2; ++ai)
#pragma unroll
            for (int m = 0; m < 4; ++m) cw[ai][m] = tb_[256 + r0 + ai * HALF + m * 16];
#pragma unroll
        for (int ai = 0; ai < 2; ++ai)
#pragma unroll
            for (int m = 0; m < 4; ++m) { const int r = r0 + ai * HALF + m * 16;
                if (r < u.nrows) {
#pragma unroll
                    for (int bj = 0; bj < 2; ++bj) {
                        const f32x4 v0 = (acc[ai][bj][m][0] + b0[bj]) * cw[ai][m], v1 = (acc[ai][bj][m][1] + b1[bj]) * cw[ai][m];
                        u32x4 w; w.x = cvt_pk_bf16(v0[0], v0[1]); w.y = cvt_pk_bf16(v0[2], v0[3]); w.z = cvt_pk_bf16(v1[0], v1[1]); w.w = cvt_pk_bf16(v1[2], v1[3]);
                        *(u32x4*)(EOUT + (size_t)(u.row0 + r) * DM + c0 + bj * HALF) = w; } } }
    }
};
}

DI pg8::MoeTab moe_tables_again(Frame& F) {
    pg8::MoeTab tb; tb.cnt = (LAS int*)(F.MISC + 64); tb.tpre = (LAS int*)(F.MISC + 100); tb.off = (LAS int*)(F.MISC + 140); tb.xe = (LAS int*)(F.MISC + 176); tb.xt = (LAS int*)(F.MISC + 208);
    __syncthreads();
    return tb;
}
DI pg8::MoeTab moe_tables(Frame& F, int l) {
    LAS int* cnt = (LAS int*)(F.MISC + 64); LAS int* tpre = (LAS int*)(F.MISC + 100); LAS int* off = (LAS int*)(F.MISC + 140);
    LAS int* xe = (LAS int*)(F.MISC + 176); LAS int* xt = (LAS int*)(F.MISC + 208);
    __syncthreads();
    if (F.tid < NEXP) cnt[F.tid] = (int)__hip_atomic_load(F.ctl + CW_CNT + l * NEXP + F.tid, RLX_AGENT);
    __syncthreads();
    if (F.tid == 0) { int tp = 0, so = 0; for (int e = 0; e < NEXP; ++e) { tpre[e] = tp; off[e] = so; tp += (cnt[e] + 255) >> 8; so += cnt[e]; } tpre[NEXP] = tp; off[NEXP] = so; }
    if (F.tid >= 64 && F.tid < 64 + NEXP) {
        const int e = F.tid - 64, tl = (cnt[e] + 255) >> 8; int r = 0;
        for (int o = 0; o < NEXP; ++o) { const int to = (cnt[o] + 255) >> 8; r += (to > tl || (to == tl && o < e)) ? 1 : 0; }
        const int grp = r >> 3, pos = r & 7, x = (grp & 1) ? 7 - pos : pos; xe[x * 4 + grp] = e; }
    __syncthreads();
    if (F.tid < 8) { int s = 0; for (int k = 0; k < 4; ++k) { xt[F.tid * 5 + k] = s; s += (cnt[xe[F.tid * 4 + k]] + 255) >> 8; } xt[F.tid * 5 + 4] = s; }
    __syncthreads();
    pg8::MoeTab tb; tb.cnt = cnt; tb.tpre = tpre; tb.off = off; tb.xe = xe; tb.xt = xt; return tb;
}
DI unsigned f_sortable(float f) { const unsigned b = __builtin_bit_cast(unsigned, f); return b ^ ((b >> 31) ? 0xFFFFFFFFu : 0x80000000u); }
DI void p_norm2_router(Frame& F, ArgsP a, int l, size_t dofs = 0, int cslot = -1) {
    if (cslot < 0) cslot = l;
    LAS float* WT = (LAS float*)(F.lds + RING_OFF);
    { const float* rw = ((const float*)a->router_w) + (size_t)l * DM * NEXP;
#pragma unroll
      for (int ch = 0; ch < 2; ++ch) { const int k = 128 * F.wave + 64 * ch + F.lane; f32x4 w[8];
#pragma unroll
          for (int e4 = 0; e4 < 8; ++e4) w[e4] = *(const f32x4*)(rw + (size_t)k * NEXP + 4 * e4);
#pragma unroll
          for (int e4 = 0; e4 < 8; ++e4) { WT[(4 * e4 + 0) * DM + k] = w[e4].x; WT[(4 * e4 + 1) * DM + k] = w[e4].y; WT[(4 * e4 + 2) * DM + k] = w[e4].z; WT[(4 * e4 + 3) * DM + k] = w[e4].w; } } }
    __syncthreads();
    const float* MOD = (const float*)(F.ws + opq(WS_MOD)); const float* X = (const float*)(F.ws + opq(WS_X)); bf16_t* XN = (bf16_t*)(F.ws + opq(WS_XN) + dofs);
    int* LIST = (int*)(F.ws + opq(WS_LIST) + dofs); float* LISTW = (float*)(F.ws + opq(WS_LISTW) + dofs); int* TOKE = (int*)(F.ws + opq(WS_TOKE) + dofs);
    volatile LAS unsigned* RENT = (volatile LAS unsigned*)(F.lds + MISC_OFF + 1024);
    if (F.tid < NEXP) F.MISC[64 + F.tid] = 0u;
    const int lane = F.lane; const int e_mine = lane >> 1;
    const float rb = ((const float*)a->router_b)[l * NEXP + e_mine];
    constexpr int RPW = 8;
    const int rstride = F.NGW * RPW, riters = (T + rstride - 1) / rstride;
    for (int rit = 0; rit < riters; ++rit) {
        const int r0 = F.gw * RPW + rit * rstride; const bool ract = r0 < T;
        if (ract) {
        const int b = r0 / SEQ; const float* mod = MOD + (size_t)(l * 2 + b) * 6 * DM;
        RowCoef c; load_coef(c, ((const float*)a->norm_ffn_g) + l * DM, mod + 3 * DM, mod + 4 * DM, lane);
        f32x4 nx[4];
#pragma unroll
        for (int j = 0; j < 4; ++j) nx[j] = *(const f32x4*)(X + (size_t)r0 * DM + 4 * lane + 256 * j);
        for (int r = r0; r < r0 + RPW; ++r) {
            f32x4 h[4];
#pragma unroll
            for (int j = 0; j < 4; ++j) h[j] = nx[j];
            if (r + 1 < r0 + RPW) {
#pragma unroll
                for (int j = 0; j < 4; ++j) nx[j] = *(const f32x4*)(X + (size_t)(r + 1) * DM + 4 * lane + 256 * j); }
            const float rstd = row_rstd(h, lane);
#pragma unroll
            for (int j = 0; j < 4; ++j) h[j] = h[j] * rstd * c.a[j] + c.b[j];
            store_xn(XN + (size_t)r * DM, h, lane);
            float v[32];
#pragma unroll
            for (int e = 0; e < 32; ++e) { float s = 0.f;
#pragma unroll
                for (int j = 0; j < 4; ++j) { const f32x4 w = *(const LAS f32x4*)(WT + e * DM + 4 * lane + 256 * j); s += (h[j].x * w.x + h[j].y * w.y) + (h[j].z * w.z + h[j].w * w.w); }
                v[e] = s; if ((e & 3) == 3) __builtin_amdgcn_sched_barrier(0); }
            float a16[16], a8[8], a4[4], a2[2], a1;
            { const bool up = lane & 32;
#pragma unroll
              for (int i = 0; i < 16; ++i) { const float keep = up ? v[16 + i] : v[i], send = up ? v[i] : v[16 + i]; a16[i] = keep + shx(send, 32, lane); } }
            { const bool up = lane & 16;
#pragma unroll
              for (int i = 0; i < 8; ++i) { const float keep = up ? a16[8 + i] : a16[i], send = up ? a16[i] : a16[8 + i]; a8[i] = keep + shx(send, 16, lane); } }
            { const bool up = lane & 8;
#pragma unroll
              for (int i = 0; i < 4; ++i) { const float keep = up ? a8[4 + i] : a8[i], send = up ? a8[i] : a8[4 + i]; a4[i] = keep + shx(send, 8, lane); } }
            { const bool up = lane & 4;
#pragma unroll
              for (int i = 0; i < 2; ++i) { const float keep = up ? a4[2 + i] : a4[i], send = up ? a4[i] : a4[2 + i]; a2[i] = keep + shx(send, 4, lane); } }
            { const bool up = lane & 2; const float keep = up ? a2[1] : a2[0], send = up ? a2[0] : a2[1]; a1 = keep + shx(send, 2, lane); }
            a1 += shx(a1, 1, lane);
            const float logit = a1 + rb;
            unsigned long long key = ((unsigned long long)f_sortable(logit) << 32) | (unsigned)(31 - e_mine);
            int te[4]; float tv[4];
#pragma unroll
            for (int k = 0; k < 4; ++k) {
                unsigned long long m = key;
#pragma unroll
                for (int o = 1; o < 64; o <<= 1) { const unsigned long long t = shx64(m, o, lane); m = t > m ? t : m; }
                te[k] = 31 - (int)(unsigned)(m & 0xFFFFFFFFull); tv[k] = shl(logit, 2 * te[k]);
                if (e_mine == te[k]) key = 0ull;
            }
            const float e1 = __expf(tv[1] - tv[0]), e2 = __expf(tv[2] - tv[0]), e3 = __expf(tv[3] - tv[0]); const float inv = 1.0f / (1.0f + e1 + e2 + e3);
            if (lane < 4) {
                const int ek = lane == 0 ? te[0] : lane == 1 ? te[1] : lane == 2 ? te[2] : te[3];
                const float wk = (lane == 0 ? 1.0f : lane == 1 ? e1 : lane == 2 ? e2 : e3) * inv;
                const unsigned lr = __hip_atomic_fetch_add((LAS unsigned*)(F.MISC + 64 + ek), 1u, __ATOMIC_RELAXED, __HIP_MEMORY_SCOPE_WORKGROUP);
                RENT[((F.wave * RPW + (r - r0)) * 4 + lane) * 2] = (unsigned)ek | (lr << 8); RENT[((F.wave * RPW + (r - r0)) * 4 + lane) * 2 + 1] = __builtin_bit_cast(unsigned, wk);
            }
        }
        }
        __syncthreads();
        if (F.tid < NEXP) { const unsigned c = F.MISC[64 + F.tid]; F.MISC[96 + F.tid] = c ? __hip_atomic_fetch_add(F.ctl + CW_CNT + cslot * NEXP + F.tid, c, RLX_AGENT) : 0u; F.MISC[64 + F.tid] = 0u; }
        __syncthreads();
        if (ract && lane < 4 * RPW) { const int ri = lane >> 2, k = lane & 3, r = r0 + ri;
            const unsigned en = RENT[((F.wave * RPW + ri) * 4 + k) * 2]; const int ek = en & 0xff; const int rank = (int)(F.MISC[96 + ek] + (en >> 8));
            LIST[ek * ECAP + rank] = r; LISTW[ek * ECAP + rank] = __builtin_bit_cast(float, RENT[((F.wave * RPW + ri) * 4 + k) * 2 + 1]); TOKE[r * 4 + k] = ek | (rank << 8); }
        __syncthreads();
    }
}
DI void p_combine(Frame& F, ArgsP a, int l, const pg8::MoeTab& tb, size_t dofs = 0) {
    const float* MOD = (const float*)(F.ws + opq(WS_MOD)); const float* X = (const float*)(F.ws + opq(WS_X)); float* XO = (float*)(F.ws + opq(WS_X) + dofs); bf16_t* XN = (bf16_t*)(F.ws + opq(WS_XN) + dofs);
    const bf16_t* EOUT = (const bf16_t*)(F.ws + opq(WS_EOUT)); const int* TOKE = (const int*)(F.ws + opq(WS_TOKE));
    const int lane = F.lane; const bool lastl = (l == DEPTH - 1);
    constexpr int RPW = 8;
    for (int r0 = F.gw * RPW; r0 < T; r0 += F.NGW * RPW) {
        const int b = r0 / SEQ; const float* mod = MOD + (size_t)(l * 2 + b) * 6 * DM;
        f32x4 gf[4];
#pragma unroll
        for (int j = 0; j < 4; ++j) gf[j] = *(const f32x4*)(mod + 5 * DM + 4 * lane + 256 * j);
        RowCoef c;
        if (!lastl) { const float* modn = MOD + (size_t)((l + 1) * 2 + b) * 6 * DM; load_coef(c, ((const float*)a->norm_mix_g) + (l + 1) * DM, modn + 0 * DM, modn + 1 * DM, lane); }
        else {
#pragma unroll
            for (int j = 0; j < 4; ++j) { c.a[j] = *(const f32x4*)(((const float*)a->final_g) + 4 * lane + 256 * j); const float z0 = zero_op(); c.b[j] = (f32x4){z0, z0, z0, z0}; } }
        int myslot = 0;
        if (lane < 4 * RPW) { const int te = TOKE[(size_t)r0 * 4 + lane]; myslot = tb.off[te & 0xff] + (te >> 8); }
        u32x2 ne[4][4]; f32x4 nx[4];
#define CB_LOAD(r_) do { _Pragma("unroll") for (int k = 0; k < 4; ++k) { const int slot = __builtin_amdgcn_readlane(myslot, 4 * ((r_) - r0) + k); const bf16_t* ep = EOUT + (size_t)slot * DM; \
            _Pragma("unroll") for (int j = 0; j < 4; ++j) ne[k][j] = *(const u32x2*)(ep + 4 * lane + 256 * j); } \
            _Pragma("unroll") for (int j = 0; j < 4; ++j) nx[j] = *(const f32x4*)(X + (size_t)(r_) * DM + 4 * lane + 256 * j); } while (0)
        f32x4 v[4]; u32x2 ce[4][4];
#pragma unroll 1
        for (int r = r0; r < r0 + RPW; ++r) {
            if (r == r0) {
#pragma unroll
                for (int ri = 0; ri < 1; ++ri) CB_LOAD(r0); }
#pragma unroll
            for (int k = 0; k < 4; ++k)
#pragma unroll
                for (int j = 0; j < 4; ++j) ce[k][j] = ne[k][j];
#pragma unroll
            for (int j = 0; j < 4; ++j) v[j] = nx[j];
            if (r + 1 < r0 + RPW) CB_LOAD(r + 1);
            f32x4 y[4];
#pragma unroll
            for (int j = 0; j < 4; ++j) { const float z0 = zero_op(); y[j] = (f32x4){z0, z0, z0, z0}; }
#ifndef DBG_SKIP_MOE
#pragma unroll
            for (int k = 0; k < 4; ++k)
#pragma unroll
                for (int j = 0; j < 4; ++j) { const u32x2 w = ce[k][j]; y[j].x += bflo(w.x); y[j].y += bfhi(w.x); y[j].z += bflo(w.y); y[j].w += bfhi(w.y); }
#endif
#pragma unroll
            for (int j = 0; j < 4; ++j) v[j] = v[j] + gf[j] * y[j];
            const float rstd = row_rstd(v, lane);
            f32x4 h[4];
#pragma unroll
            for (int j = 0; j < 4; ++j) h[j] = v[j] * rstd * c.a[j] + c.b[j];
            if (!lastl) {
#pragma unroll
                for (int j = 0; j < 4; ++j) *(f32x4*)(XO + (size_t)r * DM + 4 * lane + 256 * j) = v[j];
                store_xn(XN + (size_t)r * DM, h, lane);
            } else {
#pragma unroll
                for (int j = 0; j < 4; ++j) *(f32x4*)((dofs ? XO : (float*)a->out) + (size_t)r * DM + 4 * lane + 256 * j) = h[j];
            }
        }
    }
}
DI f32x16 mfma32(bf16x8 a, bf16x8 b, f32x16 c) { return __builtin_amdgcn_mfma_f32_32x32x16_bf16(a, b, c, 0, 0, 0); }
typedef short v4i16_t __attribute__((ext_vector_type(4)));
DI s16x4 tr_read(LAS const unsigned char* p) { return __builtin_bit_cast(s16x4, __builtin_amdgcn_ds_read_tr16_b64_v4i16((LAS v4i16_t*)p)); }
DI int crow(int reg, int h) { return (reg & 3) + 8 * (reg >> 2) + 4 * h; }
template <int S> DI bf16x8 pack8(const f32x16& x) {
    u32x4 p; p.x = cvt_pk_bf16(x[8 * S + 0], x[8 * S + 1]); p.y = cvt_pk_bf16(x[8 * S + 2], x[8 * S + 3]); p.z = cvt_pk_bf16(x[8 * S + 4], x[8 * S + 5]); p.w = cvt_pk_bf16(x[8 * S + 6], x[8 * S + 7]);
    return __builtin_bit_cast(bf16x8, p);
}
DI bf16x8 scale8(bf16x8 v, float s) {
    u32x4 w = __builtin_bit_cast(u32x4, v); u32x4 o;
    o.x = pk2(bflo(w.x) * s, bfhi(w.x) * s); o.y = pk2(bflo(w.y) * s, bfhi(w.y) * s); o.z = pk2(bflo(w.z) * s, bfhi(w.z) * s); o.w = pk2(bflo(w.w) * s, bfhi(w.w) * s);
    return __builtin_bit_cast(bf16x8, o);
}
struct Rope8 { float c[8], d[8]; };
DI void rope_load(Rope8& r, const float* cs, const float* sn) {
    const f32x4 c0 = *(const f32x4*)cs, c1 = *(const f32x4*)(cs + 4), s0 = *(const f32x4*)sn, s1 = *(const f32x4*)(sn + 4);
#pragma unroll
    for (int j = 0; j < 4; ++j) { r.c[j] = c0[j]; r.c[4 + j] = c1[j]; r.d[j] = s0[j]; r.d[4 + j] = s1[j]; }
}
DI void rope_apply(bf16x8& a, bf16x8& b, const Rope8& r, float s) {
    const u32x4 wa = __builtin_bit_cast(u32x4, a), wb = __builtin_bit_cast(u32x4, b); u32x4 oa, ob;
#pragma unroll
    for (int p = 0; p < 4; ++p) { const float a0 = bflo(wa[p]), a1 = bfhi(wa[p]), b0 = bflo(wb[p]), b1 = bfhi(wb[p]);
        oa[p] = pk2((a0 * r.c[2 * p] - b0 * r.d[2 * p]) * s, (a1 * r.c[2 * p + 1] - b1 * r.d[2 * p + 1]) * s);
        ob[p] = pk2((b0 * r.c[2 * p] + a0 * r.d[2 * p]) * s, (b1 * r.c[2 * p + 1] + a1 * r.d[2 * p + 1]) * s); }
    asm volatile("" : "+v"(oa), "+v"(ob));
    a = __builtin_bit_cast(bf16x8, oa); b = __builtin_bit_cast(bf16x8, ob);
}
DI void rope8(bf16x8& a, bf16x8& b, const float* cs, const float* sn, float s) { Rope8 r; rope_load(r, cs, sn); rope_apply(a, b, r, s); }
template <int KB2, int PST = 4096> DI void pv_block(f32x16 (&o)[2], const f32x16& p, LAS const unsigned char* vs, int lane) {
    const int hi = lane >> 5, i16 = lane & 15, q4 = i16 >> 2, p4 = i16 & 3, blk = (lane >> 4) & 1;
    const bf16x8 pb0 = pack8<0>(p), pb1 = pack8<1>(p);
    LAS const unsigned char* base = vs + (32 * KB2 + 4 * hi + q4) * 64 + (16 * blk + 4 * p4) * 2;
#pragma unroll
    for (int dh = 0; dh < 2; ++dh) {
        const s16x4 l0 = tr_read(base + dh * PST), h0 = tr_read(base + dh * PST + 8 * 64), l1 = tr_read(base + dh * PST + 16 * 64), h1 = tr_read(base + dh * PST + 24 * 64);
        const bf16x8 v0 = __builtin_shufflevector(l0, h0, 0, 1, 2, 3, 4, 5, 6, 7), v1 = __builtin_shufflevector(l1, h1, 0, 1, 2, 3, 4, 5, 6, 7);
        o[dh] = mfma32(v0, pb0, o[dh]); o[dh] = mfma32(v1, pb1, o[dh]);
    }
}
DI void store_ot(bf16_t* orow, const f32x16 (&o)[2], float sc, int hi) {
#pragma unroll
    for (int dh = 0; dh < 2; ++dh)
#pragma unroll
        for (int g = 0; g < 4; ++g) { u32x2 w; w.x = pk2(o[dh][4 * g] * sc, o[dh][4 * g + 1] * sc); w.y = pk2(o[dh][4 * g + 2] * sc, o[dh][4 * g + 3] * sc);
            *(u32x2*)(orow + 32 * dh + 8 * g + 4 * hi) = w; }
}
DI float max3f(float a, float b, float c) { float r; asm("v_max3_f32 %0, %1, %2, %3" : "=v"(r) : "v"(a), "v"(b), "v"(c)); return r; }
DI float rowmax32(const f32x16& A, const f32x16& B) {
    float m = max3f(A[0], B[0], A[1]), n = max3f(B[1], A[2], B[2]);
#pragma unroll
    for (int i = 3; i < 15; i += 2) { m = max3f(m, A[i], B[i]); n = max3f(n, A[i + 1], B[i + 1]); }
    return max3f(m, n, fmaxf(A[15], B[15]));
}
DI void raise_ref(f32x16& p0, f32x16& p1, f32x16 (&o)[2], f32x16& negm, float& m_ref, float& l_run, bool& init, float mx, int lane) {
    mx = fmaxf(mx, shx(mx, 32, lane)); const float dl = init ? fmaxf(mx, 0.f) : mx; init = true;
    m_ref += dl; const float alpha = __builtin_amdgcn_exp2f(-dl); l_run *= alpha;
#pragma unroll
    for (int i = 0; i < 16; ++i) { o[0][i] *= alpha; o[1][i] *= alpha; p0[i] -= dl; p1[i] -= dl; negm[i] = -m_ref; }
}
template <int BIT> DI float mask_bit(float e, unsigned word) {
    unsigned m; asm("v_bfe_i32 %0, %1, %2, 1" : "=v"(m) : "v"(word), "n"(BIT));
    return __builtin_bit_cast(float, __builtin_bit_cast(unsigned, e) & m);
}
constexpr int AT_KS = 13312, AT_K0 = 0, AT_V0 = 2 * AT_KS, AT_VS = 8192;

DI void mla_unit(Frame& F, int b, int h, int qb) {
    const bf16_t* QM = (const bf16_t*)(F.ws + opq(WS_QM)); const bf16_t* KVM = (const bf16_t*)(F.ws + opq(WS_KVM)); const bf16_t* KR = (const bf16_t*)(F.ws + opq(WS_KR)); bf16_t* OUT = (bf16_t*)(F.ws + opq(WS_OMLA));
    const float* C16 = (const float*)(F.ws + opq(WS_ROPE16)); const float* S16 = C16 + (size_t)T * 16;
    const int tid = F.tid, lane = F.lane, r32 = lane & 31, hi = lane >> 5, w = F.wave;
    const int qw = qb * 256 + 32 * w; const size_t row = (size_t)b * SEQ + qw + r32;
    constexpr float QS = 0.10206207261596577f * 1.4426950408889634f;
    bf16x8 qf[6];
    { const bf16_t* qp = QM + row * 768 + h * 96 + 8 * hi;
#pragma unroll
      for (int s = 0; s < 6; ++s) qf[s] = *(const bf16x8*)(qp + 16 * s);
#pragma unroll
      for (int s = 0; s < 4; ++s) qf[s] = scale8(qf[s], QS);
      rope8(qf[4], qf[5], C16 + row * 16 + 8 * hi, S16 + row * 16 + 8 * hi, QS); }
    const int NS = 2 * (qb + 1), cw = 4 * qb + (w >> 1);
    constexpr int MK = 4 * AT_KS;
    const int kr = tid >> 3, c8 = tid & 7, kr2 = (tid >> 2) & 63, c4 = tid & 3, rp = tid >> 8;
    const bf16_t* gk = KVM + ((size_t)b * SEQ + kr) * 768 + h * 128 + 8 * c8;
    const bf16_t* gr = KR + ((size_t)b * SEQ + rp * 64 + kr2) * 32 + 8 * c4;
    const int lk = kr * 208 + c8 * 16, lr = rp * AT_KS + kr2 * 208 + 128 + c4 * 16, lv = (c8 >> 2) * 4096 + kr * 64 + (c8 & 3) * 16;
    LAS unsigned char* L = F.lds + RING_OFF;
    u32x4 rkA, rvA, rkB, rvB, rr;
#define MLA_LOAD(s) do { const bf16_t* g_ = gk + (size_t)(s) * 128 * 768; rkA = *(const u32x4*)g_; rvA = *(const u32x4*)(g_ + 64); rkB = *(const u32x4*)(g_ + 64 * 768); rvB = *(const u32x4*)(g_ + 64 * 768 + 64); rr = *(const u32x4*)(gr + (size_t)(s) * 128 * 32); } while (0)
#define MLA_WRITE(bf) do { LAS unsigned char* k_ = L + (bf) * 2 * AT_KS; LAS unsigned char* v_ = L + MK + (bf) * 2 * AT_VS; *(LAS u32x4*)(k_ + lk) = rkA; *(LAS u32x4*)(v_ + lv) = rvA; *(LAS u32x4*)(k_ + AT_KS + lk) = rkB; *(LAS u32x4*)(v_ + AT_VS + lv) = rvB; *(LAS u32x4*)(k_ + lr) = rr; } while (0)
    MLA_LOAD(0); MLA_WRITE(0);
    __syncthreads();
    float m_ref = 0.f, l_run = 0.f; bool init = false; f32x16 o[2], negm; const float zz0 = zero_op();
#pragma unroll
    for (int i = 0; i < 16; ++i) { o[0][i] = zz0; o[1][i] = zz0; negm[i] = zz0; }
    for (int s = 0; s < NS; ++s) {
        const int bf = s & 1;
        if (s + 1 < NS) MLA_LOAD(s + 1);
#pragma unroll
        for (int u2 = 0; u2 < 2; ++u2) {
            if (2 * s + u2 <= cw) {
                f32x16 p0, p1;
                LAS const unsigned char* kb = L + (bf * 2 + u2) * AT_KS + r32 * 208 + hi * 16;
#pragma unroll
                for (int s6 = 0; s6 < 6; ++s6) { const bf16x8 a0 = *(LAS const bf16x8*)(kb + 32 * s6), a1 = *(LAS const bf16x8*)(kb + 32 * 208 + 32 * s6); p0 = mfma32(a0, qf[s6], s6 == 0 ? negm : p0); p1 = mfma32(a1, qf[s6], s6 == 0 ? negm : p1); }
                asm volatile("s_nop 15\n\ts_nop 7" : "+v"(p0), "+v"(p1));
                const float mx = rowmax32(p0, p1);
                if (!init || __any(mx > 8.0f)) raise_ref(p0, p1, o, negm, m_ref, l_run, init, mx, lane);
                float ls0 = 0.f, one = 1.0f; asm volatile("" : "+v"(one));
#pragma unroll
                for (int i = 0; i < 16; ++i) { p0[i] = __builtin_amdgcn_exp2f(p0[i]); p1[i] = __builtin_amdgcn_exp2f(p1[i]); ls0 = __builtin_fmaf(p0[i], one, ls0); ls0 = __builtin_fmaf(p1[i], one, ls0); }
                l_run += ls0;
                LAS const unsigned char* vs = L + MK + (bf * 2 + u2) * AT_VS;
                pv_block<0>(o, p0, vs, lane); pv_block<1>(o, p1, vs, lane);
            }
        }
        if (s + 1 < NS) MLA_WRITE(bf ^ 1);
        __syncthreads();
    }
#undef MLA_LOAD
#undef MLA_WRITE
    const float lt = l_run + shx(l_run, 32, lane);
#ifdef DBG_ZERO_MLA
    store_ot(OUT + row * 384 + h * 64, o, zz0, hi);
#else
    store_ot(OUT + row * 384 + h * 64, o, 1.0f / lt, hi);
#endif
}

DI void sb_unit(Frame& F, int b, int h, int qb) {
    const bf16_t* PROJ = (const bf16_t*)(F.ws + opq(WS_PROJ)); bf16_t* OUT = (bf16_t*)(F.ws + opq(WS_OSB));
    const int tid = F.tid, lane = F.lane, r32 = lane & 31, hi = lane >> 5, w = F.wave;
    const int qw = qb * 256 + 32 * w, qg = qw + r32; const size_t row = (size_t)b * SEQ + qg;
    bf16x8 qf[4];
    { const bf16_t* qp = PROJ + row * NPROJ + C_SBQ + h * 64 + 8 * hi;
#pragma unroll
      for (int s = 0; s < 4; ++s) qf[s] = *(const bf16x8*)(qp + 16 * s); }
    const int t_hi = 4 * qb + 3, cw = 4 * qb + (w >> 1);
    const int kr = tid >> 3, c8 = tid & 7;
    const bf16_t* gk = PROJ + ((size_t)b * SEQ + kr) * NPROJ + C_SBK + h * 64 + 8 * c8;
    const bf16_t* gv = PROJ + ((size_t)b * SEQ + kr) * NPROJ + C_SBV + h * 64 + 8 * c8;
    const int lk = kr * 144 + c8 * 16, lv = (c8 >> 2) * 4096 + kr * 64 + (c8 & 3) * 16;
    LAS unsigned char* L = F.lds + RING_OFF;
    volatile LAS unsigned* dflag = F.MISC + 16;
    u32x4 rk, rv;
#define SB_LOAD(t) do { rk = *(const u32x4*)(gk + (size_t)(t) * 64 * NPROJ); rv = *(const u32x4*)(gv + (size_t)(t) * 64 * NPROJ); } while (0)
#define SB_WRITE(bf) do { *(LAS u32x4*)(L + AT_K0 + (bf) * AT_KS + lk) = rk; *(LAS u32x4*)(L + AT_V0 + (bf) * AT_VS + lv) = rv; } while (0)
    SB_LOAD(t_hi); SB_WRITE(0);
    __syncthreads();
    float carry = 0.f; bool done = false; f32x16 o[2]; const float zz0 = zero_op();
#pragma unroll
    for (int i = 0; i < 16; ++i) { o[0][i] = zz0; o[1][i] = zz0; }
    int kt = t_hi;
    for (int it = 0;; ++it, --kt) {
        const int bf = it & 1;
        if (kt > 0) SB_LOAD(kt - 1);
        if (kt <= cw && !done) {
            f32x16 z[2];
#pragma unroll
            for (int i = 0; i < 16; ++i) { z[0][i] = zz0; z[1][i] = zz0; }
            LAS const unsigned char* kb = L + AT_K0 + bf * AT_KS + r32 * 144 + hi * 16;
#pragma unroll
            for (int s = 0; s < 4; ++s) { const bf16x8 a0 = *(LAS const bf16x8*)(kb + 32 * s), a1 = *(LAS const bf16x8*)(kb + 32 * 144 + 32 * s); z[0] = mfma32(a0, qf[s], z[0]); z[1] = mfma32(a1, qf[s], z[1]); }
            const int kbase = 64 * kt;
            float own[8];
#pragma unroll
            for (int kb2 = 0; kb2 < 2; ++kb2)
#pragma unroll
                for (int g = 0; g < 4; ++g) {
                    float lsv[4];
#pragma unroll
                    for (int j = 0; j < 4; ++j) { const int i = 4 * g + j; const float zz = z[kb2][i] * 0.125f; const int key = kbase + 32 * kb2 + crow(i, hi);
                        const float sp = fmaxf(zz, 0.f) + 0.6931471805599453f * __builtin_amdgcn_logf(1.0f + __builtin_amdgcn_exp2f(-1.4426950408889634f * fabsf(zz)));
                        const bool valid = key < qg; lsv[j] = valid ? -sp : 0.f; z[kb2][i] = valid ? (zz - sp) : -INFINITY; }
                    const float e2 = lsv[3], e1 = e2 + lsv[2], e0 = e1 + lsv[1];
                    z[kb2][4 * g + 2] += e2; z[kb2][4 * g + 1] += e1; z[kb2][4 * g + 0] += e0;
                    own[4 * kb2 + g] = e0 + lsv[0];
                }
            float par[8];
#pragma unroll
            for (int g = 0; g < 8; ++g) par[g] = shx(own[g], 32, lane);
            float so = 0.f, sp_ = 0.f;
#pragma unroll
            for (int g = 7; g >= 0; --g) {
                const float off = carry + so + (hi ? sp_ : sp_ + par[g]);
#pragma unroll
                for (int j = 0; j < 4; ++j) { const int kb2 = g >> 2, i = 4 * (g & 3) + j; z[kb2][i] = __builtin_amdgcn_exp2f(1.4426950408889634f * (z[kb2][i] + off)); }
                so += own[g]; sp_ += par[g];
            }
            carry += hi ? (sp_ + so) : (so + sp_);
            LAS const unsigned char* vs = L + AT_V0 + bf * AT_VS;
            pv_block<0>(o, z[0], vs, lane); pv_block<1>(o, z[1], vs, lane);
            done = __all(carry < -104.0f);
        }
        if (lane == 0) dflag[bf * 8 + w] = (done || kt == 0) ? 1u : 0u;
        if (kt > 0) SB_WRITE(bf ^ 1);
        __syncthreads();
        if (kt == 0) break;
        bool alld = true;
#pragma unroll
        for (int i = 0; i < 8; ++i) alld = alld && (dflag[bf * 8 + i] != 0u);
        if (alld) break;
    }
#undef SB_LOAD
#undef SB_WRITE
#ifdef DBG_ZERO_SB
    store_ot(OUT + row * 384 + h * 64, o, zz0, hi);
#else
    store_ot(OUT + row * 384 + h * 64, o, 1.0f, hi);
#endif
}
constexpr int DS_HIST = 0, DS_BITS = 65536, DS_VST = 98304, DS_NB = 512, DS_CAP = 256, DS_TOPK = 256;
constexpr int DM_ABOVE = 160, DM_CNT = 192;
constexpr int DL_INV = DS_VST, DL_OFF = DS_VST + 3 * 128, DL_BIN = DS_VST + 6 * 128;

DI int ds_bin(float s, float inv, float off) { const float t = __builtin_fmaf(s, inv, off); return (int)__builtin_amdgcn_fmed3f(t, 0.f, (float)(DS_NB - 1)); }

DI void ds_scores(float (&sc)[16], const bf16x8 k0, const bf16x8 k1, const bf16x8 (&qt)[2], const bf16x8 (&qi)[8][2], const float (&wh)[8], float zz0) {
    f32x16 z;
#pragma unroll
    for (int i = 0; i < 16; ++i) z[i] = zz0;
    f32x16 lin = mfma32(k0, qt[0], z); lin = mfma32(k1, qt[1], lin);
    f32x16 cur = mfma32(k0, qi[0][0], z); cur = mfma32(k1, qi[0][1], cur);
#pragma unroll
    for (int i = 0; i < 16; ++i) sc[i] = lin[i];
    __builtin_amdgcn_sched_barrier(0);
#pragma unroll
    for (int h = 0; h < 8; ++h) {
        f32x16 nxt = cur;
        if (h < 7) { nxt = mfma32(k0, qi[h + 1][0], z); nxt = mfma32(k1, qi[h + 1][1], nxt); }
#pragma unroll
        for (int i = 0; i < 16; ++i) sc[i] = __builtin_fmaf(wh[h], __builtin_fabsf(cur[i]), sc[i]);
        cur = nxt;
        __builtin_amdgcn_sched_barrier(0);
    }
    asm volatile("" : "+v"(sc[0]), "+v"(sc[1]), "+v"(sc[2]), "+v"(sc[3]), "+v"(sc[4]), "+v"(sc[5]), "+v"(sc[6]), "+v"(sc[7]));
    asm volatile("" : "+v"(sc[8]), "+v"(sc[9]), "+v"(sc[10]), "+v"(sc[11]), "+v"(sc[12]), "+v"(sc[13]), "+v"(sc[14]), "+v"(sc[15]));
}

DI void dsa_select_unit(Frame& F, int b, int qt_, int l) {
    const bf16_t* PROJ = (const bf16_t*)(F.ws + opq(WS_PROJ)); const bf16_t* IK = (const bf16_t*)(F.ws + opq(WS_IK));
    const float* IW = (const float*)(F.ws + opq(WS_IW));
    const float* C16 = (const float*)(F.ws + opq(WS_ROPE16)); const float* S16 = C16 + (size_t)T * 16;
    const int tid = F.tid, lane = F.lane, r32 = lane & 31, hi = lane >> 5, w = F.wave;
    const int q0 = qt_ * 32, chunk = q0 >> 6, NK = 64 * (chunk + 1), nblk = NK >> 5;
    const size_t row = (size_t)b * SEQ + q0 + r32, krow0 = (size_t)b * SEQ;
    LAS unsigned char* L = F.lds + RING_OFF;
    LAS unsigned* HIST = (LAS unsigned*)(L + DS_HIST); LAS unsigned* BITS = (LAS unsigned*)(L + DS_BITS);
    volatile LAS unsigned* M = F.MISC;
    const float zz0 = zero_op();
    { unsigned z0 = 0u; asm volatile("" : "+v"(z0));
      for (int i = tid; i < (DS_BITS + 32768) / 16; i += NTHR) *(LAS u32x4*)(L + i * 16) = (u32x4){z0, z0, z0, z0}; }
    if (NK <= DS_TOPK) {
        __syncthreads();
        for (int i = tid; i < nblk * 32; i += NTHR) BITS[i] = 0xFFFFFFFFu;
        __syncthreads();
    } else {
        bf16x8 qi[8][2], qt[2]; float wh[8];
        float B = 0.f;
        { const bf16_t* qp = PROJ + row * NPROJ + C_IQ + 8 * hi;
          Rope8 rp; rope_load(rp, C16 + row * 16 + 8 * hi, S16 + row * 16 + 8 * hi);
          const f32x4 w0 = *(const f32x4*)(IW + row * 8), w1 = *(const f32x4*)(IW + row * 8 + 4);
          wh[0] = 0.5f * w0[0]; wh[1] = 0.5f * w0[1]; wh[2] = 0.5f * w0[2]; wh[3] = 0.5f * w0[3]; wh[4] = 0.5f * w1[0]; wh[5] = 0.5f * w1[1]; wh[6] = 0.5f * w1[2]; wh[7] = 0.5f * w1[3];
          float ql[2][8];
#pragma unroll
          for (int s = 0; s < 2; ++s)
#pragma unroll
              for (int j = 0; j < 8; ++j) ql[s][j] = zz0;
#pragma unroll
          for (int h = 0; h < 8; ++h) { qi[h][0] = *(const bf16x8*)(qp + 32 * h); qi[h][1] = *(const bf16x8*)(qp + 32 * h + 16); }
          __builtin_amdgcn_sched_barrier(0);
#pragma unroll
          for (int h = 0; h < 8; ++h) {
              rope_apply(qi[h][0], qi[h][1], rp, 1.0f);
              float n2 = 0.f;
#pragma unroll
              for (int s = 0; s < 2; ++s)
#pragma unroll
                  for (int j = 0; j < 8; ++j) { const float v = bf2f((unsigned short)qi[h][s][j]); n2 = __builtin_fmaf(v, v, n2); ql[s][j] = __builtin_fmaf(wh[h], v, ql[s][j]); }
              n2 += shx(n2, 32, lane); B += 2.0f * fabsf(wh[h]) * sqrtf(n2);
              __builtin_amdgcn_sched_barrier(0); }
#pragma unroll
          for (int s = 0; s < 2; ++s) { u32x4 p; p.x = pk2(ql[s][0], ql[s][1]); p.y = pk2(ql[s][2], ql[s][3]); p.z = pk2(ql[s][4], ql[s][5]); p.w = pk2(ql[s][6], ql[s][7]); asm volatile("" : "+v"(p)); qt[s] = __builtin_bit_cast(bf16x8, p); } }
        { const float kmax = sqrtf(__builtin_bit_cast(float, __hip_atomic_load(F.ctl + CW_KMAX + 64 * (l * 2 + b), RLX_AGENT)));
          B = fmaxf(B * kmax * 1.03f, 1e-20f);
          if (w == 0 && hi == 0) { ((LAS float*)(L + DL_INV))[r32] = 1024.0f / B; ((LAS float*)(L + DL_OFF))[r32] = 256.0f; M[DM_ABOVE + r32] = 0u; } }
        __syncthreads();
        const bf16_t* kbase = IK + (krow0 + r32) * 32 + 8 * hi;
#define DS_LOADK(K0_, K1_, kb_) do { const bf16_t* kp_ = kbase + (size_t)(kb_) * 32 * 32; K0_ = *(const bf16x8*)kp_; K1_ = *(const bf16x8*)(kp_ + 16); } while (0)
        int lev = 0;
        for (;;) {
            float pinv[3], poff[3]; int pbin[3];
#pragma unroll
            for (int v = 0; v < 3; ++v) { pinv[v] = ((LAS float*)(L + DL_INV))[v * 32 + r32]; poff[v] = ((LAS float*)(L + DL_OFF))[v * 32 + r32]; pbin[v] = ((LAS int*)(L + DL_BIN))[v * 32 + r32]; }
#ifdef DBG_REP_S1
            for (int rep_ = 0; rep_ < 2; ++rep_)
#endif
            {
#ifdef DBG_REP_S1
                if (rep_) { __syncthreads(); unsigned z0 = 0u; asm volatile("" : "+v"(z0)); for (int i = tid; i < 65536 / 16; i += NTHR) *(LAS u32x4*)(L + DS_HIST + i * 16) = (u32x4){z0, z0, z0, z0}; __syncthreads(); }
#endif
                bf16x8 c0, c1, n0, n1; c0 = c1 = n0 = n1 = qt[0];
                if (w < nblk) DS_LOADK(c0, c1, w);
                if (lev == 0) {
                    const float inv0 = pinv[0], off0 = poff[0];
                    for (int kb = w; kb < nblk; kb += NWAVES) {
                        if (kb + NWAVES < nblk) DS_LOADK(n0, n1, kb + NWAVES);
                        float sc[16]; ds_scores(sc, c0, c1, qt, qi, wh, zz0);
#pragma unroll
                        for (int i = 0; i < 16; ++i) { const int bin = ds_bin(sc[i], inv0, off0);
                            __hip_atomic_fetch_add((LAS unsigned*)((LAS unsigned char*)HIST + (bin << 7) + (r32 << 2)), 1u, __ATOMIC_RELAXED, __HIP_MEMORY_SCOPE_WORKGROUP); }
                        c0 = n0; c1 = n1;
                    }
                } else {
                    for (int kb = w; kb < nblk; kb += NWAVES) {
                        if (kb + NWAVES < nblk) DS_LOADK(n0, n1, kb + NWAVES);
                        float sc[16]; ds_scores(sc, c0, c1, qt, qi, wh, zz0);
#pragma unroll
                        for (int i = 0; i < 16; ++i) { int bin = ds_bin(sc[i], pinv[0], poff[0]); bool in = (bin == pbin[0]); bin = ds_bin(sc[i], pinv[1], poff[1]);
                            if (lev >= 2) { in = in && (bin == pbin[1]); bin = ds_bin(sc[i], pinv[2], poff[2]); }
                            if (in) __hip_atomic_fetch_add(HIST + bin * 32 + r32, 1u, __ATOMIC_RELAXED, __HIP_MEMORY_SCOPE_WORKGROUP); }
                        c0 = n0; c1 = n1;
                    }
                }
            }
            __syncthreads();
#pragma unroll 1
            for (int sq = 0; sq < 4; ++sq) {
                int lane = F.lane; asm volatile("" : "+v"(lane));
                const int q = 4 * w + sq; unsigned hw[8]; unsigned mysum = 0;
#pragma unroll
                for (int i = 0; i < 8; ++i) { hw[i] = HIST[(8 * lane + i) * 32 + q]; mysum += hw[i]; }
                unsigned suf = mysum;
#pragma unroll
                for (int o = 1; o < 64; o <<= 1) { const unsigned t = (unsigned)__builtin_amdgcn_ds_bpermute(((lane + o) & 63) << 2, (int)suf); if (lane + o < 64) suf += t; }
                const unsigned above0 = M[DM_ABOVE + q]; const unsigned need = DS_TOPK - above0;
                const unsigned long long bal = __ballot(suf >= need);
                const int Ls = 63 - __builtin_clzll(bal | 1ull);
                const unsigned sufL = (unsigned)__builtin_amdgcn_ds_bpermute(Ls << 2, (int)suf), sumL = (unsigned)__builtin_amdgcn_ds_bpermute(Ls << 2, (int)mysum);
                unsigned acc = sufL - sumL; int bstar = 8 * Ls; unsigned cstar = 0;
#pragma unroll
                for (int i = 7; i >= 0; --i) { const unsigned c = (unsigned)__builtin_amdgcn_ds_bpermute(Ls << 2, (int)hw[i]);
                    if (cstar == 0u) { if (acc + c >= need) { bstar = 8 * Ls + i; cstar = c; } else acc += c; } }
                if (lane == 0) { ((LAS int*)(L + DL_BIN))[lev * 32 + q] = bstar; M[DM_ABOVE + q] = above0 + acc; M[DM_CNT + q] = cstar; }
            }
            __syncthreads();
            unsigned mxc = 0;
#pragma unroll 1
            for (int q = 0; q < 32; ++q) { const unsigned c = M[DM_CNT + q]; mxc = c > mxc ? c : mxc; }
            if (mxc <= (unsigned)DS_CAP || lev == 2) break;
            if (w == 0 && hi == 0) { const float pinv_ = ((LAS float*)(L + DL_INV))[lev * 32 + r32], poff_ = ((LAS float*)(L + DL_OFF))[lev * 32 + r32]; const int pb_ = ((LAS int*)(L + DL_BIN))[lev * 32 + r32];
                ((LAS float*)(L + DL_INV))[(lev + 1) * 32 + r32] = pinv_ * 511.5f; ((LAS float*)(L + DL_OFF))[(lev + 1) * 32 + r32] = (poff_ - (float)pb_) * 511.5f; }
            { unsigned z0 = 0u; asm volatile("" : "+v"(z0));
              for (int i = tid; i < 65536 / 16; i += NTHR) *(LAS u32x4*)(L + DS_HIST + i * 16) = (u32x4){z0, z0, z0, z0}; }
            ++lev;
            __syncthreads();
        }
        __syncthreads();
        if (tid < 32) M[DM_CNT + tid] = 0u;
        __syncthreads();
        {
            float pinv[3], poff[3]; int pbin[3];
#pragma unroll
            for (int v = 0; v < 3; ++v) { pinv[v] = ((LAS float*)(L + DL_INV))[v * 32 + r32]; poff[v] = ((LAS float*)(L + DL_OFF))[v * 32 + r32]; pbin[v] = ((LAS int*)(L + DL_BIN))[v * 32 + r32]; }
            LAS unsigned long long* CAND = (LAS unsigned long long*)(L + DS_HIST);
#define DS_SELBLK(K0_, K1_, kb_) do { float sc[16]; ds_scores(sc, K0_, K1_, qt, qi, wh, zz0); \
            unsigned word = 0u; const unsigned kinv = 0xFFFFu - (unsigned)((kb_) * 32 + 4 * hi); \
            _Pragma("unroll") for (int i = 0; i < 16; ++i) { \
                int bin = ds_bin(sc[i], pinv[0], poff[0]); bool sel = bin > pbin[0], eq = bin == pbin[0]; \
                if (lev >= 1) { bin = ds_bin(sc[i], pinv[1], poff[1]); sel = sel || (eq && bin > pbin[1]); eq = eq && bin == pbin[1]; } \
                if (lev >= 2) { bin = ds_bin(sc[i], pinv[2], poff[2]); sel = sel || (eq && bin > pbin[2]); eq = eq && bin == pbin[2]; } \
                if (sel) word |= 1u << crow(i, 0); \
                if (eq) { const unsigned slot = __hip_atomic_fetch_add((LAS unsigned*)(M + DM_CNT + r32), 1u, __ATOMIC_RELAXED, __HIP_MEMORY_SCOPE_WORKGROUP); \
                    if (slot < (unsigned)DS_CAP) CAND[r32 * DS_CAP + slot] = ((unsigned long long)f_sortable(sc[i]) << 32) | (unsigned)(kinv - (unsigned)crow(i, 0)); } } \
            word <<= 4 * hi; \
            if (word) __hip_atomic_fetch_or(BITS + (kb_) * 32 + r32, word, __ATOMIC_RELAXED, __HIP_MEMORY_SCOPE_WORKGROUP); } while (0)
#ifdef DBG_REP_S2
            for (int rep_ = 0; rep_ < 2; ++rep_)
#endif
            {
#ifdef DBG_REP_S2
                if (rep_) { __syncthreads(); if (tid < 32) M[DM_CNT + tid] = 0u; __syncthreads(); }
#endif
                bf16x8 c0, c1, n0, n1; c0 = c1 = n0 = n1 = qt[0];
                if (w < nblk) DS_LOADK(c0, c1, w);
                if (lev == 0) {
                    const float inv0 = pinv[0], off0 = poff[0];
                    const float T1 = pbin[0] >= DS_NB - 1 ? INFINITY : (float)(pbin[0] + 1), T0 = pbin[0] <= 0 ? -INFINITY : (float)pbin[0];
                    for (int kb = w; kb < nblk; kb += NWAVES) {
                        if (kb + NWAVES < nblk) DS_LOADK(n0, n1, kb + NWAVES);
                        float sc[16]; ds_scores(sc, c0, c1, qt, qi, wh, zz0);
                        unsigned cb = 0u; const unsigned kinv = 0xFFFFu - (unsigned)(kb * 32 + 4 * hi);
#pragma unroll
                        for (int i = 15; i >= 0; --i) { const float t = __builtin_fmaf(sc[i], inv0, off0); const bool sel = t >= T1, eq = (t >= T0) && !sel;
                            cb = cb * 2u + (sel ? 1u : 0u);
                            if (eq) { const unsigned slot = __hip_atomic_fetch_add((LAS unsigned*)(M + DM_CNT + r32), 1u, __ATOMIC_RELAXED, __HIP_MEMORY_SCOPE_WORKGROUP);
                                if (slot < (unsigned)DS_CAP) CAND[r32 * DS_CAP + slot] = ((unsigned long long)f_sortable(sc[i]) << 32) | (unsigned)(kinv - (unsigned)crow(i, 0)); } }
                        unsigned word = (cb & 0xFu) | ((cb & 0xF0u) << 4) | ((cb & 0xF00u) << 8) | ((cb & 0xF000u) << 12);
                        word <<= 4 * hi;
                        if (word) __hip_atomic_fetch_or(BITS + kb * 32 + r32, word, __ATOMIC_RELAXED, __HIP_MEMORY_SCOPE_WORKGROUP);
                        c0 = n0; c1 = n1;
                    }
                } else
                for (int kb = w; kb < nblk; kb += NWAVES) {
                    if (kb + NWAVES < nblk) DS_LOADK(n0, n1, kb + NWAVES);
                    DS_SELBLK(c0, c1, kb);
                    c0 = n0; c1 = n1;
                }
            }
#undef DS_SELBLK
            __syncthreads();
#ifdef DBG_REP_RES
            for (int rep_ = 0; rep_ < 2; ++rep_)
#endif
#pragma unroll 1
            for (int sq = 0; sq < 4; ++sq) {
                int lane = F.lane; asm volatile("" : "+v"(lane));
                const int q = 4 * w + sq; unsigned cnt = M[DM_CNT + q]; cnt = cnt < (unsigned)DS_CAP ? cnt : (unsigned)DS_CAP;
                const unsigned need = DS_TOPK - M[DM_ABOVE + q];
                const unsigned cnt4 = cnt & ~3u;
                for (unsigned i = lane; i < cnt; i += 64) { const unsigned long long ki = CAND[q * DS_CAP + i]; unsigned rank = 0; unsigned j = 0;
                    for (; j < cnt4; j += 4) { const unsigned long long x0 = CAND[q * DS_CAP + j], x1 = CAND[q * DS_CAP + j + 1], x2 = CAND[q * DS_CAP + j + 2], x3 = CAND[q * DS_CAP + j + 3];
                        rank += (x0 > ki ? 1u : 0u) + (x1 > ki ? 1u : 0u) + (x2 > ki ? 1u : 0u) + (x3 > ki ? 1u : 0u); }
                    for (; j < cnt; ++j) rank += (CAND[q * DS_CAP + j] > ki) ? 1u : 0u;
                    if (rank < need) { const unsigned key = 0xFFFFu - (unsigned)(ki & 0xFFFFull); __hip_atomic_fetch_or(BITS + (key >> 5) * 32 + q, 1u << (key & 31), __ATOMIC_RELAXED, __HIP_MEMORY_SCOPE_WORKGROUP); } }
            }
            __syncthreads();
        }
#undef DS_LOADK
    }
    {
        unsigned* BM = (unsigned*)(F.ws + opq(WS_BM)) + (size_t)b * 256 * SEQ + q0;
        for (int i = tid; i < nblk * 32; i += NTHR) __hip_atomic_store(BM + (size_t)(i >> 5) * SEQ + (i & 31), BITS[i], RLX_AGENT);
        asm volatile("s_waitcnt vmcnt(0)" ::: "memory");
        __syncthreads();
        if (tid == 0) __hip_atomic_store(F.ctl + CW_SELF + b * 256 + qt_, (unsigned)(l + 1), RLX_AGENT);
    }
}

DI void dsa_attn_unit(Frame& F, int b, int hd, int qb, int l) {
    const bf16_t* PROJ = (const bf16_t*)(F.ws + opq(WS_PROJ)); const bf16_t* DK = (const bf16_t*)(F.ws + opq(WS_DK)); bf16_t* OUT = (bf16_t*)(F.ws + opq(WS_ODSA));
    const float* C32 = (const float*)(F.ws + opq(WS_ROPE32)); const float* S32 = C32 + (size_t)T * 32;
    const int tid = F.tid, lane = F.lane, r32 = lane & 31, hi = lane >> 5, w = F.wave;
    const int qw = qb * 256 + 32 * w; const size_t row = (size_t)b * SEQ + qw + r32;
    if (w == 0) { unsigned sp = 0;
        for (;;) { const unsigned fv = lane < 8 ? __hip_atomic_load(F.ctl + CW_SELF + b * 256 + 8 * qb + lane, RLX_AGENT) : (unsigned)(l + 1);
            if (__all(fv == (unsigned)(l + 1)) || ++sp > (1u << 22)) break; __builtin_amdgcn_s_sleep(2); }
        __builtin_amdgcn_fence(__ATOMIC_ACQUIRE, "agent"); }
    asm volatile("s_waitcnt vmcnt(0)" ::: "memory");
    __syncthreads();
    constexpr float QS = 0.125f * 1.4426950408889634f;
    bf16x8 qf[4];
    { const bf16_t* qp = PROJ + row * NPROJ + C_DQ + hd * 64 + 8 * hi;
#pragma unroll
      for (int s = 0; s < 4; ++s) qf[s] = *(const bf16x8*)(qp + 16 * s);
      rope8(qf[0], qf[2], C32 + row * 32 + 8 * hi, S32 + row * 32 + 8 * hi, QS); rope8(qf[1], qf[3], C32 + row * 32 + 16 + 8 * hi, S32 + row * 32 + 16 + 8 * hi, QS); }
    const int NT = 4 * (qb + 1), cw = 4 * qb + (w >> 1);
    const int kr = tid >> 3, c8 = tid & 7;
    const bf16_t* gk = DK + ((size_t)b * SEQ + kr) * 256 + hd * 64 + 8 * c8;
    const bf16_t* gv = PROJ + ((size_t)b * SEQ + kr) * NPROJ + C_DV + hd * 64 + 8 * c8;
    const unsigned* bm = (const unsigned*)(F.ws + opq(WS_BM)) + (size_t)b * 256 * SEQ + qw + r32;
    const int lk = kr * 144 + c8 * 16, lv = (c8 >> 2) * 4096 + kr * 64 + (c8 & 3) * 16;
    LAS unsigned char* L = F.lds + RING_OFF;
    constexpr int MK = 4 * AT_KS;
    u32x4 rkA, rvA, rkB, rvB; unsigned nA0, nA1, nB0, nB1;
#define DA_LOAD(t) do { rkA = *(const u32x4*)(gk + (size_t)(t) * 64 * 256); rvA = *(const u32x4*)(gv + (size_t)(t) * 64 * NPROJ); \
        rkB = *(const u32x4*)(gk + (size_t)((t) + 1) * 64 * 256); rvB = *(const u32x4*)(gv + (size_t)((t) + 1) * 64 * NPROJ); \
        nA0 = __hip_atomic_load(bm + (size_t)(2 * (t)) * SEQ, RLX_AGENT); nA1 = __hip_atomic_load(bm + (size_t)(2 * (t) + 1) * SEQ, RLX_AGENT); \
        nB0 = __hip_atomic_load(bm + (size_t)(2 * (t) + 2) * SEQ, RLX_AGENT); nB1 = __hip_atomic_load(bm + (size_t)(2 * (t) + 3) * SEQ, RLX_AGENT); } while (0)
#define DA_WRITE(bf) do { LAS unsigned char* k_ = L + (bf) * 2 * AT_KS; LAS unsigned char* v_ = L + MK + (bf) * 2 * AT_VS; \
        *(LAS u32x4*)(k_ + lk) = rkA; *(LAS u32x4*)(v_ + lv) = rvA; *(LAS u32x4*)(k_ + AT_KS + lk) = rkB; *(LAS u32x4*)(v_ + AT_VS + lv) = rvB; } while (0)
    DA_LOAD(0); DA_WRITE(0);
    unsigned cA0 = nA0, cA1 = nA1, cB0 = nB0, cB1 = nB1;
    __syncthreads();
    float m_ref = 0.f, l_run = 0.f; bool init = false; f32x16 o[2], negm; const float zz0 = zero_op();
#pragma unroll
    for (int i = 0; i < 16; ++i) { o[0][i] = zz0; o[1][i] = zz0; negm[i] = zz0; }
    for (int t = 0; t < NT; t += 2) {
        const int bf = (t >> 1) & 1;
        if (t + 2 < NT) DA_LOAD(t + 2);
#pragma unroll
        for (int u2 = 0; u2 < 2; ++u2) {
        if (t + u2 <= cw) {
            const unsigned wd0 = (u2 ? cB0 : cA0) >> (4 * hi), wd1 = (u2 ? cB1 : cA1) >> (4 * hi);
            f32x16 p0, p1;
            LAS const unsigned char* kb = L + (bf * 2 + u2) * AT_KS + r32 * 144 + hi * 16;
#pragma unroll
            for (int s = 0; s < 4; ++s) { const bf16x8 a0 = *(LAS const bf16x8*)(kb + 32 * s), a1 = *(LAS const bf16x8*)(kb + 32 * 144 + 32 * s); p0 = mfma32(a0, qf[s], s == 0 ? negm : p0); p1 = mfma32(a1, qf[s], s == 0 ? negm : p1); }
            asm volatile("s_nop 15\n\ts_nop 7" : "+v"(p0), "+v"(p1));
            const float mx = rowmax32(p0, p1);
            if (!init || __any(mx > 8.0f)) raise_ref(p0, p1, o, negm, m_ref, l_run, init, mx, lane);
            float ls0 = 0.f, one = 1.0f; asm volatile("" : "+v"(one));
#define DA_E(i) do { p0[i] = mask_bit<((i) & 3) + 8 * ((i) >> 2)>(__builtin_amdgcn_exp2f(p0[i]), wd0); p1[i] = mask_bit<((i) & 3) + 8 * ((i) >> 2)>(__builtin_amdgcn_exp2f(p1[i]), wd1); ls0 = __builtin_fmaf(p0[i], one, ls0); ls0 = __builtin_fmaf(p1[i], one, ls0); } while (0)
            DA_E(0); DA_E(1); DA_E(2); DA_E(3); DA_E(4); DA_E(5); DA_E(6); DA_E(7); DA_E(8); DA_E(9); DA_E(10); DA_E(11); DA_E(12); DA_E(13); DA_E(14); DA_E(15);
#undef DA_E
            l_run += ls0;
            LAS const unsigned char* vs = L + MK + (bf * 2 + u2) * AT_VS;
            pv_block<0>(o, p0, vs, lane); pv_block<1>(o, p1, vs, lane);
        }
        }
        if (t + 2 < NT) { DA_WRITE(bf ^ 1); cA0 = nA0; cA1 = nA1; cB0 = nB0; cB1 = nB1; }
        __syncthreads();
    }
#undef DA_LOAD
#undef DA_WRITE
    const float lt = l_run + shx(l_run, 32, lane);
    store_ot(OUT + row * 256 + hd * 64, o, 1.0f / lt, hi);
}
constexpr int N_SEL = T / 32, N_MLA = BATCH * 6 * 32, N_DSAA = BATCH * 4 * 32, N_SB = BATCH * 6 * 32, N_ATT = N_SEL + N_MLA + N_DSAA + N_SB;
DI void p_attention(Frame& F, ArgsP a, int l, int qslot) {
    for (;;) {
        __syncthreads();
        if (F.tid == 0) F.MISC[12] = __hip_atomic_fetch_add(F.ctl + CW_QATT + 64 * qslot, 1u, RLX_AGENT);
        __syncthreads();
        int u = (int)F.MISC[12];
        if (u >= N_ATT + N_CVT) break;
        { int t_ = threadIdx.x; asm volatile("" : "+v"(t_)); F.tid = t_; F.lane = t_ & 63; }
        if (u < 3 * N_CVT) { const int q3 = u / 3; if (u - 3 * q3 == 2) { cvt_unit(F, a, l, q3); continue; } u -= q3; } else u -= N_CVT;
        if (u < N_SEL) { const int qt = 255 - u / 2, b = u & 1; dsa_select_unit(F, b, qt, l); }
        else if (u < N_SEL + N_MLA + N_DSAA) {
            const int v = u - N_SEL, qb = 31 - v / 20, r = v % 20;
            if (r < 8) dsa_attn_unit(F, r / 4, r % 4, qb, l); else mla_unit(F, (r - 8) / 6, (r - 8) % 6, qb);
        }
        else { const int v = u - N_SEL - N_MLA - N_DSAA; const int qb = 31 - v / 12, bh = v % 12; sb_unit(F, bh / 6, bh % 6, qb); }
    }
}

constexpr int PH_PER_LAYER = 10, N_PHASES = 2 + DEPTH * PH_PER_LAYER;
__global__ void __launch_bounds__(NTHR, 2) mk_fwd(Args a_unused) {
    ArgsP a = (ArgsP)__builtin_amdgcn_kernarg_segment_ptr();
    extern __shared__ __attribute__((aligned(16))) unsigned char lds_raw[];
    Frame F;
    F.lds = (LAS unsigned char*)lds_raw; F.MISC = (volatile LAS unsigned*)(F.lds + MISC_OFF);
    F.tid = threadIdx.x; F.lane = F.tid & 63; F.wave = __builtin_amdgcn_readfirstlane(F.tid >> 6);
    F.G = gridDim.x; F.bx = blockIdx.x; F.gw = blockIdx.x * NWAVES + F.wave; F.NGW = F.G * NWAVES; F.ws = (unsigned char*)a->ws; F.ctl = (gu32*)((unsigned char*)a->ws + WS_CTL);
    for (int u = F.tid; u < 256; u += NTHR) F.MISC[u] = 0u;
    __syncthreads();
    const int lo = a->ph_lo, hi = a->ph_hi;
    const bool one = (hi - lo) > 1;
    XcdBarrier bar; bar.bar = (unsigned*)(F.ctl + CW_BAR); bar.x = 0; bar.st = nullptr;
    if (one) bar = xcd_barrier_post((unsigned*)(F.ctl + CW_BAR), F.MISC + 8);
#define IN(k) (lo <= (k) && (k) < hi)
#define XN ((bf16_t*)(F.ws + opq(WS_XN)))
#define PROJ ((bf16_t*)(F.ws + opq(WS_PROJ)))
#define REFRESH() do { int t_ = threadIdx.x; asm volatile("" : "+v"(t_)); F.tid = t_; F.lane = t_ & 63; size_t z_ = 0; asm volatile("" : "+s"(z_)); a = (ArgsP)__builtin_amdgcn_kernarg_segment_ptr(); asm volatile("" : "+s"(a)); F.ws = (unsigned char*)a->ws + z_; F.ctl = (gu32*)(F.ws + opq(WS_CTL)); { LAS unsigned char* l_ = (LAS unsigned char*)lds_raw; asm volatile("" : "+s"(l_)); F.lds = l_; F.MISC = (volatile LAS unsigned*)(l_ + MISC_OFF); } \
    int b_ = blockIdx.x; asm volatile("" : "+s"(b_)); F.bx = b_; F.gw = b_ * NWAVES + F.wave; } while (0)
#ifdef DBG_DOUBLE_BAR
#define SEAM(k) do { if (IN(k) && IN((k) + 1)) { XcdBarrier b2_ = bar; size_t z_ = 0; asm volatile("" : "+s"(z_)); b2_.bar = (unsigned*)((unsigned char*)a->ws + z_ + WS_CTL) + CW_BAR; xcd_barrier(b2_); xcd_barrier(b2_); } } while (0)
#else
#define SEAM(k) do { if (IN(k) && IN((k) + 1)) { XcdBarrier b2_ = bar; size_t z_ = 0; asm volatile("" : "+s"(z_)); b2_.bar = (unsigned*)((unsigned char*)a->ws + z_ + WS_CTL) + CW_BAR; xcd_barrier(b2_); } } while (0)
#endif

    if (IN(0)) { REFRESH(); p0_mod(F, a); p0_rope(F, a); p0_convert(F, a); p0_convert_up(F, a);
#ifdef DBG_DOUBLE_P0
        p0_convert(F, a);
#endif
    } SEAM(0);
    if (IN(1)) { REFRESH(); p_norm_first(F, a); } SEAM(1);

    for (int l = 0; l < DEPTH; ++l) {
        const int pb = 2 + l * PH_PER_LAYER;
#ifndef DBG_SKIP_MIXER
        if (IN(pb + 0)) { REFRESH();
#ifdef DBG_REP_GIN
            for (int rep_ = 0; rep_ < 2; ++rep_) {
#else
            {
#endif

            pg8::DenseSched S; S.init(XN, (const bf16_t*)(F.ws + opq(WS_WIN)) + (size_t)l * NPROJ * DM, T, NPROJ, DM, F.G, F.bx);
            pg8::EpiStore E{PROJ, NPROJ};
            pg8::gemm_phase<pg8::EpiStore, pg8::DenseSched, true>(F.lds + RING_OFF, S, E);
                    }
        } SEAM(pb + 0);
        if (IN(pb + 2)) { REFRESH();
            p_post1(F, a, l);
            LAS float* tabq = (LAS float*)(F.lds + MISC_OFF + 1024); LAS float* tabkv = tabq + 256;
            { pg8::DenseSched S; S.init(PROJ + C_CQ, (const bf16_t*)(F.ws + opq(WS_WUQ)) + (size_t)l * 768 * 256, T, 768, 256, F.G, F.bx, NPROJ);
              pg8::Unit u0; if (S.next(0, u0)) rs_table<256>(F, PROJ + (size_t)u0.pm * 256 * NPROJ + C_CQ, tabq);
              __syncthreads();
              pg8::EpiStoreRS E{(bf16_t*)(F.ws + opq(WS_QM)), 768, tabq}; pg8::gemm_phase<pg8::EpiStoreRS, pg8::DenseSched, false>(F.lds + RING_OFF, S, E); }
            REFRESH();
            { pg8::DenseSched S; S.init(PROJ + C_CKV, (const bf16_t*)(F.ws + opq(WS_WUKV)) + (size_t)l * 768 * 128, T, 768, 128, F.G, (F.bx + 128) % F.G, NPROJ);
              pg8::Unit u0; if (S.next(0, u0)) rs_table<128>(F, PROJ + (size_t)u0.pm * 256 * NPROJ + C_CKV, tabkv);
              __syncthreads();
              pg8::EpiStoreRS E{(bf16_t*)(F.ws + opq(WS_KVM)), 768, tabkv}; pg8::gemm_phase<pg8::EpiStoreRS, pg8::DenseSched, false>(F.lds + RING_OFF, S, E); }
        } SEAM(pb + 2);
        if (IN(pb + 3)) { REFRESH(); p_attention(F, a, l, l);
#ifdef DBG_DOUBLE_ATT
            p_attention(F, a, l, l + 4);
#endif
        } SEAM(pb + 3);
        if (IN(pb + 4)) { REFRESH();
#ifdef DBG_REP_SMALL
            for (int rep_ = 0; rep_ < 2; ++rep_) {
#else
            {
#endif

            for (int s = 0; s < 3; ++s) {
                const bf16_t* A = (const bf16_t*)(F.ws + (s == 0 ? WS_OSB : s == 1 ? WS_OMLA : WS_ODSA));
                const bf16_t* B = (const bf16_t*)(F.ws + (s == 0 ? WS_WSB : s == 1 ? WS_WMLA : WS_WDSA)) + (size_t)l * DM * (s == 2 ? 256 : 384);
                pg8::DenseSched S; S.init(A, B, T, DM, s == 2 ? 256 : 384, F.G, F.bx);
                pg8::EpiBranch E{(bf16_t*)(F.ws + opq(WS_MRG)), PROJ, C_GATE + s * DM, s == 0};
                pg8::gemm_phase<pg8::EpiBranch, pg8::DenseSched, false>(F.lds + RING_OFF, S, E);
            }
                    }
        } SEAM(pb + 4);
        if (IN(pb + 5)) { REFRESH();
            pg8::DenseSched S; S.init((const bf16_t*)(F.ws + opq(WS_MRG)), (const bf16_t*)(F.ws + opq(WS_WOUT)) + (size_t)l * DM * DM, T, DM, DM, F.G, F.bx);
            pg8::EpiResid E{(float*)(F.ws + opq(WS_X)), (const float*)(F.ws + opq(WS_MOD)) + (size_t)l * 2 * 6 * DM + 2 * DM, 0};
            pg8::gemm_phase<pg8::EpiResid, pg8::DenseSched, false>(F.lds + RING_OFF, S, E);
#ifdef DBG_REP_OUT
            { pg8::EpiResid E2 = E; E2.dofs = (size_t)1600 * MiB; pg8::gemm_phase<pg8::EpiResid, pg8::DenseSched, false>(F.lds + RING_OFF, S, E2); }
#endif
        } SEAM(pb + 5);
#endif
        if (IN(pb + 6)) { REFRESH(); p_norm2_router(F, a, l);
#ifdef DBG_REP_ROUTER
            p_norm2_router(F, a, l, (size_t)1600 * MiB, 64 + l);
#endif
        } SEAM(pb + 6);
#ifndef DBG_SKIP_MOE
        if (IN(pb + 7)) { REFRESH();
#ifdef DBG_REP_MOE
            for (int rep_ = 0; rep_ < 2; ++rep_) {
#else
            {
#endif

            const pg8::MoeTab tb = moe_tables(F, l);
            pg8::MoeSched<true, 8> S{XN, (const bf16_t*)(F.ws + opq(WS_WGU)) + (size_t)l * NEXP * 2048 * DM, (const int*)(F.ws + opq(WS_LIST)), tb, DM, F.G, F.bx, (LAS unsigned*)(F.lds + MISC_OFF + 1024)};
            pg8::EpiSwiglu E{(bf16_t*)(F.ws + opq(WS_ACT)), ((const float*)a->b_gu) + (size_t)l * NEXP * 2048, (LAS float*)(F.lds + MISC_OFF + 3072)};
            pg8::gemm_phase<pg8::EpiSwiglu, pg8::MoeSched<true, 8>, true>(F.lds + RING_OFF, S, E);
                    }
        } SEAM(pb + 7);
        if (IN(pb + 8)) { REFRESH();
#ifdef DBG_REP_MOE
            for (int rep_ = 0; rep_ < 2; ++rep_) {
#else
            {
#endif

            const pg8::MoeTab tb = moe_tables_again(F);
            pg8::MoeSched<false, 4> S{(const bf16_t*)(F.ws + opq(WS_ACT)), (const bf16_t*)(F.ws + opq(WS_WDN)) + (size_t)l * NEXP * DM * DM, nullptr, tb, DM, F.G, F.bx, (LAS unsigned*)(F.lds + MISC_OFF + 1024)};
            pg8::EpiDown E{(bf16_t*)(F.ws + opq(WS_EOUT)), ((const float*)a->b_dn) + (size_t)l * NEXP * DM, (const float*)(F.ws + opq(WS_LISTW)), (LAS float*)(F.lds + MISC_OFF + 3072)};
            pg8::gemm_phase<pg8::EpiDown, pg8::MoeSched<false, 4>, true>(F.lds + RING_OFF, S, E);
                    }
        } SEAM(pb + 8);
#endif
        if (IN(pb + 9)) { REFRESH(); const pg8::MoeTab tb = moe_tables_again(F);
#ifdef DBG_REP_COMBINE
            p_combine(F, a, l, tb, (size_t)1600 * MiB);
#endif
            p_combine(F, a, l, tb); } SEAM(pb + 9);
    }
#undef IN
#undef SEAM
#undef XN
#undef PROJ
}

#ifndef MK_MULTI
#define MK_MULTI 0
#endif
extern "C" void kernel_launch(void* const* d_in, const int* in_sizes, int n_in, void* d_out, int out_size, void* d_ws, size_t ws_size, hipStream_t stream) {
    static int grid = 0;
    if (grid == 0) {
        if (n_in != 23 || in_sizes[0] != T * DM || out_size != T * DM || ws_size < WS_END) { fprintf(stderr, "kernel_launch: unexpected shapes (n_in %d, ws %zu); nothing launched\n", n_in, ws_size); grid = -1; return; }
        int dev = 0, cus = 0, per_cu = 0;
        if (hipGetDevice(&dev) != hipSuccess || hipDeviceGetAttribute(&cus, hipDeviceAttributeMultiprocessorCount, dev) != hipSuccess) { grid = -1; return; }
        if (hipFuncSetAttribute((const void*)mk_fwd, hipFuncAttributeMaxDynamicSharedMemorySize, LDS_BYTES) != hipSuccess) { fprintf(stderr, "kernel_launch: hipFuncSetAttribute failed\n"); grid = -1; return; }
        if (hipOccupancyMaxActiveBlocksPerMultiprocessor(&per_cu, (const void*)mk_fwd, NTHR, LDS_BYTES) != hipSuccess || per_cu < 1) { fprintf(stderr, "kernel_launch: note: occupancy query says %d\n", per_cu); (void)hipGetLastError(); }
        grid = cus;
    }
    if (grid < 0) return;
    if (hipMemsetAsync((char*)d_ws + WS_CTL, 0, CTL_ZERO_BYTES, stream) != hipSuccess) return;
    Args a{};
    a.x = (gcf)d_in[0]; a.c = (gcf)d_in[1]; a.pos = (gci)d_in[2];
    a.ada_w = (gcf)d_in[3]; a.ada_b = (gcf)d_in[4]; a.norm_mix_g = (gcf)d_in[5]; a.w_in = (gcf)d_in[6];
    a.q_norm_g = (gcf)d_in[7]; a.kv_norm_g = (gcf)d_in[8]; a.w_uq = (gcf)d_in[9]; a.w_ukv = (gcf)d_in[10];
    a.w_sb_out = (gcf)d_in[11]; a.w_mla_out = (gcf)d_in[12]; a.w_dsa_out = (gcf)d_in[13]; a.w_out = (gcf)d_in[14];
    a.norm_ffn_g = (gcf)d_in[15]; a.router_w = (gcf)d_in[16]; a.router_b = (gcf)d_in[17];
    a.w_gu = (gcf)d_in[18]; a.b_gu = (gcf)d_in[19]; a.w_dn = (gcf)d_in[20]; a.b_dn = (gcf)d_in[21]; a.final_g = (gcf)d_in[22];
    a.out = (GAS float*)d_out; a.ws = (GAS unsigned char*)d_ws;
#if MK_MULTI
    for (int p = 0; p < N_PHASES; ++p) { a.ph_lo = p; a.ph_hi = p + 1; hipLaunchKernelGGL(mk_fwd, dim3(grid), dim3(NTHR), LDS_BYTES, stream, a); }
#else
    a.ph_lo = 0; a.ph_hi = N_PHASES; hipLaunchKernelGGL(mk_fwd, dim3(grid), dim3(NTHR), LDS_BYTES, stream, a);
#endif
}
```

```cpp
#include <hip/hip_runtime.h>
#include <cstdio>
#include <cstdint>

#define LAS __attribute__((address_space(3)))
#define GAS __attribute__((address_space(1)))
typedef unsigned short bf16_t;
typedef short bf16x8 __attribute__((ext_vector_type(8)));
typedef short s16x4 __attribute__((ext_vector_type(4)));
typedef float f32x2 __attribute__((ext_vector_type(2)));
typedef float f32x4 __attribute__((ext_vector_type(4)));
typedef float f32x16 __attribute__((ext_vector_type(16)));
typedef unsigned u32x2 __attribute__((ext_vector_type(2)));
typedef unsigned u32x4 __attribute__((ext_vector_type(4)));
typedef GAS unsigned gu32;
#define RLX_AGENT __ATOMIC_RELAXED, __HIP_MEMORY_SCOPE_AGENT
#define DI __device__ __forceinline__

constexpr int BATCH = 2, SEQ = 8192, DM = 1024, DEPTH = 4, T = BATCH * SEQ;
constexpr int D_IN = 5704, NPROJ = 5888;
constexpr int C_SBQ = 0, C_SBK = 384, C_SBV = 768, C_CQ = 1152, C_CKV = 1408, C_KR = 1536, C_DQ = 1568, C_DK = 1824, C_DV = 2080,
              C_IQ = 2336, C_IK = 2592, C_IW = 2624, C_GATE = 2632;
constexpr int NEXP = 32, ECAP = T;
constexpr float NORM_EPS = 1e-6f;
constexpr int NWAVES = 8, NTHR = 512;

DI unsigned f2bf(float f) { unsigned u = __builtin_bit_cast(unsigned, f); return (u + 0x7fffu + ((u >> 16) & 1u)) >> 16; }
DI unsigned pk2(float lo, float hi) { return f2bf(lo) | (f2bf(hi) << 16); }
DI float bf2f(unsigned short h) { return __builtin_bit_cast(float, (unsigned)h << 16); }
DI float bflo(unsigned w) { return __builtin_bit_cast(float, w << 16); }
DI float bfhi(unsigned w) { return __builtin_bit_cast(float, w & 0xffff0000u); }
DI unsigned cvt_pk_bf16(float lo, float hi) { unsigned r; asm volatile("v_cvt_pk_bf16_f32 %0, %1, %2" : "=v"(r) : "v"(lo), "v"(hi)); return r; }
DI float shx(float v, int o, int lane) { return __builtin_bit_cast(float, __builtin_amdgcn_ds_bpermute((lane ^ o) << 2, __builtin_bit_cast(int, v))); }
DI float shl(float v, int src) { return __builtin_bit_cast(float, __builtin_amdgcn_ds_bpermute(src << 2, __builtin_bit_cast(int, v))); }
DI unsigned long long shx64(unsigned long long v, int o, int lane) {
    const unsigned lo = (unsigned)__builtin_amdgcn_ds_bpermute((lane ^ o) << 2, (int)(unsigned)v), hi = (unsigned)__builtin_amdgcn_ds_bpermute((lane ^ o) << 2, (int)(unsigned)(v >> 32));
    return ((unsigned long long)hi << 32) | lo; }
DI float wave_sum(float v, int lane) {
#pragma unroll
    for (int o = 1; o < 64; o <<= 1) v += shx(v, o, lane);
    return v;
}
DI float zero_op() { float z = 0.f; asm volatile("" : "+v"(z)); return z; }
DI size_t opq(size_t v) { asm volatile("" : "+s"(v)); return v; }
DI float fast_sigmoid(float x) { return __builtin_amdgcn_rcpf(1.0f + __builtin_amdgcn_exp2f(-1.4426950408889634f * x)); }

namespace pg8 {
constexpr int BM = 256, BK = 64, HALF = 128, HTB = HALF * BK * 2, STAGE_BYTES = 8 * HTB, NXCD = 8, WGM = 8;
__host__ __device__ __forceinline__ int lds_byte(int r, int c) { const int st = (r >> 4) * 2 + (c >> 5), rr = r & 15, cc = c & 31, ob = rr * 64 + cc * 2; return st * 1024 + (ob ^ (((ob >> 9) & 1) << 5)); }
__host__ __device__ __forceinline__ void stage_rc(int b, int& R, int& C) { const int st = b / 1024, sb = b % 1024, swz = sb ^ (((sb >> 9) & 1) << 5); R = (st >> 1) * 16 + swz / 64; C = (st & 1) * 32 + (swz % 64) / 2; }
__host__ __device__ __forceinline__ int perm32(int rho) { const int n = rho >> 4, i = rho & 15; return 8 * (i >> 2) + 4 * n + (i & 3); }

struct Unit { int pm, pn, e, row0, nrows, par; };

struct DenseSched {
    const bf16_t* A; const bf16_t* Bt; int K; int nM, nN, nwg, G, c, lda;
    DI void init(const bf16_t* A_, const bf16_t* Bt_, int M, int N, int K_, int G_, int c_, int lda_ = 0) { A = A_; Bt = Bt_; K = K_; nM = M / BM; nN = N / BM; nwg = nM * nN; G = G_; c = c_; lda = lda_ ? lda_ : K_; }
    DI bool next(int i, Unit& u) const {
        const long L = (long)i * G + c; if (L >= nwg) return false;
        int wgid = (int)L; { const int q = nwg / NXCD, r = nwg % NXCD, xcd = wgid % NXCD, off = wgid / NXCD; wgid = (xcd < r ? xcd * (q + 1) : r * (q + 1) + (xcd - r) * q) + off; }
        const int nig = WGM * nN, gid = wgid / nig, fm = gid * WGM, gsz = (nM - fm) < WGM ? (nM - fm) : WGM;
        u.pm = fm + ((wgid % nig) % gsz); u.pn = (wgid % nig) / gsz; u.e = 0; u.row0 = u.pm * BM; u.nrows = BM; return true;
    }
    DI const char* abase(const Unit& u) const { return (const char*)A + (size_t)u.pm * BM * lda * 2; }
    DI const char* bbase(const Unit& u) const { return (const char*)Bt + (size_t)u.pn * BM * K * 2; }
    DI void aoffs(const Unit&, int R, int C, unsigned (&v)[4]) const {
#pragma unroll
        for (int m = 0; m < 4; ++m) v[m] = (unsigned)((R + 64 * m) * lda + C) * 2u;
    }
    DI void prefetch(const Unit&, int, int) const {}
    DI void aoffs_next(const Unit& u, int R, int C, unsigned (&v)[4], int) const { aoffs(u, R, C, v); }
};

template <class Epi, class Sched, bool ALIGN_EPI>
DI void gemm_phase(LAS unsigned char* lds, const Sched& S, const Epi& E) {
    int tid = threadIdx.x; asm volatile("" : "+v"(tid));
    const int wid = __builtin_amdgcn_readfirstlane(tid >> 6), lane = tid & 63, wr = wid >> 2, wc = wid & 3, fr = lane & 15, fq = lane >> 4;
    const int K = S.K, nt = K / BK;
    int sR, sC; stage_rc(tid * 16, sR, sC);
    unsigned voffB[2];
#pragma unroll
    for (int i = 0; i < 2; ++i) { const int R = sR + 64 * i; const int Rb = Epi::PERM ? ((R & ~31) + perm32(R & 31)) : R; voffB[i] = (unsigned)(Rb * K + sC) * 2u; }
    const size_t kstep = (size_t)(BK * 2);
    const size_t hstep = (size_t)HALF * K * 2;
    const unsigned ldsw = (unsigned)wid * 1024u;
    const int aoff = lds_byte(wr * 64 + fr, fq * 8), boff = lds_byte(wc * 32 + fr, fq * 8);
#define PG8_SA(b, h) (((b) * 2 + (h)) * HTB)
#define PG8_SB(b, h) ((4 + (b) * 2 + (h)) * HTB)
#define PG8_STAGEB(bufoff, gbase) do { _Pragma("unroll") for (int _i = 0; _i < 2; ++_i) \
        __builtin_amdgcn_global_load_lds((const unsigned*)((const char*)(gbase) + voffB[_i]), (LAS unsigned*)(lds + (bufoff) + ldsw + _i * 8192), 16, 0, 0); } while (0)
#define PG8_STAGEA(bufoff, gbase, v0, v1) do { \
        __builtin_amdgcn_global_load_lds((const unsigned*)((const char*)(gbase) + (v0)), (LAS unsigned*)(lds + (bufoff) + ldsw), 16, 0, 0); \
        __builtin_amdgcn_global_load_lds((const unsigned*)((const char*)(gbase) + (v1)), (LAS unsigned*)(lds + (bufoff) + ldsw + 8192), 16, 0, 0); } while (0)
#define PG8_LDA(dst, b, h) do { _Pragma("unroll") for (int m = 0; m < 4; ++m) _Pragma("unroll") for (int k = 0; k < 2; ++k) dst[m][k] = *(const LAS bf16x8*)(lds + PG8_SA(b, h) + aoff + m * 2048 + k * 1024); } while (0)
#define PG8_LDB(dst, b, h) do { _Pragma("unroll") for (int n = 0; n < 2; ++n) _Pragma("unroll") for (int k = 0; k < 2; ++k) dst[n][k] = *(const LAS bf16x8*)(lds + PG8_SB(b, h) + boff + n * 2048 + k * 1024); } while (0)
#define PG8_MMA(ai, bj, At, Bt) do { __builtin_amdgcn_s_setprio(1); _Pragma("unroll") for (int m = 0; m < 4; ++m) _Pragma("unroll") for (int n = 0; n < 2; ++n) _Pragma("unroll") for (int k = 0; k < 2; ++k) \
        acc[ai][bj][m][n] = __builtin_amdgcn_mfma_f32_16x16x32_bf16(Bt[n][k], At[m][k], acc[ai][bj][m][n], 0, 0, 0); __builtin_amdgcn_s_setprio(0); } while (0)
#define PG8_WAIT_V(n) asm volatile("s_waitcnt vmcnt(" #n ")" ::: "memory")
#define PG8_WAIT_L(n) asm volatile("s_waitcnt lgkmcnt(" #n ")" ::: "memory")
#define PG8_BAR __builtin_amdgcn_s_barrier()
#define PG8_SCHED __builtin_amdgcn_sched_barrier(0)
    Unit cur, nxt; int ui = 0;
    if (!S.next(0, cur)) return;
    f32x4 acc[2][2][4][2];
    float zz = 0.f; asm volatile("" : "+v"(zz));
#pragma unroll
    for (int a = 0; a < 2; ++a)
#pragma unroll
        for (int b = 0; b < 2; ++b)
#pragma unroll
            for (int m = 0; m < 4; ++m)
#pragma unroll
                for (int n = 0; n < 2; ++n) acc[a][b][m][n] = (f32x4){zz, zz, zz, zz};
    bf16x8 At[4][2], B0[2][2], B1[2][2];
    const char* cA = S.abase(cur); const char* cB = S.bbase(cur);
    unsigned cv[4];
    S.aoffs(cur, sR, sC, cv);
    PG8_STAGEB(PG8_SB(0, 0), cB); PG8_STAGEB(PG8_SB(0, 1), cB + hstep); PG8_STAGEA(PG8_SA(0, 0), cA, cv[0], cv[1]); PG8_STAGEA(PG8_SA(0, 1), cA, cv[2], cv[3]);
    if (wr == 1) PG8_BAR;
    PG8_WAIT_V(2); PG8_BAR;
    PG8_STAGEB(PG8_SB(1, 0), cB + kstep); PG8_STAGEA(PG8_SA(1, 0), cA + kstep, cv[0], cv[1]); PG8_STAGEB(PG8_SB(1, 1), cB + hstep + kstep);
    PG8_WAIT_V(6); PG8_BAR;
    for (;;) {
        const bool has_next = S.next(ui + 1, nxt);
        cur.par = ui & 1;
        { int t2 = threadIdx.x; asm volatile("" : "+v"(t2)); E.prefetch(cur, t2); }
        const char* nA = cA; const char* nB = cB;
        if (has_next) { nA = S.abase(nxt); nB = S.bbase(nxt); int t2 = threadIdx.x; asm volatile("" : "+v"(t2)); S.prefetch(nxt, t2, (ui + 1) & 1); }
        for (int t = 0; t < nt; t += 2) {
            const bool last = (t == nt - 2);
            const char* a1 = cA + (size_t)(t + 1) * kstep;
            const char* a2 = last ? nA : cA + (size_t)(t + 2) * kstep; const char* b2 = last ? nB : cB + (size_t)(t + 2) * kstep;
            const char* a3 = a2 + kstep; const char* b3 = b2 + kstep;
            unsigned wv[4];
#pragma unroll
            for (int m = 0; m < 4; ++m) wv[m] = cv[m];
            if (last && has_next) { int t2 = threadIdx.x; asm volatile("" : "+v"(t2)); int R2, C2; stage_rc(t2 * 16, R2, C2); S.aoffs_next(nxt, R2, C2, wv, (ui + 1) & 1); }
            const unsigned w0 = wv[0], w1 = wv[1], w2 = wv[2], w3 = wv[3];
            PG8_LDB(B0, 0, 0); PG8_LDB(B1, 0, 1); PG8_SCHED; PG8_LDA(At, 0, 0); PG8_STAGEA(PG8_SA(1, 1), a1, cv[2], cv[3]);
            PG8_WAIT_V(8); PG8_WAIT_L(0); PG8_BAR; PG8_MMA(0, 0, At, B0); PG8_MMA(0, 1, At, B1); PG8_BAR; PG8_SCHED;
            PG8_LDA(At, 0, 1); PG8_STAGEB(PG8_SB(0, 0), b2); PG8_STAGEB(PG8_SB(0, 1), b2 + hstep); PG8_STAGEA(PG8_SA(0, 0), a2, w0, w1);
            PG8_WAIT_V(8); PG8_WAIT_L(0); PG8_BAR; PG8_MMA(1, 0, At, B0); PG8_MMA(1, 1, At, B1); PG8_BAR; PG8_SCHED;
            PG8_LDB(B0, 1, 0); PG8_LDB(B1, 1, 1); PG8_SCHED; PG8_LDA(At, 1, 0); PG8_STAGEA(PG8_SA(0, 1), a2, w2, w3);
            PG8_WAIT_V(8); PG8_WAIT_L(0); PG8_BAR; PG8_MMA(0, 0, At, B0); PG8_MMA(0, 1, At, B1); PG8_BAR; PG8_SCHED;
            PG8_LDA(At, 1, 1); PG8_STAGEB(PG8_SB(1, 0), b3); PG8_STAGEB(PG8_SB(1, 1), b3 + hstep); PG8_STAGEA(PG8_SA(1, 0), a3, w0, w1);
            PG8_WAIT_V(8); PG8_WAIT_L(0); PG8_BAR; PG8_MMA(1, 0, At, B0); PG8_MMA(1, 1, At, B1); PG8_BAR; PG8_SCHED;
        }
        if constexpr (ALIGN_EPI) { if (wr == 0) PG8_BAR; }
        { int t2 = threadIdx.x; asm volatile("" : "+v"(t2)); const int l2 = t2 & 63; E(acc, cur, wr, wc, l2 & 15, l2 >> 4); }
        if (!has_next) break;
#pragma unroll
        for (int a = 0; a < 2; ++a)
#pragma unroll
            for (int b = 0; b < 2; ++b)
#pragma unroll
                for (int m = 0; m < 4; ++m)
#pragma unroll
                    for (int n = 0; n < 2; ++n) acc[a][b][m][n] = (f32x4){zz, zz, zz, zz};
        cur = nxt; cA = nA; cB = nB; ++ui;
        { int t2 = threadIdx.x; asm volatile("" : "+v"(t2)); int R2, C2; stage_rc(t2 * 16, R2, C2); S.aoffs_next(cur, R2, C2, cv, ui & 1); }
        if constexpr (ALIGN_EPI) { if (wr == 1) PG8_BAR; }
    }
    PG8_WAIT_V(0);
    if constexpr (!ALIGN_EPI) { if (wr == 0) PG8_BAR; }
    PG8_BAR;
#undef PG8_SA
#undef PG8_SB
#undef PG8_STAGEA
#undef PG8_STAGEB
#undef PG8_LDA
#undef PG8_LDB
#undef PG8_MMA
#undef PG8_WAIT_V
#undef PG8_WAIT_L
#undef PG8_BAR
#undef PG8_SCHED
}
}
constexpr size_t MiB = 1u << 20;
constexpr size_t WS_CTL = 0, CTL_ZERO_BYTES = 1 * MiB;
constexpr size_t WS_MOD   = 1 * MiB;
constexpr size_t WS_ROPE32 = 2 * MiB;
constexpr size_t WS_ROPE16 = 6 * MiB;
constexpr size_t WS_WIN   = 8 * MiB;
constexpr size_t WS_WUQ   = 56 * MiB;
constexpr size_t WS_WUKV  = 58 * MiB;
constexpr size_t WS_WSB   = 60 * MiB;
constexpr size_t WS_WMLA  = 64 * MiB;
constexpr size_t WS_WDSA  = 68 * MiB;
constexpr size_t WS_WOUT  = 72 * MiB;
constexpr size_t WS_WGU   = 80 * MiB;
constexpr size_t WS_WDN   = 592 * MiB;
constexpr size_t WS_X     = 848 * MiB;
constexpr size_t WS_XN    = 912 * MiB;
constexpr size_t WS_PROJ  = 944 * MiB;
constexpr size_t WS_CQN   = 1128 * MiB;
constexpr size_t WS_CKVN  = 1136 * MiB;
constexpr size_t WS_KR    = 1140 * MiB;
constexpr size_t WS_DK    = 1141 * MiB;
constexpr size_t WS_IK    = 1149 * MiB;
constexpr size_t WS_IW    = 1150 * MiB;
constexpr size_t WS_QM    = 1152 * MiB;
constexpr size_t WS_KVM   = 1176 * MiB;
constexpr size_t WS_OSB   = 1200 * MiB;
constexpr size_t WS_OMLA  = 1212 * MiB;
constexpr size_t WS_ODSA  = 1224 * MiB;
constexpr size_t WS_MRG   = 1232 * MiB;
constexpr size_t WS_LIST  = 1264 * MiB;
constexpr size_t WS_LISTW = 1266 * MiB;
constexpr size_t WS_TOKE  = 1268 * MiB;
constexpr size_t WS_ACT   = 1272 * MiB;
constexpr size_t WS_EOUT  = 1402 * MiB;
constexpr size_t WS_BM    = 1532 * MiB;
constexpr size_t WS_END   = 1548 * MiB;
constexpr int CW_BAR = 4096;
constexpr int CW_CNT = 8192;
constexpr int CW_QATT = 8192 + 256;
constexpr int CW_SELF = 16384;
constexpr int CW_KMAX = 8192 + 1024;

constexpr int RING_OFF = 0, RING_BYTES = 131072;
constexpr int MISC_OFF = RING_BYTES;
constexpr int LDS_BYTES = 147456;

#define XB_TMO      128
#define XB_XCNT(j)  (256  + 64 * (j))
#define XB_XSUB(j)  (1280 + 64 * (j))
#define XB_XGEN(j)  (2304 + 64 * (j))
#define XB_TOP      3328
#define XB_TOPGEN   3392
#define XCD_BAR_WORDS 3456
#define XB_SPIN_CAP (1u << 18)

__device__ __forceinline__ unsigned xb_ld(unsigned* p)              { return __hip_atomic_load(p, __ATOMIC_RELAXED, __HIP_MEMORY_SCOPE_AGENT); }
__device__ __forceinline__ unsigned xb_add(unsigned* p, unsigned v) { return __hip_atomic_fetch_add(p, v, __ATOMIC_RELAXED, __HIP_MEMORY_SCOPE_AGENT); }
__device__ __forceinline__ unsigned xb_xcc_id() { return (unsigned)__builtin_amdgcn_s_getreg((3 << 11) | 20) & 0xFu; }
#define XB_SPIN(cond, bar) do { unsigned _sp = 0; while (cond) { __builtin_amdgcn_s_sleep(1); \
    if ((++_sp & 255u) == 0u) { if (xb_ld(&(bar)[XB_TMO])) break; if (_sp > XB_SPIN_CAP) { atomicAdd(&(bar)[XB_TMO], 1u); break; } } } } while (0)

struct XcdBarrier { unsigned* bar; unsigned x; volatile LAS unsigned* st; };

__device__ __forceinline__ XcdBarrier xcd_barrier_post(unsigned* bar, volatile LAS unsigned* st) {
    XcdBarrier b; b.bar = bar; b.x = xb_xcc_id(); b.st = st;
    if (threadIdx.x == 0) (void)xb_add(&bar[XB_XCNT(b.x)], 1u);
    return b;
}
__device__ __forceinline__ void xcd_barrier_complete(unsigned* bar, unsigned x, unsigned& nloc, unsigned& nx) {
    const unsigned G = gridDim.x * gridDim.y * gridDim.z;
    unsigned sum, cnt, mine, sp = 0u;
    for (;;) {
        sum = 0u; cnt = 0u; mine = 0u;
#pragma unroll
        for (unsigned j = 0; j < 16; ++j) { const unsigned c = xb_ld(&bar[XB_XCNT(j)]); sum += c; cnt += (c > 0u) ? 1u : 0u; mine = (j == x) ? c : mine; }
        if (sum == G) break;
        __builtin_amdgcn_s_sleep(1);
        if ((++sp & 255u) == 0u) { if (xb_ld(&bar[XB_TMO])) break; if (sp > XB_SPIN_CAP) { atomicAdd(&bar[XB_TMO], 1u); break; } }
    }
    nloc = mine > 0u ? mine : 1u; nx = cnt > 0u ? cnt : 1u;
}
__device__ __forceinline__ void xcd_barrier(const XcdBarrier& b) {
    asm volatile("s_waitcnt vmcnt(0)" ::: "memory");
    __syncthreads();
    if (threadIdx.x == 0) {
        unsigned* bar = b.bar;
        __builtin_amdgcn_s_waitcnt(0);
        unsigned nloc = b.st[0], nx = b.st[1];
        if (nloc == 0u) { xcd_barrier_complete(bar, b.x, nloc, nx); b.st[0] = nloc; b.st[1] = nx; }
        const unsigned old = xb_add(&bar[XB_XSUB(b.x)], 1u);
        const unsigned gen = old / nloc;
        if (old + 1u == (gen + 1u) * nloc) {
            __builtin_amdgcn_fence(__ATOMIC_RELEASE, "agent");
            asm volatile("s_waitcnt vmcnt(0)" ::: "memory");
            const unsigned og = xb_add(&bar[XB_TOP], 1u);
            const unsigned tg = og / nx;
            if (og + 1u == (tg + 1u) * nx) xb_add(&bar[XB_TOPGEN], 1u);
            else XB_SPIN(xb_ld(&bar[XB_TOPGEN]) == tg, bar);
            __builtin_amdgcn_fence(__ATOMIC_ACQUIRE, "agent");
            xb_add(&bar[XB_XGEN(b.x)], 1u);
            asm volatile("s_waitcnt vmcnt(0)" ::: "memory");
        } else {
            XB_SPIN(xb_ld(&bar[XB_XGEN(b.x)]) == gen, bar);
            __builtin_amdgcn_fence(__ATOMIC_ACQUIRE, "agent");
            asm volatile("s_waitcnt vmcnt(0)" ::: "memory");
        }
    }
    __syncthreads();
}

typedef const GAS float* gcf; typedef const GAS int* gci;
struct Args {
    gcf x, c; gci pos;
    gcf ada_w, ada_b, norm_mix_g, w_in, q_norm_g, kv_norm_g, w_uq, w_ukv, w_sb_out, w_mla_out, w_dsa_out, w_out,
        norm_ffn_g, router_w, router_b, w_gu, b_gu, w_dn, b_dn, final_g;
    GAS float* out; GAS unsigned char* ws;
    int ph_lo, ph_hi;
};
typedef const __attribute__((address_space(4))) Args* ArgsP;
struct Frame {
    LAS unsigned char* lds;
    volatile LAS unsigned* MISC;
    gu32* ctl;
    int tid, lane, wave, G, gw, NGW, bx;
    unsigned char* ws;
};
__constant__ float INVF32[32] = {1.f, 0.749894261f, 0.562341332f, 0.421696514f, 0.316227764f, 0.237137377f, 0.177827939f, 0.133352131f, 0.100000001f, 0.0749894157f, 0.0562341325f, 0.0421696529f, 0.0316227749f, 0.0237137377f, 0.0177827943f, 0.0133352149f, 0.00999999978f, 0.00749894185f, 0.00562341325f, 0.00421696482f, 0.00316227763f, 0.00237137359f, 0.00177827943f, 0.00133352145f, 0.00100000005f, 0.000749894243f, 0.000562341302f, 0.000421696517f, 0.000316227757f, 0.00023713737f, 0.00017782794f, 0.00013335215f};
__constant__ float INVF16[16] = {1.f, 0.562341332f, 0.316227764f, 0.177827939f, 0.100000001f, 0.0562341325f, 0.0316227749f, 0.0177827943f, 0.00999999978f, 0.00562341325f, 0.00316227763f, 0.00177827943f, 0.00100000005f, 0.000562341302f, 0.000316227757f, 0.00017782794f};

DI void p0_mod(Frame& F, ArgsP a) {
    LAS float* sc = (LAS float*)(F.lds + RING_OFF);
    LAS float* part = sc + 2048;
    for (int i = F.tid; i < 2048; i += NTHR) { const float v = ((const float*)a->c)[i]; sc[i] = v * fast_sigmoid(v); }
    __syncthreads();
    float* MOD = (float*)(F.ws + opq(WS_MOD));
    for (int task = F.bx; task < DEPTH * 96; task += F.G) {
        const int l = task / 96, n = (task % 96) * 64 + F.lane;
        const float* W = ((const float*)a->ada_w) + (size_t)l * DM * 6 * DM + n;
        float a0 = 0.f, a1 = 0.f; const int kb = F.wave * 128;
#pragma unroll 8
        for (int k = 0; k < 128; ++k) { const float w = W[(size_t)(kb + k) * (6 * DM)]; a0 = __builtin_fmaf(sc[kb + k], w, a0); a1 = __builtin_fmaf(sc[1024 + kb + k], w, a1); }
        part[(F.wave * 2 + 0) * 64 + F.lane] = a0; part[(F.wave * 2 + 1) * 64 + F.lane] = a1;
        __syncthreads();
        if (F.wave < 2) { float s = ((const float*)a->ada_b)[l * 6 * DM + n];
#pragma unroll
            for (int w = 0; w < 8; ++w) s += part[(w * 2 + F.wave) * 64 + F.lane];
            MOD[(size_t)(l * 2 + F.wave) * 6 * DM + n] = s; }
        __syncthreads();
    }
}
DI void p0_rope(Frame& F, ArgsP a) {
    float* R32 = (float*)(F.ws + opq(WS_ROPE32)); float* R16 = (float*)(F.ws + opq(WS_ROPE16));
    const int gt = F.bx * NTHR + F.tid, NT = F.G * NTHR;
    for (int i = gt; i < T * 32; i += NT) { const int t = i >> 5, f = i & 31; const float ang = (float)((const int*)a->pos)[t] * INVF32[f]; R32[i] = cosf(ang); R32[T * 32 + i] = sinf(ang); }
    for (int i = gt; i < T * 16; i += NT) { const int t = i >> 4, f = i & 15; const float ang = (float)((const int*)a->pos)[t] * INVF16[f]; R16[i] = cosf(ang); R16[T * 16 + i] = sinf(ang); }
}
struct CvtItem { const float* W; bf16_t* WT; int ld, nvalid, K, Ndst, mode, item; };
constexpr int CV_IN = (NPROJ / 32) * 16, CV_UQ = 0, CV_UKV = 0, CV_SB = 32 * 6, CV_MLA = 32 * 6, CV_DSA = 32 * 4, CV_OUT = 32 * 16, CV_GU = 64 * 16, CV_DN = 32 * 16;
constexpr int CV_SMALL = CV_IN + CV_UQ + CV_UKV + CV_SB + CV_MLA + CV_DSA + CV_OUT, CV_EXP = NEXP * (CV_GU + CV_DN);
constexpr int CV_UNIT = 96, N_CVT = CV_EXP / CV_UNIT;
DI void cvt_decode_small(CvtItem& c, Frame& F, ArgsP a, int it) {
    const int l = it / CV_SMALL; int r = it % CV_SMALL;
    if (r < CV_IN)  { c = CvtItem{((const float*)a->w_in) + (size_t)l * DM * D_IN, (bf16_t*)(F.ws + opq(WS_WIN)) + (size_t)l * NPROJ * DM, D_IN, D_IN, DM, NPROJ, 0, r}; return; } r -= CV_IN;
    if (r < CV_UQ)  { c = CvtItem{((const float*)a->w_uq) + (size_t)l * 256 * 576, (bf16_t*)(F.ws + opq(WS_WUQ)) + (size_t)l * 768 * 256, 576, 576, 256, 768, 0, r}; return; } r -= CV_UQ;
    if (r < CV_UKV) { c = CvtItem{((const float*)a->w_ukv) + (size_t)l * 128 * 768, (bf16_t*)(F.ws + opq(WS_WUKV)) + (size_t)l * 768 * 128, 768, 768, 128, 768, 0, r}; return; } r -= CV_UKV;
    if (r < CV_SB)  { c = CvtItem{((const float*)a->w_sb_out) + (size_t)l * 384 * DM, (bf16_t*)(F.ws + opq(WS_WSB)) + (size_t)l * DM * 384, DM, DM, 384, DM, 0, r}; return; } r -= CV_SB;
    if (r < CV_MLA) { c = CvtItem{((const float*)a->w_mla_out) + (size_t)l * 384 * DM, (bf16_t*)(F.ws + opq(WS_WMLA)) + (size_t)l * DM * 384, DM, DM, 384, DM, 0, r}; return; } r -= CV_MLA;
    if (r < CV_DSA) { c = CvtItem{((const float*)a->w_dsa_out) + (size_t)l * 256 * DM, (bf16_t*)(F.ws + opq(WS_WDSA)) + (size_t)l * DM * 256, DM, DM, 256, DM, 0, r}; return; } r -= CV_DSA;
    c = CvtItem{((const float*)a->w_out) + (size_t)l * DM * DM, (bf16_t*)(F.ws + opq(WS_WOUT)) + (size_t)l * DM * DM, DM, DM, DM, DM, 0, r};
}
DI void cvt_decode_expert(CvtItem& c, Frame& F, ArgsP a, int l, int r) {
    if (r < NEXP * CV_GU) { const int e = r / CV_GU; c = CvtItem{((const float*)a->w_gu) + (size_t)(l * NEXP + e) * DM * 2048, (bf16_t*)(F.ws + opq(WS_WGU)) + (size_t)(l * NEXP + e) * 2048 * DM, 2048, 2048, DM, 2048, 1, r % CV_GU}; return; } r -= NEXP * CV_GU;
    { const int e = r / CV_DN; c = CvtItem{((const float*)a->w_dn) + (size_t)(l * NEXP + e) * DM * DM, (bf16_t*)(F.ws + opq(WS_WDN)) + (size_t)(l * NEXP + e) * DM * DM, DM, DM, DM, DM, 0, r % CV_DN}; }
}
DI void cvt_load(f32x4 (&v)[8], const CvtItem& c, int lane) {
    const int nblk = c.Ndst / 32, kb = c.item / nblk, nb = c.item % nblk, k0 = 64 * kb, n0 = 32 * nb, quad = lane & 7;
    int col; if (c.mode == 0) col = n0 + 4 * quad; else col = (quad < 4) ? (n0 / 2 + 4 * quad) : (1024 + n0 / 2 + 4 * (quad - 4));
    const bool ok = (c.mode != 0) || (col < c.nvalid);
#pragma unroll
    for (int i = 0; i < 8; ++i) { const int row = (lane >> 3) + 8 * i; const float z0 = zero_op(); v[i] = (f32x4){z0, z0, z0, z0}; if (ok) v[i] = *(const f32x4*)(c.W + (size_t)(k0 + row) * c.ld + col); }
}
DI void cvt_store(const f32x4 (&v)[8], const CvtItem& c, LAS float* scr, int lane) {
    const int nblk = c.Ndst / 32, kb = c.item / nblk, nb = c.item % nblk, k0 = 64 * kb, n0 = 32 * nb, quad = lane & 7;
#pragma unroll
    for (int i = 0; i < 8; ++i) { const int row = (lane >> 3) + 8 * i; LAS float* d = scr + row * 33 + 4 * quad; d[0] = v[i][0]; d[1] = v[i][1]; d[2] = v[i][2]; d[3] = v[i][3]; }
    asm volatile("s_waitcnt lgkmcnt(0)" ::: "memory");
    const int cc = lane & 7;
#pragma unroll
    for (int j = 0; j < 4; ++j) { const int nn = (lane >> 3) + 8 * j; const int slot = (c.mode == 0) ? nn : ((nn & 1) * 16 + (nn >> 1)); const LAS float* s = scr + (8 * cc) * 33 + slot;
        u32x4 o; o.x = cvt_pk_bf16(s[0 * 33], s[1 * 33]); o.y = cvt_pk_bf16(s[2 * 33], s[3 * 33]); o.z = cvt_pk_bf16(s[4 * 33], s[5 * 33]); o.w = cvt_pk_bf16(s[6 * 33], s[7 * 33]);
        *(u32x4*)(c.WT + (size_t)(n0 + nn) * c.K + k0 + 8 * cc) = o; }
    asm volatile("s_waitcnt lgkmcnt(0)" ::: "memory");
}
DI void p0_convert_up(Frame& F, ArgsP a) {
    const int gt = F.bx * NTHR + F.tid, NT_ = F.G * NTHR;
    bf16_t* WUQ = (bf16_t*)(F.ws + opq(WS_WUQ)); bf16_t* WUKV = (bf16_t*)(F.ws + opq(WS_WUKV));
    for (int i = gt; i < DEPTH * 256 * 768; i += NT_) { const int n = i % 768, k = (i / 768) % 256, l = i / (768 * 256);
        const float v = n < 576 ? ((const float*)a->w_uq)[((size_t)l * 256 + k) * 576 + n] * ((const float*)a->q_norm_g)[l * 256 + k] : 0.f;
        WUQ[((size_t)l * 768 + n) * 256 + k] = (bf16_t)f2bf(v); }
    for (int i = gt; i < DEPTH * 128 * 768; i += NT_) { const int n = i % 768, k = (i / 768) % 128, l = i / (768 * 128);
        const float v = ((const float*)a->w_ukv)[((size_t)l * 128 + k) * 768 + n] * ((const float*)a->kv_norm_g)[l * 128 + k];
        WUKV[((size_t)l * 768 + n) * 128 + k] = (bf16_t)f2bf(v); }
}
DI void p0_convert(Frame& F, ArgsP a) {
    LAS float* scr = (LAS float*)(F.lds + RING_OFF + 16384 + F.wave * 12288);
    constexpr int NIT = DEPTH * CV_SMALL;
    f32x4 va[8], vb[8]; CvtItem ca, cb;
    int it = F.gw;
    if (it < NIT) { cvt_decode_small(ca, F, a, it); cvt_load(va, ca, F.lane); }
    while (it < NIT) {
        const int it1 = it + F.NGW;
        if (it1 < NIT) { cvt_decode_small(cb, F, a, it1); cvt_load(vb, cb, F.lane); }
        cvt_store(va, ca, scr, F.lane);
        if (it1 >= NIT) break;
        const int it2 = it1 + F.NGW;
        if (it2 < NIT) { cvt_decode_small(ca, F, a, it2); cvt_load(va, ca, F.lane); }
        cvt_store(vb, cb, scr, F.lane);
        it = it2;
    }
}
DI void cvt_unit(Frame& F, ArgsP a, int l, int cu) {
    LAS float* scr = (LAS float*)(F.lds + RING_OFF + F.wave * 12288);
    const int base = cu * CV_UNIT + F.wave; constexpr int NK = CV_UNIT / NWAVES;
    f32x4 va[8], vb[8], vc[8], vd[8]; CvtItem ca, cb, cc, cd;
    cvt_decode_expert(ca, F, a, l, base); cvt_load(va, ca, F.lane);
    cvt_decode_expert(cb, F, a, l, base + 8); cvt_load(vb, cb, F.lane);
    cvt_decode_expert(cc, F, a, l, base + 16); cvt_load(vc, cc, F.lane);
#pragma unroll 1
    for (int k = 0; k < NK; k += 4) {
        cvt_decode_expert(cd, F, a, l, base + 8 * (k + 3)); cvt_load(vd, cd, F.lane);
        cvt_store(va, ca, scr, F.lane);
        if (k + 4 < NK) { cvt_decode_expert(ca, F, a, l, base + 8 * (k + 4)); cvt_load(va, ca, F.lane); }
        cvt_store(vb, cb, scr, F.lane);
        if (k + 4 < NK) { cvt_decode_expert(cb, F, a, l, base + 8 * (k + 5)); cvt_load(vb, cb, F.lane); }
        cvt_store(vc, cc, scr, F.lane);
        if (k + 4 < NK) { cvt_decode_expert(cc, F, a, l, base + 8 * (k + 6)); cvt_load(vc, cc, F.lane); }
        cvt_store(vd, cd, scr, F.lane);
    }
}

struct RowCoef { f32x4 a[4], b[4]; };
DI void load_coef(RowCoef& c, const float* g, const float* sh, const float* sc, int lane) {
    f32x4 gg[4], ss[4];
#pragma unroll
    for (int j = 0; j < 4; ++j) { const int o = 4 * lane + 256 * j; gg[j] = *(const f32x4*)(g + o); ss[j] = *(const f32x4*)(sc + o); c.b[j] = *(const f32x4*)(sh + o); }
    __builtin_amdgcn_sched_barrier(0);
#pragma unroll
    for (int j = 0; j < 4; ++j) c.a[j] = gg[j] * (ss[j] + 1.0f);
}
DI float row_rstd(const f32x4 (&v)[4], int lane) {
    float s = 0.f;
#pragma unroll
    for (int j = 0; j < 4; ++j) s += (v[j].x * v[j].x + v[j].y * v[j].y) + (v[j].z * v[j].z + v[j].w * v[j].w);
    return 1.0f / sqrtf(wave_sum(s, lane) * (1.0f / DM) + NORM_EPS);
}
DI void store_xn(bf16_t* xn_row, const f32x4 (&h)[4], int lane) {
#pragma unroll
    for (int j = 0; j < 4; ++j) { u32x2 w; w.x = pk2(h[j].x, h[j].y); w.y = pk2(h[j].z, h[j].w); *(u32x2*)(xn_row + 4 * lane + 256 * j) = w; }
}
DI void p_norm_first(Frame& F, ArgsP a) {
    const float* MOD = (const float*)(F.ws + opq(WS_MOD)); float* X = (float*)(F.ws + opq(WS_X)); bf16_t* XN = (bf16_t*)(F.ws + opq(WS_XN));
    constexpr int RPW = 8;
    for (int r0 = F.gw * RPW; r0 < T; r0 += F.NGW * RPW) {
        const int b = r0 / SEQ; const float* mod = MOD + (size_t)(0 * 2 + b) * 6 * DM;
        RowCoef c; load_coef(c, ((const float*)a->norm_mix_g), mod + 0 * DM, mod + 1 * DM, F.lane);
        for (int r = r0; r < r0 + RPW; ++r) {
            f32x4 v[4];
#pragma unroll
            for (int j = 0; j < 4; ++j) v[j] = *(const f32x4*)(((const float*)a->x) + (size_t)r * DM + 4 * F.lane + 256 * j);
            const float rstd = row_rstd(v, F.lane);
            f32x4 h[4];
#pragma unroll
            for (int j = 0; j < 4; ++j) { *(f32x4*)(X + (size_t)r * DM + 4 * F.lane + 256 * j) = v[j]; h[j] = v[j] * rstd * c.a[j] + c.b[j]; }
            store_xn(XN + (size_t)r * DM, h, F.lane);
        }
    }
}
template <int NC> DI void rs_table(Frame& F, const bf16_t* src, LAS float* tab) {
    constexpr int LPR = NC / 8, RPI = 64 / LPR, NI = 32 / RPI;
    const int lane = F.lane, sub = lane / LPR, cl = lane % LPR;
    u32x4 v[NI];
#pragma unroll
    for (int j = 0; j < NI; ++j) v[j] = *(const u32x4*)(src + (size_t)(32 * F.wave + RPI * j + sub) * NPROJ + 8 * cl);
#pragma unroll
    for (int j = 0; j < NI; ++j) { float s = 0.f;
#pragma unroll
        for (int p = 0; p < 4; ++p) { const float x0 = bflo(v[j][p]), x1 = bfhi(v[j][p]); s = __builtin_fmaf(x0, x0, s); s = __builtin_fmaf(x1, x1, s); }
#pragma unroll
        for (int o = 1; o < LPR; o <<= 1) s += shx(s, o, lane);
        if (cl == 0) tab[32 * F.wave + RPI * j + sub] = 1.0f / sqrtf(s * (1.0f / NC) + NORM_EPS); }
}
DI void p_post1(Frame& F, ArgsP a, int l) {
    const bf16_t* PROJ = (const bf16_t*)(F.ws + opq(WS_PROJ));
    bf16_t* KR = (bf16_t*)(F.ws + opq(WS_KR));
    bf16_t* DK = (bf16_t*)(F.ws + opq(WS_DK)); bf16_t* IK = (bf16_t*)(F.ws + opq(WS_IK)); float* IW = (float*)(F.ws + opq(WS_IW));
    const float* C32 = (const float*)(F.ws + opq(WS_ROPE32)); const float* S32 = C32 + (size_t)T * 32;
    const float* C16 = (const float*)(F.ws + opq(WS_ROPE16)); const float* S16 = C16 + (size_t)T * 16;
    const int lane = F.lane;
    float kmx0 = 0.f, kmx1 = 0.f;
    const int hd = lane >> 4, i2 = 2 * (lane & 15), i1 = lane & 15; const bool second = lane >= 16;
    constexpr int RB = 8;
    for (int r0 = F.gw; r0 < T; r0 += RB * F.NGW) {
        unsigned w1[RB], w2[RB]; f32x2 cs[RB], sn[RB]; float x1[RB], x2[RB], c16[RB], s16[RB], iw[RB];
#pragma unroll
        for (int j = 0; j < RB; ++j) { const int r = r0 + j * F.NGW; const float z0 = zero_op();
            w1[j] = 0u; w2[j] = 0u; cs[j] = (f32x2){z0, z0}; sn[j] = (f32x2){z0, z0}; x1[j] = z0; x2[j] = z0; c16[j] = z0; s16[j] = z0; iw[j] = z0;
            if (r < T) { const bf16_t* p = PROJ + (size_t)r * NPROJ;
                { const bf16_t* q = p + C_DK + hd * 64; w1[j] = *(const unsigned*)(q + i2); w2[j] = *(const unsigned*)(q + 32 + i2); }
                cs[j] = *(const f32x2*)(C32 + (size_t)r * 32 + i2); sn[j] = *(const f32x2*)(S32 + (size_t)r * 32 + i2);
                if (lane < 32) { const bf16_t* q = p + (second ? C_IK : C_KR); x1[j] = bf2f(q[i1]); x2[j] = bf2f(q[i1 + 16]); c16[j] = C16[(size_t)r * 16 + i1]; s16[j] = S16[(size_t)r * 16 + i1]; }
                if (lane < 8) iw[j] = bf2f(p[C_IW + lane]); } }
#pragma unroll
        for (int j = 0; j < RB; ++j) { const int r = r0 + j * F.NGW;
            if (r < T) {
            { const float a0 = bflo(w1[j]), a1 = bfhi(w1[j]), b0 = bflo(w2[j]), b1 = bfhi(w2[j]);
              bf16_t* o = DK + (size_t)r * 256 + hd * 64;
              *(unsigned*)(o + i2) = pk2(a0 * cs[j].x - b0 * sn[j].x, a1 * cs[j].y - b1 * sn[j].y); *(unsigned*)(o + 32 + i2) = pk2(b0 * cs[j].x + a0 * sn[j].x, b1 * cs[j].y + a1 * sn[j].y); }
            float kn2 = 0.f;
            if (lane < 32) { bf16_t* o = (second ? IK : KR) + (size_t)r * 32; o[i1] = (bf16_t)f2bf(x1[j] * c16[j] - x2[j] * s16[j]); o[i1 + 16] = (bf16_t)f2bf(x2[j] * c16[j] + x1[j] * s16[j]);
              kn2 = second ? (x1[j] * x1[j] + x2[j] * x2[j]) : 0.f; }
            kn2 = wave_sum(kn2, lane);
            if (r < SEQ) kmx0 = fmaxf(kmx0, kn2); else kmx1 = fmaxf(kmx1, kn2);
            if (lane < 8) IW[(size_t)r * 8 + lane] = iw[j] * 0.0625f;
            } }
    }
    if (lane == 0) { F.MISC[32 + F.wave] = __builtin_bit_cast(unsigned, kmx0); F.MISC[40 + F.wave] = __builtin_bit_cast(unsigned, kmx1); }
    __syncthreads();
    if (F.tid < 2) { unsigned m = 0u; for (int w = 0; w < NWAVES; ++w) { const unsigned v = F.MISC[32 + 8 * F.tid + w]; m = v > m ? v : m; }
        atomicMax((unsigned*)(F.ctl + CW_KMAX + 64 * (l * 2 + F.tid)), m); }
}
namespace pg8 {
struct EpiStore {
    static constexpr bool PERM = true;
    DI void prefetch(const Unit&, int) const {}
    bf16_t* O; int ld;
    DI void operator()(const f32x4 (&acc)[2][2][4][2], const Unit& u, int wr, int wc, int fr, int fq) const {
        const int row0 = u.pm * BM + wr * 64 + fr, col0 = u.pn * BM + wc * 32 + 8 * fq;
#pragma unroll
        for (int ai = 0; ai < 2; ++ai)
#pragma unroll
            for (int m = 0; m < 4; ++m) { bf16_t* rowp = O + (size_t)(row0 + ai * HALF + m * 16) * ld + col0;
#pragma unroll
                for (int bj = 0; bj < 2; ++bj) { const f32x4 v0 = acc[ai][bj][m][0], v1 = acc[ai][bj][m][1];
                    u32x4 w; w.x = cvt_pk_bf16(v0[0], v0[1]); w.y = cvt_pk_bf16(v0[2], v0[3]); w.z = cvt_pk_bf16(v1[0], v1[1]); w.w = cvt_pk_bf16(v1[2], v1[3]);
                    *(u32x4*)(rowp + bj * HALF) = w; } }
    }
};
struct EpiStoreRS {
    static constexpr bool PERM = true;
    DI void prefetch(const Unit&, int) const {}
    bf16_t* O; int ld; LAS const float* rs;
    DI void operator()(const f32x4 (&acc)[2][2][4][2], const Unit& u, int wr, int wc, int fr, int fq) const {
        const int row0 = u.pm * BM + wr * 64 + fr, col0 = u.pn * BM + wc * 32 + 8 * fq;
#pragma unroll
        for (int ai = 0; ai < 2; ++ai)
#pragma unroll
            for (int m = 0; m < 4; ++m) { bf16_t* rowp = O + (size_t)(row0 + ai * HALF + m * 16) * ld + col0; const float s = rs[wr * 64 + fr + ai * HALF + m * 16];
#pragma unroll
                for (int bj = 0; bj < 2; ++bj) { const f32x4 v0 = acc[ai][bj][m][0] * s, v1 = acc[ai][bj][m][1] * s;
                    u32x4 w; w.x = cvt_pk_bf16(v0[0], v0[1]); w.y = cvt_pk_bf16(v0[2], v0[3]); w.z = cvt_pk_bf16(v1[0], v1[1]); w.w = cvt_pk_bf16(v1[2], v1[3]);
                    *(u32x4*)(rowp + bj * HALF) = w; } }
    }
};
struct EpiBranch {
    static constexpr bool PERM = true;
    DI void prefetch(const Unit&, int) const {}
    bf16_t* MRG; const bf16_t* PROJ; int gate0; int first;
    DI void operator()(const f32x4 (&acc)[2][2][4][2], const Unit& u, int wr, int wc, int fr, int fq) const {
        const int row0 = u.pm * BM + wr * 64 + fr, col0 = u.pn * BM + wc * 32 + 8 * fq;
#pragma unroll
        for (int ai = 0; ai < 2; ++ai) {
                u32x4 gl[4][2], pv[4][2];
#pragma unroll
                for (int m = 0; m < 4; ++m) { const size_t row = (size_t)(row0 + ai * HALF + m * 16);
#pragma unroll
                    for (int bj = 0; bj < 2; ++bj) { gl[m][bj] = *(const u32x4*)(PROJ + row * NPROJ + gate0 + col0 + bj * HALF);
                        if (!first) pv[m][bj] = *(const u32x4*)(MRG + row * DM + col0 + bj * HALF); else pv[m][bj] = (u32x4){0u, 0u, 0u, 0u}; } }
                __builtin_amdgcn_sched_barrier(0);
#pragma unroll
                for (int m = 0; m < 4; ++m) { const size_t row = (size_t)(row0 + ai * HALF + m * 16);
#pragma unroll
                    for (int bj = 0; bj < 2; ++bj) { const f32x4 v0 = acc[ai][bj][m][0], v1 = acc[ai][bj][m][1]; const u32x4 g_ = gl[m][bj], p_ = pv[m][bj];
                        bf16_t* mp_ = MRG + row * DM + col0 + bj * HALF;
                        float o[8];
                        o[0] = fast_sigmoid(bflo(g_.x)) * v0[0]; o[1] = fast_sigmoid(bfhi(g_.x)) * v0[1]; o[2] = fast_sigmoid(bflo(g_.y)) * v0[2]; o[3] = fast_sigmoid(bfhi(g_.y)) * v0[3];
                        o[4] = fast_sigmoid(bflo(g_.z)) * v1[0]; o[5] = fast_sigmoid(bfhi(g_.z)) * v1[1]; o[6] = fast_sigmoid(bflo(g_.w)) * v1[2]; o[7] = fast_sigmoid(bfhi(g_.w)) * v1[3];
                        if (!first) { o[0] += bflo(p_.x); o[1] += bfhi(p_.x); o[2] += bflo(p_.y); o[3] += bfhi(p_.y); o[4] += bflo(p_.z); o[5] += bfhi(p_.z); o[6] += bflo(p_.w); o[7] += bfhi(p_.w); }
                        u32x4 w; w.x = cvt_pk_bf16(o[0], o[1]); w.y = cvt_pk_bf16(o[2], o[3]); w.z = cvt_pk_bf16(o[4], o[5]); w.w = cvt_pk_bf16(o[6], o[7]);
                        *(u32x4*)mp_ = w; } }
            }
    }
};
struct EpiResid {
    static constexpr bool PERM = false;
    DI void prefetch(const Unit&, int) const {}
    float* X; const float* gvec; size_t dofs;
    DI void operator()(const f32x4 (&acc)[2][2][4][2], const Unit& u, int wr, int wc, int fr, int fq) const {
        const int row0 = u.pm * BM + wr * 64 + fr, col0 = u.pn * BM + wc * 32 + 4 * fq; const float* g = gvec + (size_t)((u.pm * BM) / SEQ) * 6 * DM;
#pragma unroll
        for (int bj = 0; bj < 2; ++bj) { f32x4 gv[2];
#pragma unroll
            for (int n = 0; n < 2; ++n) gv[n] = *(const f32x4*)(g + col0 + bj * HALF + n * 16);
            f32x4 xv[2][4][2];
#pragma unroll
            for (int ai = 0; ai < 2; ++ai)
#pragma unroll
                for (int m = 0; m < 4; ++m)
#pragma unroll
                    for (int n = 0; n < 2; ++n) xv[ai][m][n] = *(const f32x4*)(X + (size_t)(row0 + ai * HALF + m * 16) * DM + col0 + bj * HALF + n * 16);
            __builtin_amdgcn_sched_barrier(0);
#pragma unroll
            for (int ai = 0; ai < 2; ++ai)
#pragma unroll
                for (int m = 0; m < 4; ++m)
#pragma unroll
                    for (int n = 0; n < 2; ++n) { float* xp = X + (size_t)(row0 + ai * HALF + m * 16) * DM + col0 + bj * HALF + n * 16;
                        *(f32x4*)((char*)xp + dofs) = xv[ai][m][n] + gv[n] * acc[ai][bj][m][n]; } }
    }
};
struct MoeTab { LAS const int* cnt; LAS const int* tpre; LAS const int* off; LAS const int* xe; LAS const int* xt; };
template <bool GATHER, int NCOLT> struct MoeSched {
    const bf16_t* A; const bf16_t* Bt; const int* list; MoeTab tb; int K, G, c; LAS unsigned* ltab;
    DI bool next(int i, Unit& u) const {
        const int GX = G >> 3, x = c & 7, j = c >> 3; if (j >= GX) return false;
        LAS const int* xt = tb.xt + x * 5;
        const int L = i * GX + j; if (L >= __builtin_amdgcn_readfirstlane(xt[4]) * NCOLT) return false;
        const int tile = L / NCOLT; u.pn = L % NCOLT; int k = 0; while (__builtin_amdgcn_readfirstlane(xt[k + 1]) <= tile) ++k;
        const int e = __builtin_amdgcn_readfirstlane(tb.xe[x * 4 + k]), tp = __builtin_amdgcn_readfirstlane(xt[k]);
        const int of = __builtin_amdgcn_readfirstlane(tb.off[e]), cn = __builtin_amdgcn_readfirstlane(tb.cnt[e]);
        u.e = e; u.pm = (tile - tp) * BM; u.row0 = of + u.pm; const int left = cn - u.pm; u.nrows = left < BM ? left : BM; return true;
    }
    DI const char* abase(const Unit& u) const { return GATHER ? (const char*)A : (const char*)A + (size_t)u.row0 * K * 2; }
    DI const char* bbase(const Unit& u) const { return (const char*)Bt + ((size_t)u.e * NCOLT * BM + (size_t)u.pn * BM) * K * 2; }
    DI void aoffs(const Unit& u, int R, int C, unsigned (&v)[4]) const {
#pragma unroll
        for (int m = 0; m < 4; ++m) { int rr = R + 64 * m;
            if (GATHER) { rr = rr < u.nrows ? rr : 0; rr = list[u.e * ECAP + u.pm + rr]; }
            v[m] = (unsigned)(rr * K + C) * 2u; }
    }
    DI void prefetch(const Unit& u, int tid, int par) const {
        if (GATHER) { if (tid < 256) { const int rr = tid < u.nrows ? tid : 0;
            __builtin_amdgcn_global_load_lds((const unsigned*)(list + u.e * ECAP + u.pm + rr), (LAS unsigned*)(ltab + par * 256 + (tid & ~63)), 4, 0, 0); } }
    }
    DI void aoffs_next(const Unit& u, int R, int C, unsigned (&v)[4], int par) const {
        if (GATHER) {
#pragma unroll
            for (int m = 0; m < 4; ++m) v[m] = (unsigned)((int)ltab[par * 256 + R + 64 * m] * K + C) * 2u;
        } else aoffs(u, R, C, v);
    }
};
struct EpiSwiglu {
    static constexpr bool PERM = true;
    bf16_t* ACT; const float* bgu; LAS float* etab;
    DI void prefetch(const Unit& u, int tid) const {
        if (tid < 64) { const float* bg = bgu + (size_t)u.e * 2048 + u.pn * 128 + (tid < 32 ? 4 * tid : 1024 + 4 * (tid - 32));
            __builtin_amdgcn_global_load_lds((const unsigned*)bg, (LAS unsigned*)(etab + u.par * 256), 16, 0, 0); }
    }
    DI void operator()(const f32x4 (&acc)[2][2][4][2], const Unit& u, int wr, int wc, int fr, int fq) const {
        const int r0 = wr * 64 + fr, c0 = u.pn * BM + wc * 32 + 8 * fq; LAS const float* tb_ = etab + u.par * 256;
        f32x4 bgate[2], bup[2];
#pragma unroll
        for (int bj = 0; bj < 2; ++bj) { const int jj = wc * 16 + 4 * fq + bj * 64; bgate[bj] = *(LAS const f32x4*)(tb_ + jj); bup[bj] = *(LAS const f32x4*)(tb_ + 128 + jj); }
#pragma unroll
        for (int bj = 0; bj < 2; ++bj) { const int j0 = (c0 + bj * HALF) >> 1;
#pragma unroll
            for (int ai = 0; ai < 2; ++ai)
#pragma unroll
                for (int m = 0; m < 4; ++m) { const int r = r0 + ai * HALF + m * 16; const f32x4 v0 = acc[ai][bj][m][0], v1 = acc[ai][bj][m][1];
                    float g[4] = {v0[0] + bgate[bj][0], v0[2] + bgate[bj][1], v1[0] + bgate[bj][2], v1[2] + bgate[bj][3]};
                    float p[4] = {v0[1] + bup[bj][0], v0[3] + bup[bj][1], v1[1] + bup[bj][2], v1[3] + bup[bj][3]};
                    float o[4];
#pragma unroll
                    for (int k = 0; k < 4; ++k) { const float gg = fminf(g[k], 7.0f), uu = fminf(fmaxf(p[k], -7.0f), 7.0f); o[k] = (uu + 1.0f) * (gg * fast_sigmoid(1.702f * gg)); }
                    if (r < u.nrows) { u32x2 w; w.x = cvt_pk_bf16(o[0], o[1]); w.y = cvt_pk_bf16(o[2], o[3]); *(u32x2*)(ACT + (size_t)(u.row0 + r) * DM + j0) = w; } } }
    }
};
struct EpiDown {
    static constexpr bool PERM = true;
    bf16_t* EOUT; const float* bdn; const float* listw; LAS float* etab;
    DI void prefetch(const Unit& u, int tid) const {
        if (tid < 128) { const float* src = tid < 64 ? bdn + (size_t)u.e * DM + u.pn * BM + 4 * tid : listw + (size_t)u.e * ECAP + u.pm + 4 * (tid - 64);
            __builtin_amdgcn_global_load_lds((const unsigned*)src, (LAS unsigned*)(etab + u.par * 512 + (tid & 64) * 4), 16, 0, 0); }
    }
    DI void operator()(const f32x4 (&acc)[2][2][4][2], const Unit& u, int wr, int wc, int fr, int fq) const {
        const int r0 = wr * 64 + fr, c0 = u.pn * BM + wc * 32 + 8 * fq; LAS const float* tb_ = etab + u.par * 512;
        f32x4 b0[2], b1[2]; float cw[2][4];
#pragma unroll
        for (int bj = 0; bj < 2; ++bj) { const int cc = wc * 32 + 8 * fq + bj * HALF; b0[bj] = *(LAS const f32x4*)(tb_ + cc); b1[bj] = *(LAS const f32x4*)(tb_ + cc + 4); }
#pragma unroll
        for (int ai = 0; ai < 2; ++ai)
#pragma unroll
            for (int m = 0; m < 4; ++m) cw[ai][m] = tb_[256 + r0 + ai * HALF + m * 16];
#pragma unroll
        for (int ai = 0; ai < 2; ++ai)
#pragma unroll
            for (int m = 0; m < 4; ++m) { const int r = r0 + ai * HALF + m * 16;
                if (r < u.nrows) {
#pragma unroll
                    for (int bj = 0; bj < 2; ++bj) {
                        const f32x4 v0 = (acc[ai][bj][m][0] + b0[bj]) * cw[ai][m], v1 = (acc[ai][bj][m][1] + b1[bj]) * cw[ai][m];
                        u32x4 w; w.x = cvt_pk_bf16(v0[0], v0[1]); w.y = cvt_pk_bf16(v0[2], v0[3]); w.z = cvt_pk_bf16(v1[0], v1[1]); w.w = cvt_pk_bf16(v1[2], v1[3]);
                        *(u32x4*)(EOUT + (size_t)(u.row0 + r) * DM + c0 + bj * HALF) = w; } } }
    }
};
}

DI pg8::MoeTab moe_tables_again(Frame& F) {
    pg8::MoeTab tb; tb.cnt = (LAS int*)(F.MISC + 64); tb.tpre = (LAS int*)(F.MISC + 100); tb.off = (LAS int*)(F.MISC + 140); tb.xe = (LAS int*)(F.MISC + 176); tb.xt = (LAS int*)(F.MISC + 208);
    __syncthreads();
    return tb;
}
DI pg8::MoeTab moe_tables(Frame& F, int l) {
    LAS int* cnt = (LAS int*)(F.MISC + 64); LAS int* tpre = (LAS int*)(F.MISC + 100); LAS int* off = (LAS int*)(F.MISC + 140);
    LAS int* xe = (LAS int*)(F.MISC + 176); LAS int* xt = (LAS int*)(F.MISC + 208);
    __syncthreads();
    if (F.tid < NEXP) cnt[F.tid] = (int)__hip_atomic_load(F.ctl + CW_CNT + l * NEXP + F.tid, RLX_AGENT);
    __syncthreads();
    if (F.tid == 0) { int tp = 0, so = 0; for (int e = 0; e < NEXP; ++e) { tpre[e] = tp; off[e] = so; tp += (cnt[e] + 255) >> 8; so += cnt[e]; } tpre[NEXP] = tp; off[NEXP] = so; }
    if (F.tid >= 64 && F.tid < 64 + NEXP) {
        const int e = F.tid - 64, tl = (cnt[e] + 255) >> 8; int r = 0;
        for (int o = 0; o < NEXP; ++o) { const int to = (cnt[o] + 255) >> 8; r += (to > tl || (to == tl && o < e)) ? 1 : 0; }
        const int grp = r >> 3, pos = r & 7, x = (grp & 1) ? 7 - pos : pos; xe[x * 4 + grp] = e; }
    __syncthreads();
    if (F.tid < 8) { int s = 0; for (int k = 0; k < 4; ++k) { xt[F.tid * 5 + k] = s; s += (cnt[xe[F.tid * 4 + k]] + 255) >> 8; } xt[F.tid * 5 + 4] = s; }
    __syncthreads();
    pg8::MoeTab tb; tb.cnt = cnt; tb.tpre = tpre; tb.off = off; tb.xe = xe; tb.xt = xt; return tb;
}
DI unsigned f_sortable(float f) { const unsigned b = __builtin_bit_cast(unsigned, f); return b ^ ((b >> 31) ? 0xFFFFFFFFu : 0x80000000u); }
DI void p_norm2_router(Frame& F, ArgsP a, int l, size_t dofs = 0, int cslot = -1) {
    if (cslot < 0) cslot = l;
    LAS float* WT = (LAS float*)(F.lds + RING_OFF);
    { const float* rw = ((const float*)a->router_w) + (size_t)l * DM * NEXP;
#pragma unroll
      for (int ch = 0; ch < 2; ++ch) { const int k = 128 * F.wave + 64 * ch + F.lane; f32x4 w[8];
#pragma unroll
          for (int e4 = 0; e4 < 8; ++e4) w[e4] = *(const f32x4*)(rw + (size_t)k * NEXP + 4 * e4);
#pragma unroll
          for (int e4 = 0; e4 < 8; ++e4) { WT[(4 * e4 + 0) * DM + k] = w[e4].x; WT[(4 * e4 + 1) * DM + k] = w[e4].y; WT[(4 * e4 + 2) * DM + k] = w[e4].z; WT[(4 * e4 + 3) * DM + k] = w[e4].w; } } }
    __syncthreads();
    const float* MOD = (const float*)(F.ws + opq(WS_MOD)); const float* X = (const float*)(F.ws + opq(WS_X)); bf16_t* XN = (bf16_t*)(F.ws + opq(WS_XN) + dofs);
    int* LIST = (int*)(F.ws + opq(WS_LIST) + dofs); float* LISTW = (float*)(F.ws + opq(WS_LISTW) + dofs); int* TOKE = (int*)(F.ws + opq(WS_TOKE) + dofs);
    volatile LAS unsigned* RENT = (volatile LAS unsigned*)(F.lds + MISC_OFF + 1024);
    if (F.tid < NEXP) F.MISC[64 + F.tid] = 0u;
    const int lane = F.lane; const int e_mine = lane >> 1;
    const float rb = ((const float*)a->router_b)[l * NEXP + e_mine];
    constexpr int RPW = 8;
    const int rstride = F.NGW * RPW, riters = (T + rstride - 1) / rstride;
    for (int rit = 0; rit < riters; ++rit) {
        const int r0 = F.gw * RPW + rit * rstride; const bool ract = r0 < T;
        if (ract) {
        const int b = r0 / SEQ; const float* mod = MOD + (size_t)(l * 2 + b) * 6 * DM;
        RowCoef c; load_coef(c, ((const float*)a->norm_ffn_g) + l * DM, mod + 3 * DM, mod + 4 * DM, lane);
        f32x4 nx[4];
#pragma unroll
        for (int j = 0; j < 4; ++j) nx[j] = *(const f32x4*)(X + (size_t)r0 * DM + 4 * lane + 256 * j);
        for (int r = r0; r < r0 + RPW; ++r) {
            f32x4 h[4];
#pragma unroll
            for (int j = 0; j < 4; ++j) h[j] = nx[j];
            if (r + 1 < r0 + RPW) {
#pragma unroll
                for (int j = 0; j < 4; ++j) nx[j] = *(const f32x4*)(X + (size_t)(r + 1) * DM + 4 * lane + 256 * j); }
            const float rstd = row_rstd(h, lane);
#pragma unroll
            for (int j = 0; j < 4; ++j) h[j] = h[j] * rstd * c.a[j] + c.b[j];
            store_xn(XN + (size_t)r * DM, h, lane);
            float v[32];
#pragma unroll
            for (int e = 0; e < 32; ++e) { float s = 0.f;
#pragma unroll
                for (int j = 0; j < 4; ++j) { const f32x4 w = *(const LAS f32x4*)(WT + e * DM + 4 * lane + 256 * j); s += (h[j].x * w.x + h[j].y * w.y) + (h[j].z * w.z + h[j].w * w.w); }
                v[e] = s; if ((e & 3) == 3) __builtin_amdgcn_sched_barrier(0); }
            float a16[16], a8[8], a4[4], a2[2], a1;
            { const bool up = lane & 32;
#pragma unroll
              for (int i = 0; i < 16; ++i) { const float keep = up ? v[16 + i] : v[i], send = up ? v[i] : v[16 + i]; a16[i] = keep + shx(send, 32, lane); } }
            { const bool up = lane & 16;
#pragma unroll
              for (int i = 0; i < 8; ++i) { const float keep = up ? a16[8 + i] : a16[i], send = up ? a16[i] : a16[8 + i]; a8[i] = keep + shx(send, 16, lane); } }
            { const bool up = lane & 8;
#pragma unroll
              for (int i = 0; i < 4; ++i) { const float keep = up ? a8[4 + i] : a8[i], send = up ? a8[i] : a8[4 + i]; a4[i] = keep + shx(send, 8, lane); } }
            { const bool up = lane & 4;
#pragma unroll
              for (int i = 0; i < 2; ++i) { const float keep = up ? a4[2 + i] : a4[i], send = up ? a4[i] : a4[2 + i]; a2[i] = keep + shx(send, 4, lane); } }
            { const bool up = lane & 2; const float keep = up ? a2[1] : a2[0], send = up ? a2[0] : a2[1]; a1 = keep + shx(send, 2, lane); }
            a1 += shx(a1, 1, lane);
            const float logit = a1 + rb;
            unsigned long long key = ((unsigned long long)f_sortable(logit) << 32) | (unsigned)(31 - e_mine);
            int te[4]; float tv[4];
#pragma unroll
            for (int k = 0; k < 4; ++k) {
                unsigned long long m = key;
#pragma unroll
                for (int o = 1; o < 64; o <<= 1) { const unsigned long long t = shx64(m, o, lane); m = t > m ? t : m; }
                te[k] = 31 - (int)(unsigned)(m & 0xFFFFFFFFull); tv[k] = shl(logit, 2 * te[k]);
                if (e_mine == te[k]) key = 0ull;
            }
            const float e1 = __expf(tv[1] - tv[0]), e2 = __expf(tv[2] - tv[0]), e3 = __expf(tv[3] - tv[0]); const float inv = 1.0f / (1.0f + e1 + e2 + e3);
            if (lane < 4) {
                const int ek = lane == 0 ? te[0] : lane == 1 ? te[1] : lane == 2 ? te[2] : te[3];
                const float wk = (lane == 0 ? 1.0f : lane == 1 ? e1 : lane == 2 ? e2 : e3) * inv;
                const unsigned lr = __hip_atomic_fetch_add((LAS unsigned*)(F.MISC + 64 + ek), 1u, __ATOMIC_RELAXED, __HIP_MEMORY_SCOPE_WORKGROUP);
                RENT[((F.wave * RPW + (r - r0)) * 4 + lane) * 2] = (unsigned)ek | (lr << 8); RENT[((F.wave * RPW + (r - r0)) * 4 + lane) * 2 + 1] = __builtin_bit_cast(unsigned, wk);
            }
        }
        }
        __syncthreads();
        if (F.tid < NEXP) { const unsigned c = F.MISC[64 + F.tid]; F.MISC[96 + F.tid] = c ? __hip_atomic_fetch_add(F.ctl + CW_CNT + cslot * NEXP + F.tid, c, RLX_AGENT) : 0u; F.MISC[64 + F.tid] = 0u; }
        __syncthreads();
        if (ract && lane < 4 * RPW) { const int ri = lane >> 2, k = lane & 3, r = r0 + ri;
            const unsigned en = RENT[((F.wave * RPW + ri) * 4 + k) * 2]; const int ek = en & 0xff; const int rank = (int)(F.MISC[96 + ek] + (en >> 8));
            LIST[ek * ECAP + rank] = r; LISTW[ek * ECAP + rank] = __builtin_bit_cast(float, RENT[((F.wave * RPW + ri) * 4 + k) * 2 + 1]); TOKE[r * 4 + k] = ek | (rank << 8); }
        __syncthreads();
    }
}
DI void p_combine(Frame& F, ArgsP a, int l, const pg8::MoeTab& tb, size_t dofs = 0) {
    const float* MOD = (const float*)(F.ws + opq(WS_MOD)); const float* X = (const float*)(F.ws + opq(WS_X)); float* XO = (float*)(F.ws + opq(WS_X) + dofs); bf16_t* XN = (bf16_t*)(F.ws + opq(WS_XN) + dofs);
    const bf16_t* EOUT = (const bf16_t*)(F.ws + opq(WS_EOUT)); const int* TOKE = (const int*)(F.ws + opq(WS_TOKE));
    const int lane = F.lane; const bool lastl = (l == DEPTH - 1);
    constexpr int RPW = 8;
    for (int r0 = F.gw * RPW; r0 < T; r0 += F.NGW * RPW) {
        const int b = r0 / SEQ; const float* mod = MOD + (size_t)(l * 2 + b) * 6 * DM;
        f32x4 gf[4];
#pragma unroll
        for (int j = 0; j < 4; ++j) gf[j] = *(const f32x4*)(mod + 5 * DM + 4 * lane + 256 * j);
        RowCoef c;
        if (!lastl) { const float* modn = MOD + (size_t)((l + 1) * 2 + b) * 6 * DM; load_coef(c, ((const float*)a->norm_mix_g) + (l + 1) * DM, modn + 0 * DM, modn + 1 * DM, lane); }
        else {
#pragma unroll
            for (int j = 0; j < 4; ++j) { c.a[j] = *(const f32x4*)(((const float*)a->final_g) + 4 * lane + 256 * j); const float z0 = zero_op(); c.b[j] = (f32x4){z0, z0, z0, z0}; } }
        int myslot = 0;
        if (lane < 4 * RPW) { const int te = TOKE[(size_t)r0 * 4 + lane]; myslot = tb.off[te & 0xff] + (te >> 8); }
        u32x2 ne[4][4]; f32x4 nx[4];
#define CB_LOAD(r_) do { _Pragma("unroll") for (int k = 0; k < 4; ++k) { const int slot = __builtin_amdgcn_readlane(myslot, 4 * ((r_) - r0) + k); const bf16_t* ep = EOUT + (size_t)slot * DM; \
            _Pragma("unroll") for (int j = 0; j < 4; ++j) ne[k][j] = *(const u32x2*)(ep + 4 * lane + 256 * j); } \
            _Pragma("unroll") for (int j = 0; j < 4; ++j) nx[j] = *(const f32x4*)(X + (size_t)(r_) * DM + 4 * lane + 256 * j); } while (0)
        f32x4 v[4]; u32x2 ce[4][4];
#pragma unroll 1
        for (int r = r0; r < r0 + RPW; ++r) {
            if (r == r0) {
#pragma unroll
                for (int ri = 0; ri < 1; ++ri) CB_LOAD(r0); }
#pragma unroll
            for (int k = 0; k < 4; ++k)
#pragma unroll
                for (int j = 0; j < 4; ++j) ce[k][j] = ne[k][j];
#pragma unroll
            for (int j = 0; j < 4; ++j) v[j] = nx[j];
            if (r + 1 < r0 + RPW) CB_LOAD(r + 1);
            f32x4 y[4];
#pragma unroll
            for (int j = 0; j < 4; ++j) { const float z0 = zero_op(); y[j] = (f32x4){z0, z0, z0, z0}; }
#ifndef DBG_SKIP_MOE
#pragma unroll
            for (int k = 0; k < 4; ++k)
#pragma unroll
                for (int j = 0; j < 4; ++j) { const u32x2 w = ce[k][j]; y[j].x += bflo(w.x); y[j].y += bfhi(w.x); y[j].z += bflo(w.y); y[j].w += bfhi(w.y); }
#endif
#pragma unroll
            for (int j = 0; j < 4; ++j) v[j] = v[j] + gf[j] * y[j];
            const float rstd = row_rstd(v, lane);
            f32x4 h[4];
#pragma unroll
            for (int j = 0; j < 4; ++j) h[j] = v[j] * rstd * c.a[j] + c.b[j];
            if (!lastl) {
#pragma unroll
                for (int j = 0; j < 4; ++j) *(f32x4*)(XO + (size_t)r * DM + 4 * lane + 256 * j) = v[j];
                store_xn(XN + (size_t)r * DM, h, lane);
            } else {
#pragma unroll
                for (int j = 0; j < 4; ++j) *(f32x4*)((dofs ? XO : (float*)a->out) + (size_t)r * DM + 4 * lane + 256 * j) = h[j];
            }
        }
    }
}
DI f32x16 mfma32(bf16x8 a, bf16x8 b, f32x16 c) { return __builtin_amdgcn_mfma_f32_32x32x16_bf16(a, b, c, 0, 0, 0); }
typedef short v4i16_t __attribute__((ext_vector_type(4)));
DI s16x4 tr_read(LAS const unsigned char* p) { return __builtin_bit_cast(s16x4, __builtin_amdgcn_ds_read_tr16_b64_v4i16((LAS v4i16_t*)p)); }
DI int crow(int reg, int h) { return (reg & 3) + 8 * (reg >> 2) + 4 * h; }
template <int S> DI bf16x8 pack8(const f32x16& x) {
    u32x4 p; p.x = cvt_pk_bf16(x[8 * S + 0], x[8 * S + 1]); p.y = cvt_pk_bf16(x[8 * S + 2], x[8 * S + 3]); p.z = cvt_pk_bf16(x[8 * S + 4], x[8 * S + 5]); p.w = cvt_pk_bf16(x[8 * S + 6], x[8 * S + 7]);
    return __builtin_bit_cast(bf16x8, p);
}
DI bf16x8 scale8(bf16x8 v, float s) {
    u32x4 w = __builtin_bit_cast(u32x4, v); u32x4 o;
    o.x = pk2(bflo(w.x) * s, bfhi(w.x) * s); o.y = pk2(bflo(w.y) * s, bfhi(w.y) * s); o.z = pk2(bflo(w.z) * s, bfhi(w.z) * s); o.w = pk2(bflo(w.w) * s, bfhi(w.w) * s);
    return __builtin_bit_cast(bf16x8, o);
}
struct Rope8 { float c[8], d[8]; };
DI void rope_load(Rope8& r, const float* cs, const float* sn) {
    const f32x4 c0 = *(const f32x4*)cs, c1 = *(const f32x4*)(cs + 4), s0 = *(const f32x4*)sn, s1 = *(const f32x4*)(sn + 4);
#pragma unroll
    for (int j = 0; j < 4; ++j) { r.c[j] = c0[j]; r.c[4 + j] = c1[j]; r.d[j] = s0[j]; r.d[4 + j] = s1[j]; }
}
DI void rope_apply(bf16x8& a, bf16x8& b, const Rope8& r, float s) {
    const u32x4 wa = __builtin_bit_cast(u32x4, a), wb = __builtin_bit_cast(u32x4, b); u32x4 oa, ob;
#pragma unroll
    for (int p = 0; p < 4; ++p) { const float a0 = bflo(wa[p]), a1 = bfhi(wa[p]), b0 = bflo(wb[p]), b1 = bfhi(wb[p]);
        oa[p] = pk2((a0 * r.c[2 * p] - b0 * r.d[2 * p]) * s, (a1 * r.c[2 * p + 1] - b1 * r.d[2 * p + 1]) * s);
        ob[p] = pk2((b0 * r.c[2 * p] + a0 * r.d[2 * p]) * s, (b1 * r.c[2 * p + 1] + a1 * r.d[2 * p + 1]) * s); }
    asm volatile("" : "+v"(oa), "+v"(ob));
    a = __builtin_bit_cast(bf16x8, oa); b = __builtin_bit_cast(bf16x8, ob);
}
DI void rope8(bf16x8& a, bf16x8& b, const float* cs, const float* sn, float s) { Rope8 r; rope_load(r, cs, sn); rope_apply(a, b, r, s); }
template <int KB2, int PST = 4096> DI void pv_block(f32x16 (&o)[2], const f32x16& p, LAS const unsigned char* vs, int lane) {
    const int hi = lane >> 5, i16 = lane & 15, q4 = i16 >> 2, p4 = i16 & 3, blk = (lane >> 4) & 1;
    const bf16x8 pb0 = pack8<0>(p), pb1 = pack8<1>(p);
    LAS const unsigned char* base = vs + (32 * KB2 + 4 * hi + q4) * 64 + (16 * blk + 4 * p4) * 2;
#pragma unroll
    for (int dh = 0; dh < 2; ++dh) {
        const s16x4 l0 = tr_read(base + dh * PST), h0 = tr_read(base + dh * PST + 8 * 64), l1 = tr_read(base + dh * PST + 16 * 64), h1 = tr_read(base + dh * PST + 24 * 64);
        const bf16x8 v0 = __builtin_shufflevector(l0, h0, 0, 1, 2, 3, 4, 5, 6, 7), v1 = __builtin_shufflevector(l1, h1, 0, 1, 2, 3, 4, 5, 6, 7);
        o[dh] = mfma32(v0, pb0, o[dh]); o[dh] = mfma32(v1, pb1, o[dh]);
    }
}
DI void store_ot(bf16_t* orow, const f32x16 (&o)[2], float sc, int hi) {
#pragma unroll
    for (int dh = 0; dh < 2; ++dh)
#pragma unroll
        for (int g = 0; g < 4; ++g) { u32x2 w; w.x = pk2(o[dh][4 * g] * sc, o[dh][4 * g + 1] * sc); w.y = pk2(o[dh][4 * g + 2] * sc, o[dh][4 * g + 3] * sc);
            *(u32x2*)(orow + 32 * dh + 8 * g + 4 * hi) = w; }
}
DI float max3f(float a, float b, float c) { float r; asm("v_max3_f32 %0, %1, %2, %3" : "=v"(r) : "v"(a), "v"(b), "v"(c)); return r; }
DI float rowmax32(const f32x16& A, const f32x16& B) {
    float m = max3f(A[0], B[0], A[1]), n = max3f(B[1], A[2], B[2]);
#pragma unroll
    for (int i = 3; i < 15; i += 2) { m = max3f(m, A[i], B[i]); n = max3f(n, A[i + 1], B[i + 1]); }
    return max3f(m, n, fmaxf(A[15], B[15]));
}
DI void raise_ref(f32x16& p0, f32x16& p1, f32x16 (&o)[2], f32x16& negm, float& m_ref, float& l_run, bool& init, float mx, int lane) {
    mx = fmaxf(mx, shx(mx, 32, lane)); const float dl = init ? fmaxf(mx, 0.f) : mx; init = true;
    m_ref += dl; const float alpha = __builtin_amdgcn_exp2f(-dl); l_run *= alpha;
#pragma unroll
    for (int i = 0; i < 16; ++i) { o[0][i] *= alpha; o[1][i] *= alpha; p0[i] -= dl; p1[i] -= dl; negm[i] = -m_ref; }
}
template <int BIT> DI float mask_bit(float e, unsigned word) {
    unsigned m; asm("v_bfe_i32 %0, %1, %2, 1" : "=v"(m) : "v"(word), "n"(BIT));
    return __builtin_bit_cast(float, __builtin_bit_cast(unsigned, e) & m);
}
constexpr int AT_KS = 13312, AT_K0 = 0, AT_V0 = 2 * AT_KS, AT_VS = 8192;

DI void mla_unit(Frame& F, int b, int h, int qb) {
    const bf16_t* QM = (const bf16_t*)(F.ws + opq(WS_QM)); const bf16_t* KVM = (const bf16_t*)(F.ws + opq(WS_KVM)); const bf16_t* KR = (const bf16_t*)(F.ws + opq(WS_KR)); bf16_t* OUT = (bf16_t*)(F.ws + opq(WS_OMLA));
    const float* C16 = (const float*)(F.ws + opq(WS_ROPE16)); const float* S16 = C16 + (size_t)T * 16;
    const int tid = F.tid, lane = F.lane, r32 = lane & 31, hi = lane >> 5, w = F.wave;
    const int qw = qb * 256 + 32 * w; const size_t row = (size_t)b * SEQ + qw + r32;
    constexpr float QS = 0.10206207261596577f * 1.4426950408889634f;
    bf16x8 qf[6];
    { const bf16_t* qp = QM + row * 768 + h * 96 + 8 * hi;
#pragma unroll
      for (int s = 0; s < 6; ++s) qf[s] = *(const bf16x8*)(qp + 16 * s);
#pragma unroll
      for (int s = 0; s < 4; ++s) qf[s] = scale8(qf[s], QS);
      rope8(qf[4], qf[5], C16 + row * 16 + 8 * hi, S16 + row * 16 + 8 * hi, QS); }
    const int NS = 2 * (qb + 1), cw = 4 * qb + (w >> 1);
    constexpr int MK = 4 * AT_KS;
    const int kr = tid >> 3, c8 = tid & 7, kr2 = (tid >> 2) & 63, c4 = tid & 3, rp = tid >> 8;
    const bf16_t* gk = KVM + ((size_t)b * SEQ + kr) * 768 + h * 128 + 8 * c8;
    const bf16_t* gr = KR + ((size_t)b * SEQ + rp * 64 + kr2) * 32 + 8 * c4;
    const int lk = kr * 208 + c8 * 16, lr = rp * AT_KS + kr2 * 208 + 128 + c4 * 16, lv = (c8 >> 2) * 4096 + kr * 64 + (c8 & 3) * 16;
    LAS unsigned char* L = F.lds + RING_OFF;
    u32x4 rkA, rvA, rkB, rvB, rr;
#define MLA_LOAD(s) do { const bf16_t* g_ = gk + (size_t)(s) * 128 * 768; rkA = *(const u32x4*)g_; rvA = *(const u32x4*)(g_ + 64); rkB = *(const u32x4*)(g_ + 64 * 768); rvB = *(const u32x4*)(g_ + 64 * 768 + 64); rr = *(const u32x4*)(gr + (size_t)(s) * 128 * 32); } while (0)
#define MLA_WRITE(bf) do { LAS unsigned char* k_ = L + (bf) * 2 * AT_KS; LAS unsigned char* v_ = L + MK + (bf) * 2 * AT_VS; *(LAS u32x4*)(k_ + lk) = rkA; *(LAS u32x4*)(v_ + lv) = rvA; *(LAS u32x4*)(k_ + AT_KS + lk) = rkB; *(LAS u32x4*)(v_ + AT_VS + lv) = rvB; *(LAS u32x4*)(k_ + lr) = rr; } while (0)
    MLA_LOAD(0); MLA_WRITE(0);
    __syncthreads();
    float m_ref = 0.f, l_run = 0.f; bool init = false; f32x16 o[2], negm; const float zz0 = zero_op();
#pragma unroll
    for (int i = 0; i < 16; ++i) { o[0][i] = zz0; o[1][i] = zz0; negm[i] = zz0; }
    for (int s = 0; s < NS; ++s) {
        const int bf = s & 1;
        if (s + 1 < NS) MLA_LOAD(s + 1);
#pragma unroll
        for (int u2 = 0; u2 < 2; ++u2) {
            if (2 * s + u2 <= cw) {
                f32x16 p0, p1;
                LAS const unsigned char* kb = L + (bf * 2 + u2) * AT_KS + r32 * 208 + hi * 16;
#pragma unroll
                for (int s6 = 0; s6 < 6; ++s6) { const bf16x8 a0 = *(LAS const bf16x8*)(kb + 32 * s6), a1 = *(LAS const bf16x8*)(kb + 32 * 208 + 32 * s6); p0 = mfma32(a0, qf[s6], s6 == 0 ? negm : p0); p1 = mfma32(a1, qf[s6], s6 == 0 ? negm : p1); }
                asm volatile("s_nop 15\n\ts_nop 7" : "+v"(p0), "+v"(p1));
                const float mx = rowmax32(p0, p1);
                if (!init || __any(mx > 8.0f)) raise_ref(p0, p1, o, negm, m_ref, l_run, init, mx, lane);
                float ls0 = 0.f, one = 1.0f; asm volatile("" : "+v"(one));
#pragma unroll
                for (int i = 0; i < 16; ++i) { p0[i] = __builtin_amdgcn_exp2f(p0[i]); p1[i] = __builtin_amdgcn_exp2f(p1[i]); ls0 = __builtin_fmaf(p0[i], one, ls0); ls0 = __builtin_fmaf(p1[i], one, ls0); }
                l_run += ls0;
                LAS const unsigned char* vs = L + MK + (bf * 2 + u2) * AT_VS;
                pv_block<0>(o, p0, vs, lane); pv_block<1>(o, p1, vs, lane);
            }
        }
        if (s + 1 < NS) MLA_WRITE(bf ^ 1);
        __syncthreads();
    }
#undef MLA_LOAD
#undef MLA_WRITE
    const float lt = l_run + shx(l_run, 32, lane);
#ifdef DBG_ZERO_MLA
    store_ot(OUT + row * 384 + h * 64, o, zz0, hi);
#else
    store_ot(OUT + row * 384 + h * 64, o, 1.0f / lt, hi);
#endif
}

DI void sb_unit(Frame& F, int b, int h, int qb) {
    const bf16_t* PROJ = (const bf16_t*)(F.ws + opq(WS_PROJ)); bf16_t* OUT = (bf16_t*)(F.ws + opq(WS_OSB));
    const int tid = F.tid, lane = F.lane, r32 = lane & 31, hi = lane >> 5, w = F.wave;
    const int qw = qb * 256 + 32 * w, qg = qw + r32; const size_t row = (size_t)b * SEQ + qg;
    bf16x8 qf[4];
    { const bf16_t* qp = PROJ + row * NPROJ + C_SBQ + h * 64 + 8 * hi;
#pragma unroll
      for (int s = 0; s < 4; ++s) qf[s] = *(const bf16x8*)(qp + 16 * s); }
    const int t_hi = 4 * qb + 3, cw = 4 * qb + (w >> 1);
    const int kr = tid >> 3, c8 = tid & 7;
    const bf16_t* gk = PROJ + ((size_t)b * SEQ + kr) * NPROJ + C_SBK + h * 64 + 8 * c8;
    const bf16_t* gv = PROJ + ((size_t)b * SEQ + kr) * NPROJ + C_SBV + h * 64 + 8 * c8;
    const int lk = kr * 144 + c8 * 16, lv = (c8 >> 2) * 4096 + kr * 64 + (c8 & 3) * 16;
    LAS unsigned char* L = F.lds + RING_OFF;
    volatile LAS unsigned* dflag = F.MISC + 16;
    u32x4 rk, rv;
#define SB_LOAD(t) do { rk = *(const u32x4*)(gk + (size_t)(t) * 64 * NPROJ); rv = *(const u32x4*)(gv + (size_t)(t) * 64 * NPROJ); } while (0)
#define SB_WRITE(bf) do { *(LAS u32x4*)(L + AT_K0 + (bf) * AT_KS + lk) = rk; *(LAS u32x4*)(L + AT_V0 + (bf) * AT_VS + lv) = rv; } while (0)
    SB_LOAD(t_hi); SB_WRITE(0);
    __syncthreads();
    float carry = 0.f; bool done = false; f32x16 o[2]; const float zz0 = zero_op();
#pragma unroll
    for (int i = 0; i < 16; ++i) { o[0][i] = zz0; o[1][i] = zz0; }
    int kt = t_hi;
    for (int it = 0;; ++it, --kt) {
        const int bf = it & 1;
        if (kt > 0) SB_LOAD(kt - 1);
        if (kt <= cw && !done) {
            f32x16 z[2];
#pragma unroll
            for (int i = 0; i < 16; ++i) { z[0][i] = zz0; z[1][i] = zz0; }
            LAS const unsigned char* kb = L + AT_K0 + bf * AT_KS + r32 * 144 + hi * 16;
#pragma unroll
            for (int s = 0; s < 4; ++s) { const bf16x8 a0 = *(LAS const bf16x8*)(kb + 32 * s), a1 = *(LAS const bf16x8*)(kb + 32 * 144 + 32 * s); z[0] = mfma32(a0, qf[s], z[0]); z[1] = mfma32(a1, qf[s], z[1]); }
            const int kbase = 64 * kt;
            float own[8];
#pragma unroll
            for (int kb2 = 0; kb2 < 2; ++kb2)
#pragma unroll
                for (int g = 0; g < 4; ++g) {
                    float lsv[4];
#pragma unroll
                    for (int j = 0; j < 4; ++j) { const int i = 4 * g + j; const float zz = z[kb2][i] * 0.125f; const int key = kbase + 32 * kb2 + crow(i, hi);
                        const float sp = fmaxf(zz, 0.f) + 0.6931471805599453f * __builtin_amdgcn_logf(1.0f + __builtin_amdgcn_exp2f(-1.4426950408889634f * fabsf(zz)));
                        const bool valid = key < qg; lsv[j] = valid ? -sp : 0.f; z[kb2][i] = valid ? (zz - sp) : -INFINITY; }
                    const float e2 = lsv[3], e1 = e2 + lsv[2], e0 = e1 + lsv[1];
                    z[kb2][4 * g + 2] += e2; z[kb2][4 * g + 1] += e1; z[kb2][4 * g + 0] += e0;
                    own[4 * kb2 + g] = e0 + lsv[0];
                }
            float par[8];
#pragma unroll
            for (int g = 0; g < 8; ++g) par[g] = shx(own[g], 32, lane);
            float so = 0.f, sp_ = 0.f;
#pragma unroll
            for (int g = 7; g >= 0; --g) {
                const float off = carry + so + (hi ? sp_ : sp_ + par[g]);
#pragma unroll
                for (int j = 0; j < 4; ++j) { const int kb2 = g >> 2, i = 4 * (g & 3) + j; z[kb2][i] = __builtin_amdgcn_exp2f(1.4426950408889634f * (z[kb2][i] + off)); }
                so += own[g]; sp_ += par[g];
            }
            carry += hi ? (sp_ + so) : (so + sp_);
            LAS const unsigned char* vs = L + AT_V0 + bf * AT_VS;
            pv_block<0>(o, z[0], vs, lane); pv_block<1>(o, z[1], vs, lane);
            done = __all(carry < -104.0f);
        }
        if (lane == 0) dflag[bf * 8 + w] = (done || kt == 0) ? 1u : 0u;
        if (kt > 0) SB_WRITE(bf ^ 1);
        __syncthreads();
        if (kt == 0) break;
        bool alld = true;
#pragma unroll
        for (int i = 0; i < 8; ++i) alld = alld && (dflag[bf * 8 + i] != 0u);
        if (alld) break;
    }
#undef SB_LOAD
#undef SB_WRITE
#ifdef DBG_ZERO_SB
    store_ot(OUT + row * 384 + h * 64, o, zz0, hi);
#else
    store_ot(OUT + row * 384 + h * 64, o, 1.0f, hi);
#endif
}
constexpr int DS_HIST = 0, DS_BITS = 65536, DS_VST = 98304, DS_NB = 512, DS_CAP = 256, DS_TOPK = 256;
constexpr int DM_ABOVE = 160, DM_CNT = 192;
constexpr int DL_INV = DS_VST, DL_OFF = DS_VST + 3 * 128, DL_BIN = DS_VST + 6 * 128;

DI int ds_bin(float s, float inv, float off) { const float t = __builtin_fmaf(s, inv, off); return (int)__builtin_amdgcn_fmed3f(t, 0.f, (float)(DS_NB - 1)); }

DI void ds_scores(float (&sc)[16], const bf16x8 k0, const bf16x8 k1, const bf16x8 (&qt)[2], const bf16x8 (&qi)[8][2], const float (&wh)[8], float zz0) {
    f32x16 z;
#pragma unroll
    for (int i = 0; i < 16; ++i) z[i] = zz0;
    f32x16 lin = mfma32(k0, qt[0], z); lin = mfma32(k1, qt[1], lin);
    f32x16 cur = mfma32(k0, qi[0][0], z); cur = mfma32(k1, qi[0][1], cur);
#pragma unroll
    for (int i = 0; i < 16; ++i) sc[i] = lin[i];
    __builtin_amdgcn_sched_barrier(0);
#pragma unroll
    for (int h = 0; h < 8; ++h) {
        f32x16 nxt = cur;
        if (h < 7) { nxt = mfma32(k0, qi[h + 1][0], z); nxt = mfma32(k1, qi[h + 1][1], nxt); }
#pragma unroll
        for (int i = 0; i < 16; ++i) sc[i] = __builtin_fmaf(wh[h], __builtin_fabsf(cur[i]), sc[i]);
        cur = nxt;
        __builtin_amdgcn_sched_barrier(0);
    }
    asm volatile("" : "+v"(sc[0]), "+v"(sc[1]), "+v"(sc[2]), "+v"(sc[3]), "+v"(sc[4]), "+v"(sc[5]), "+v"(sc[6]), "+v"(sc[7]));
    asm volatile("" : "+v"(sc[8]), "+v"(sc[9]), "+v"(sc[10]), "+v"(sc[11]), "+v"(sc[12]), "+v"(sc[13]), "+v"(sc[14]), "+v"(sc[15]));
}

DI void dsa_select_unit(Frame& F, int b, int qt_, int l) {
    const bf16_t* PROJ = (const bf16_t*)(F.ws + opq(WS_PROJ)); const bf16_t* IK = (const bf16_t*)(F.ws + opq(WS_IK));
    const float* IW = (const float*)(F.ws + opq(WS_IW));
    const float* C16 = (const float*)(F.ws + opq(WS_ROPE16)); const float* S16 = C16 + (size_t)T * 16;
    const int tid = F.tid, lane = F.lane, r32 = lane & 31, hi = lane >> 5, w = F.wave;
    const int q0 = qt_ * 32, chunk = q0 >> 6, NK = 64 * (chunk + 1), nblk = NK >> 5;
    const size_t row = (size_t)b * SEQ + q0 + r32, krow0 = (size_t)b * SEQ;
    LAS unsigned char* L = F.lds + RING_OFF;
    LAS unsigned* HIST = (LAS unsigned*)(L + DS_HIST); LAS unsigned* BITS = (LAS unsigned*)(L + DS_BITS);
    volatile LAS unsigned* M = F.MISC;
    const float zz0 = zero_op();
    { unsigned z0 = 0u; asm volatile("" : "+v"(z0));
      for (int i = tid; i < (DS_BITS + 32768) / 16; i += NTHR) *(LAS u32x4*)(L + i * 16) = (u32x4){z0, z0, z0, z0}; }
    if (NK <= DS_TOPK) {
        __syncthreads();
        for (int i = tid; i < nblk * 32; i += NTHR) BITS[i] = 0xFFFFFFFFu;
        __syncthreads();
    } else {
        bf16x8 qi[8][2], qt[2]; float wh[8];
        float B = 0.f;
        { const bf16_t* qp = PROJ + row * NPROJ + C_IQ + 8 * hi;
          Rope8 rp; rope_load(rp, C16 + row * 16 + 8 * hi, S16 + row * 16 + 8 * hi);
          const f32x4 w0 = *(const f32x4*)(IW + row * 8), w1 = *(const f32x4*)(IW + row * 8 + 4);
          wh[0] = 0.5f * w0[0]; wh[1] = 0.5f * w0[1]; wh[2] = 0.5f * w0[2]; wh[3] = 0.5f * w0[3]; wh[4] = 0.5f * w1[0]; wh[5] = 0.5f * w1[1]; wh[6] = 0.5f * w1[2]; wh[7] = 0.5f * w1[3];
          float ql[2][8];
#pragma unroll
          for (int s = 0; s < 2; ++s)
#pragma unroll
              for (int j = 0; j < 8; ++j) ql[s][j] = zz0;
#pragma unroll
          for (int h = 0; h < 8; ++h) { qi[h][0] = *(const bf16x8*)(qp + 32 * h); qi[h][1] = *(const bf16x8*)(qp + 32 * h + 16); }
          __builtin_amdgcn_sched_barrier(0);
#pragma unroll
          for (int h = 0; h < 8; ++h) {
              rope_apply(qi[h][0], qi[h][1], rp, 1.0f);
              float n2 = 0.f;
#pragma unroll
              for (int s = 0; s < 2; ++s)
#pragma unroll
                  for (int j = 0; j < 8; ++j) { const float v = bf2f((unsigned short)qi[h][s][j]); n2 = __builtin_fmaf(v, v, n2); ql[s][j] = __builtin_fmaf(wh[h], v, ql[s][j]); }
              n2 += shx(n2, 32, lane); B += 2.0f * fabsf(wh[h]) * sqrtf(n2);
              __builtin_amdgcn_sched_barrier(0); }
#pragma unroll
          for (int s = 0; s < 2; ++s) { u32x4 p; p.x = pk2(ql[s][0], ql[s][1]); p.y = pk2(ql[s][2], ql[s][3]); p.z = pk2(ql[s][4], ql[s][5]); p.w = pk2(ql[s][6], ql[s][7]); asm volatile("" : "+v"(p)); qt[s] = __builtin_bit_cast(bf16x8, p); } }
        { const float kmax = sqrtf(__builtin_bit_cast(float, __hip_atomic_load(F.ctl + CW_KMAX + 64 * (l * 2 + b), RLX_AGENT)));
          B = fmaxf(B * kmax * 1.03f, 1e-20f);
          if (w == 0 && hi == 0) { ((LAS float*)(L + DL_INV))[r32] = 1024.0f / B; ((LAS float*)(L + DL_OFF))[r32] = 256.0f; M[DM_ABOVE + r32] = 0u; } }
        __syncthreads();
        const bf16_t* kbase = IK + (krow0 + r32) * 32 + 8 * hi;
#define DS_LOADK(K0_, K1_, kb_) do { const bf16_t* kp_ = kbase + (size_t)(kb_) * 32 * 32; K0_ = *(const bf16x8*)kp_; K1_ = *(const bf16x8*)(kp_ + 16); } while (0)
        int lev = 0;
        for (;;) {
            float pinv[3], poff[3]; int pbin[3];
#pragma unroll
            for (int v = 0; v < 3; ++v) { pinv[v] = ((LAS float*)(L + DL_INV))[v * 32 + r32]; poff[v] = ((LAS float*)(L + DL_OFF))[v * 32 + r32]; pbin[v] = ((LAS int*)(L + DL_BIN))[v * 32 + r32]; }
#ifdef DBG_REP_S1
            for (int rep_ = 0; rep_ < 2; ++rep_)
#endif
            {
#ifdef DBG_REP_S1
                if (rep_) { __syncthreads(); unsigned z0 = 0u; asm volatile("" : "+v"(z0)); for (int i = tid; i < 65536 / 16; i += NTHR) *(LAS u32x4*)(L + DS_HIST + i * 16) = (u32x4){z0, z0, z0, z0}; __syncthreads(); }
#endif
                bf16x8 c0, c1, n0, n1; c0 = c1 = n0 = n1 = qt[0];
                if (w < nblk) DS_LOADK(c0, c1, w);
                if (lev == 0) {
                    const float inv0 = pinv[0], off0 = poff[0];
                    for (int kb = w; kb < nblk; kb += NWAVES) {
                        if (kb + NWAVES < nblk) DS_LOADK(n0, n1, kb + NWAVES);
                        float sc[16]; ds_scores(sc, c0, c1, qt, qi, wh, zz0);
#pragma unroll
                        for (int i = 0; i < 16; ++i) { const int bin = ds_bin(sc[i], inv0, off0);
                            __hip_atomic_fetch_add((LAS unsigned*)((LAS unsigned char*)HIST + (bin << 7) + (r32 << 2)), 1u, __ATOMIC_RELAXED, __HIP_MEMORY_SCOPE_WORKGROUP); }
                        c0 = n0; c1 = n1;
                    }
                } else {
                    for (int kb = w; kb < nblk; kb += NWAVES) {
                        if (kb + NWAVES < nblk) DS_LOADK(n0, n1, kb + NWAVES);
                        float sc[16]; ds_scores(sc, c0, c1, qt, qi, wh, zz0);
#pragma unroll
                        for (int i = 0; i < 16; ++i) { int bin = ds_bin(sc[i], pinv[0], poff[0]); bool in = (bin == pbin[0]); bin = ds_bin(sc[i], pinv[1], poff[1]);
                            if (lev >= 2) { in = in && (bin == pbin[1]); bin = ds_bin(sc[i], pinv[2], poff[2]); }
                            if (in) __hip_atomic_fetch_add(HIST + bin * 32 + r32, 1u, __ATOMIC_RELAXED, __HIP_MEMORY_SCOPE_WORKGROUP); }
                        c0 = n0; c1 = n1;
                    }
                }
            }
            __syncthreads();
#pragma unroll 1
            for (int sq = 0; sq < 4; ++sq) {
                int lane = F.lane; asm volatile("" : "+v"(lane));
                const int q = 4 * w + sq; unsigned hw[8]; unsigned mysum = 0;
#pragma unroll
                for (int i = 0; i < 8; ++i) { hw[i] = HIST[(8 * lane + i) * 32 + q]; mysum += hw[i]; }
                unsigned suf = mysum;
#pragma unroll
                for (int o = 1; o < 64; o <<= 1) { const unsigned t = (unsigned)__builtin_amdgcn_ds_bpermute(((lane + o) & 63) << 2, (int)suf); if (lane + o < 64) suf += t; }
                const unsigned above0 = M[DM_ABOVE + q]; const unsigned need = DS_TOPK - above0;
                const unsigned long long bal = __ballot(suf >= need);
                const int Ls = 63 - __builtin_clzll(bal | 1ull);
                const unsigned sufL = (unsigned)__builtin_amdgcn_ds_bpermute(Ls << 2, (int)suf), sumL = (unsigned)__builtin_amdgcn_ds_bpermute(Ls << 2, (int)mysum);
                unsigned acc = sufL - sumL; int bstar = 8 * Ls; unsigned cstar = 0;
#pragma unroll
                for (int i = 7; i >= 0; --i) { const unsigned c = (unsigned)__builtin_amdgcn_ds_bpermute(Ls << 2, (int)hw[i]);
                    if (cstar == 0u) { if (acc + c >= need) { bstar = 8 * Ls + i; cstar = c; } else acc += c; } }
                if (lane == 0) { ((LAS int*)(L + DL_BIN))[lev * 32 + q] = bstar; M[DM_ABOVE + q] = above0 + acc; M[DM_CNT + q] = cstar; }
            }
            __syncthreads();
            unsigned mxc = 0;
#pragma unroll 1
            for (int q = 0; q < 32; ++q) { const unsigned c = M[DM_CNT + q]; mxc = c > mxc ? c : mxc; }
            if (mxc <= (unsigned)DS_CAP || lev == 2) break;
            if (w == 0 && hi == 0) { const float pinv_ = ((LAS float*)(L + DL_INV))[lev * 32 + r32], poff_ = ((LAS float*)(L + DL_OFF))[lev * 32 + r32]; const int pb_ = ((LAS int*)(L + DL_BIN))[lev * 32 + r32];
                ((LAS float*)(L + DL_INV))[(lev + 1) * 32 + r32] = pinv_ * 511.5f; ((LAS float*)(L + DL_OFF))[(lev + 1) * 32 + r32] = (poff_ - (float)pb_) * 511.5f; }
            { unsigned z0 = 0u; asm volatile("" : "+v"(z0));
              for (int i = tid; i < 65536 / 16; i += NTHR) *(LAS u32x4*)(L + DS_HIST + i * 16) = (u32x4){z0, z0, z0, z0}; }
            ++lev;
            __syncthreads();
        }
        __syncthreads();
        if (tid < 32) M[DM_CNT + tid] = 0u;
        __syncthreads();
        {
            float pinv[3], poff[3]; int pbin[3];
#pragma unroll
            for (int v = 0; v < 3; ++v) { pinv[v] = ((LAS float*)(L + DL_INV))[v * 32 + r32]; poff[v] = ((LAS float*)(L + DL_OFF))[v * 32 + r32]; pbin[v] = ((LAS int*)(L + DL_BIN))[v * 32 + r32]; }
            LAS unsigned long long* CAND = (LAS unsigned long long*)(L + DS_HIST);
#define DS_SELBLK(K0_, K1_, kb_) do { float sc[16]; ds_scores(sc, K0_, K1_, qt, qi, wh, zz0); \
            unsigned word = 0u; const unsigned kinv = 0xFFFFu - (unsigned)((kb_) * 32 + 4 * hi); \
            _Pragma("unroll") for (int i = 0; i < 16; ++i) { \
                int bin = ds_bin(sc[i], pinv[0], poff[0]); bool sel = bin > pbin[0], eq = bin == pbin[0]; \
                if (lev >= 1) { bin = ds_bin(sc[i], pinv[1], poff[1]); sel = sel || (eq && bin > pbin[1]); eq = eq && bin == pbin[1]; } \
                if (lev >= 2) { bin = ds_bin(sc[i], pinv[2], poff[2]); sel = sel || (eq && bin > pbin[2]); eq = eq && bin == pbin[2]; } \
                if (sel) word |= 1u << crow(i, 0); \
                if (eq) { const unsigned slot = __hip_atomic_fetch_add((LAS unsigned*)(M + DM_CNT + r32), 1u, __ATOMIC_RELAXED, __HIP_MEMORY_SCOPE_WORKGROUP); \
                    if (slot < (unsigned)DS_CAP) CAND[r32 * DS_CAP + slot] = ((unsigned long long)f_sortable(sc[i]) << 32) | (unsigned)(kinv - (unsigned)crow(i, 0)); } } \
            word <<= 4 * hi; \
            if (word) __hip_atomic_fetch_or(BITS + (kb_) * 32 + r32, word, __ATOMIC_RELAXED, __HIP_MEMORY_SCOPE_WORKGROUP); } while (0)
#ifdef DBG_REP_S2
            for (int rep_ = 0; rep_ < 2; ++rep_)
#endif
            {
#ifdef DBG_REP_S2
                if (rep_) { __syncthreads(); if (tid < 32) M[DM_CNT + tid] = 0u; __syncthreads(); }
#endif
                bf16x8 c0, c1, n0, n1; c0 = c1 = n0 = n1 = qt[0];
                if (w < nblk) DS_LOADK(c0, c1, w);
                if (lev == 0) {
                    const float inv0 = pinv[0], off0 = poff[0];
                    const float T1 = pbin[0] >= DS_NB - 1 ? INFINITY : (float)(pbin[0] + 1), T0 = pbin[0] <= 0 ? -INFINITY : (float)pbin[0];
                    for (int kb = w; kb < nblk; kb += NWAVES) {
                        if (kb + NWAVES < nblk) DS_LOADK(n0, n1, kb + NWAVES);
                        float sc[16]; ds_scores(sc, c0, c1, qt, qi, wh, zz0);
                        unsigned cb = 0u; const unsigned kinv = 0xFFFFu - (unsigned)(kb * 32 + 4 * hi);
#pragma unroll
                        for (int i = 15; i >= 0; --i) { const float t = __builtin_fmaf(sc[i], inv0, off0); const bool sel = t >= T1, eq = (t >= T0) && !sel;
                            cb = cb * 2u + (sel ? 1u : 0u);
                            if (eq) { const unsigned slot = __hip_atomic_fetch_add((LAS unsigned*)(M + DM_CNT + r32), 1u, __ATOMIC_RELAXED, __HIP_MEMORY_SCOPE_WORKGROUP);
                                if (slot < (unsigned)DS_CAP) CAND[r32 * DS_CAP + slot] = ((unsigned long long)f_sortable(sc[i]) << 32) | (unsigned)(kinv - (unsigned)crow(i, 0)); } }
                        unsigned word = (cb & 0xFu) | ((cb & 0xF0u) << 4) | ((cb & 0xF00u) << 8) | ((cb & 0xF000u) << 12);
                        word <<= 4 * hi;
                        if (word) __hip_atomic_fetch_or(BITS + kb * 32 + r32, word, __ATOMIC_RELAXED, __HIP_MEMORY_SCOPE_WORKGROUP);
                        c0 = n0; c1 = n1;
                    }
                } else
                for (int kb = w; kb < nblk; kb += NWAVES) {
                    if (kb + NWAVES < nblk) DS_LOADK(n0, n1, kb + NWAVES);
                    DS_SELBLK(c0, c1, kb);
                    c0 = n0; c1 = n1;
                }
            }
#undef DS_SELBLK
            __syncthreads();
#ifdef DBG_REP_RES
            for (int rep_ = 0; rep_ < 2; ++rep_)
#endif
#pragma unroll 1
            for (int sq = 0; sq < 4; ++sq) {
                int lane = F.lane; asm volatile("" : "+v"(lane));
                const int q = 4 * w + sq; unsigned cnt = M[DM_CNT + q]; cnt = cnt < (unsigned)DS_CAP ? cnt : (unsigned)DS_CAP;
                const unsigned need = DS_TOPK - M[DM_ABOVE + q];
                const unsigned cnt4 = cnt & ~3u;
                for (unsigned i = lane; i < cnt; i += 64) { const unsigned long long ki = CAND[q * DS_CAP + i]; unsigned rank = 0; unsigned j = 0;
                    for (; j < cnt4; j += 4) { const unsigned long long x0 = CAND[q * DS_CAP + j], x1 = CAND[q * DS_CAP + j + 1], x2 = CAND[q * DS_CAP + j + 2], x3 = CAND[q * DS_CAP + j + 3];
                        rank += (x0 > ki ? 1u : 0u) + (x1 > ki ? 1u : 0u) + (x2 > ki ? 1u : 0u) + (x3 > ki ? 1u : 0u); }
                    for (; j < cnt; ++j) rank += (CAND[q * DS_CAP + j] > ki) ? 1u : 0u;
                    if (rank < need) { const unsigned key = 0xFFFFu - (unsigned)(ki & 0xFFFFull); __hip_atomic_fetch_or(BITS + (key >> 5) * 32 + q, 1u << (key & 31), __ATOMIC_RELAXED, __HIP_MEMORY_SCOPE_WORKGROUP); } }
            }
            __syncthreads();
        }
#undef DS_LOADK
    }
    {
        unsigned* BM = (unsigned*)(F.ws + opq(WS_BM)) + (size_t)b * 256 * SEQ + q0;
        for (int i = tid; i < nblk * 32; i += NTHR) __hip_atomic_store(BM + (size_t)(i >> 5) * SEQ + (i & 31), BITS[i], RLX_AGENT);
        asm volatile("s_waitcnt vmcnt(0)" ::: "memory");
        __syncthreads();
        if (tid == 0) __hip_atomic_store(F.ctl + CW_SELF + b * 256 + qt_, (unsigned)(l + 1), RLX_AGENT);
    }
}

DI void dsa_attn_unit(Frame& F, int b, int hd, int qb, int l) {
    const bf16_t* PROJ = (const bf16_t*)(F.ws + opq(WS_PROJ)); const bf16_t* DK = (const bf16_t*)(F.ws + opq(WS_DK)); bf16_t* OUT = (bf16_t*)(F.ws + opq(WS_ODSA));
    const float* C32 = (const float*)(F.ws + opq(WS_ROPE32)); const float* S32 = C32 + (size_t)T * 32;
    const int tid = F.tid, lane = F.lane, r32 = lane & 31, hi = lane >> 5, w = F.wave;
    const int qw = qb * 256 + 32 * w; const size_t row = (size_t)b * SEQ + qw + r32;
    if (w == 0) { unsigned sp = 0;
        for (;;) { const unsigned fv = lane < 8 ? __hip_atomic_load(F.ctl + CW_SELF + b * 256 + 8 * qb + lane, RLX_AGENT) : (unsigned)(l + 1);
            if (__all(fv == (unsigned)(l + 1)) || ++sp > (1u << 22)) break; __builtin_amdgcn_s_sleep(2); }
        __builtin_amdgcn_fence(__ATOMIC_ACQUIRE, "agent"); }
    asm volatile("s_waitcnt vmcnt(0)" ::: "memory");
    __syncthreads();
    constexpr float QS = 0.125f * 1.4426950408889634f;
    bf16x8 qf[4];
    { const bf16_t* qp = PROJ + row * NPROJ + C_DQ + hd * 64 + 8 * hi;
#pragma unroll
      for (int s = 0; s < 4; ++s) qf[s] = *(const bf16x8*)(qp + 16 * s);
      rope8(qf[0], qf[2], C32 + row * 32 + 8 * hi, S32 + row * 32 + 8 * hi, QS); rope8(qf[1], qf[3], C32 + row * 32 + 16 + 8 * hi, S32 + row * 32 + 16 + 8 * hi, QS); }
    const int NT = 4 * (qb + 1), cw = 4 * qb + (w >> 1);
    const int kr = tid >> 3, c8 = tid & 7;
    const bf16_t* gk = DK + ((size_t)b * SEQ + kr) * 256 + hd * 64 + 8 * c8;
    const bf16_t* gv = PROJ + ((size_t)b * SEQ + kr) * NPROJ + C_DV + hd * 64 + 8 * c8;
    const unsigned* bm = (const unsigned*)(F.ws + opq(WS_BM)) + (size_t)b * 256 * SEQ + qw + r32;
    const int lk = kr * 144 + c8 * 16, lv = (c8 >> 2) * 4096 + kr * 64 + (c8 & 3) * 16;
    LAS unsigned char* L = F.lds + RING_OFF;
    constexpr int MK = 4 * AT_KS;
    u32x4 rkA, rvA, rkB, rvB; unsigned nA0, nA1, nB0, nB1;
#define DA_LOAD(t) do { rkA = *(const u32x4*)(gk + (size_t)(t) * 64 * 256); rvA = *(const u32x4*)(gv + (size_t)(t) * 64 * NPROJ); \
        rkB = *(const u32x4*)(gk + (size_t)((t) + 1) * 64 * 256); rvB = *(const u32x4*)(gv + (size_t)((t) + 1) * 64 * NPROJ); \
        nA0 = __hip_atomic_load(bm + (size_t)(2 * (t)) * SEQ, RLX_AGENT); nA1 = __hip_atomic_load(bm + (size_t)(2 * (t) + 1) * SEQ, RLX_AGENT); \
        nB0 = __hip_atomic_load(bm + (size_t)(2 * (t) + 2) * SEQ, RLX_AGENT); nB1 = __hip_atomic_load(bm + (size_t)(2 * (t) + 3) * SEQ, RLX_AGENT); } while (0)
#define DA_WRITE(bf) do { LAS unsigned char* k_ = L + (bf) * 2 * AT_KS; LAS unsigned char* v_ = L + MK + (bf) * 2 * AT_VS; \
        *(LAS u32x4*)(k_ + lk) = rkA; *(LAS u32x4*)(v_ + lv) = rvA; *(LAS u32x4*)(k_ + AT_KS + lk) = rkB; *(LAS u32x4*)(v_ + AT_VS + lv) = rvB; } while (0)
    DA_LOAD(0); DA_WRITE(0);
    unsigned cA0 = nA0, cA1 = nA1, cB0 = nB0, cB1 = nB1;
    __syncthreads();
    float m_ref = 0.f, l_run = 0.f; bool init = false; f32x16 o[2], negm; const float zz0 = zero_op();
#pragma unroll
    for (int i = 0; i < 16; ++i) { o[0][i] = zz0; o[1][i] = zz0; negm[i] = zz0; }
    for (int t = 0; t < NT; t += 2) {
        const int bf = (t >> 1) & 1;
        if (t + 2 < NT) DA_LOAD(t + 2);
#pragma unroll
        for (int u2 = 0; u2 < 2; ++u2) {
        if (t + u2 <= cw) {
            const unsigned wd0 = (u2 ? cB0 : cA0) >> (4 * hi), wd1 = (u2 ? cB1 : cA1) >> (4 * hi);
            f32x16 p0, p1;
            LAS const unsigned char* kb = L + (bf * 2 + u2) * AT_KS + r32 * 144 + hi * 16;
#pragma unroll
            for (int s = 0; s < 4; ++s) { const bf16x8 a0 = *(LAS const bf16x8*)(kb + 32 * s), a1 = *(LAS const bf16x8*)(kb + 32 * 144 + 32 * s); p0 = mfma32(a0, qf[s], s == 0 ? negm : p0); p1 = mfma32(a1, qf[s], s == 0 ? negm : p1); }
            asm volatile("s_nop 15\n\ts_nop 7" : "+v"(p0), "+v"(p1));
            const float mx = rowmax32(p0, p1);
            if (!init || __any(mx > 8.0f)) raise_ref(p0, p1, o, negm, m_ref, l_run, init, mx, lane);
            float ls0 = 0.f, one = 1.0f; asm volatile("" : "+v"(one));
#define DA_E(i) do { p0[i] = mask_bit<((i) & 3) + 8 * ((i) >> 2)>(__builtin_amdgcn_exp2f(p0[i]), wd0); p1[i] = mask_bit<((i) & 3) + 8 * ((i) >> 2)>(__builtin_amdgcn_exp2f(p1[i]), wd1); ls0 = __builtin_fmaf(p0[i], one, ls0); ls0 = __builtin_fmaf(p1[i], one, ls0); } while (0)
            DA_E(0); DA_E(1); DA_E(2); DA_E(3); DA_E(4); DA_E(5); DA_E(6); DA_E(7); DA_E(8); DA_E(9); DA_E(10); DA_E(11); DA_E(12); DA_E(13); DA_E(14); DA_E(15);
#undef DA_E
            l_run += ls0;
            LAS const unsigned char* vs = L + MK + (bf * 2 + u2) * AT_VS;
            pv_block<0>(o, p0, vs, lane); pv_block<1>(o, p1, vs, lane);
        }
        }
        if (t + 2 < NT) { DA_WRITE(bf ^ 1); cA0 = nA0; cA1 = nA1; cB0 = nB0; cB1 = nB1; }
        __syncthreads();
    }
#undef DA_LOAD
#undef DA_WRITE
    const float lt = l_run + shx(l_run, 32, lane);
    store_ot(OUT + row * 256 + hd * 64, o, 1.0f / lt, hi);
}
constexpr int N_SEL = T / 32, N_MLA = BATCH * 6 * 32, N_DSAA = BATCH * 4 * 32, N_SB = BATCH * 6 * 32, N_ATT = N_SEL + N_MLA + N_DSAA + N_SB;
DI void p_attention(Frame& F, ArgsP a, int l, int qslot) {
    for (;;) {
        __syncthreads();
        if (F.tid == 0) F.MISC[12] = __hip_atomic_fetch_add(F.ctl + CW_QATT + 64 * qslot, 1u, RLX_AGENT);
        __syncthreads();
        int u = (int)F.MISC[12];
        if (u >= N_ATT + N_CVT) break;
        { int t_ = threadIdx.x; asm volatile("" : "+v"(t_)); F.tid = t_; F.lane = t_ & 63; }
        if (u < 3 * N_CVT) { const int q3 = u / 3; if (u - 3 * q3 == 2) { cvt_unit(F, a, l, q3); continue; } u -= q3; } else u -= N_CVT;
        if (u < N_SEL) { const int qt = 255 - u / 2, b = u & 1; dsa_select_unit(F, b, qt, l); }
        else if (u < N_SEL + N_MLA + N_DSAA) {
            const int v = u - N_SEL, qb = 31 - v / 20, r = v % 20;
            if (r < 8) dsa_attn_unit(F, r / 4, r % 4, qb, l); else mla_unit(F, (r - 8) / 6, (r - 8) % 6, qb);
        }
        else { const int v = u - N_SEL - N_MLA - N_DSAA; const int qb = 31 - v / 12, bh = v % 12; sb_unit(F, bh / 6, bh % 6, qb); }
    }
}

constexpr int PH_PER_LAYER = 10, N_PHASES = 2 + DEPTH * PH_PER_LAYER;
__global__ void __launch_bounds__(NTHR, 2) mk_fwd(Args a_unused) {
    ArgsP a = (ArgsP)__builtin_amdgcn_kernarg_segment_ptr();
    extern __shared__ __attribute__((aligned(16))) unsigned char lds_raw[];
    Frame F;
    F.lds = (LAS unsigned char*)lds_raw; F.MISC = (volatile LAS unsigned*)(F.lds + MISC_OFF);
    F.tid = threadIdx.x; F.lane = F.tid & 63; F.wave = __builtin_amdgcn_readfirstlane(F.tid >> 6);
    F.G = gridDim.x; F.bx = blockIdx.x; F.gw = blockIdx.x * NWAVES + F.wave; F.NGW = F.G * NWAVES; F.ws = (unsigned char*)a->ws; F.ctl = (gu32*)((unsigned char*)a->ws + WS_CTL);
    for (int u = F.tid; u < 256; u += NTHR) F.MISC[u] = 0u;
    __syncthreads();
    const int lo = a->ph_lo, hi = a->ph_hi;
    const bool one = (hi - lo) > 1;
    XcdBarrier bar; bar.bar = (unsigned*)(F.ctl + CW_BAR); bar.x = 0; bar.st = nullptr;
    if (one) bar = xcd_barrier_post((unsigned*)(F.ctl + CW_BAR), F.MISC + 8);
#define IN(k) (lo <= (k) && (k) < hi)
#define XN ((bf16_t*)(F.ws + opq(WS_XN)))
#define PROJ ((bf16_t*)(F.ws + opq(WS_PROJ)))
#define REFRESH() do { int t_ = threadIdx.x; asm volatile("" : "+v"(t_)); F.tid = t_; F.lane = t_ & 63; size_t z_ = 0; asm volatile("" : "+s"(z_)); a = (ArgsP)__builtin_amdgcn_kernarg_segment_ptr(); asm volatile("" : "+s"(a)); F.ws = (unsigned char*)a->ws + z_; F.ctl = (gu32*)(F.ws + opq(WS_CTL)); { LAS unsigned char* l_ = (LAS unsigned char*)lds_raw; asm volatile("" : "+s"(l_)); F.lds = l_; F.MISC = (volatile LAS unsigned*)(l_ + MISC_OFF); } \
    int b_ = blockIdx.x; asm volatile("" : "+s"(b_)); F.bx = b_; F.gw = b_ * NWAVES + F.wave; } while (0)
#ifdef DBG_DOUBLE_BAR
#define SEAM(k) do { if (IN(k) && IN((k) + 1)) { XcdBarrier b2_ = bar; size_t z_ = 0; asm volatile("" : "+s"(z_)); b2_.bar = (unsigned*)((unsigned char*)a->ws + z_ + WS_CTL) + CW_BAR; xcd_barrier(b2_); xcd_barrier(b2_); } } while (0)
#else
#define SEAM(k) do { if (IN(k) && IN((k) + 1)) { XcdBarrier b2_ = bar; size_t z_ = 0; asm volatile("" : "+s"(z_)); b2_.bar = (unsigned*)((unsigned char*)a->ws + z_ + WS_CTL) + CW_BAR; xcd_barrier(b2_); } } while (0)
#endif

    if (IN(0)) { REFRESH(); p0_mod(F, a); p0_rope(F, a); p0_convert(F, a); p0_convert_up(F, a);
#ifdef DBG_DOUBLE_P0
        p0_convert(F, a);
#endif
    } SEAM(0);
    if (IN(1)) { REFRESH(); p_norm_first(F, a); } SEAM(1);

    for (int l = 0; l < DEPTH; ++l) {
        const int pb = 2 + l * PH_PER_LAYER;
#ifndef DBG_SKIP_MIXER
        if (IN(pb + 0)) { REFRESH();
#ifdef DBG_REP_GIN
            for (int rep_ = 0; rep_ < 2; ++rep_) {
#else
            {
#endif

            pg8::DenseSched S; S.init(XN, (const bf16_t*)(F.ws + opq(WS_WIN)) + (size_t)l * NPROJ * DM, T, NPROJ, DM, F.G, F.bx);
            pg8::EpiStore E{PROJ, NPROJ};
            pg8::gemm_phase<pg8::EpiStore, pg8::DenseSched, true>(F.lds + RING_OFF, S, E);
                    }
        } SEAM(pb + 0);
        if (IN(pb + 2)) { REFRESH();
            p_post1(F, a, l);
            LAS float* tabq = (LAS float*)(F.lds + MISC_OFF + 1024); LAS float* tabkv = tabq + 256;
            { pg8::DenseSched S; S.init(PROJ + C_CQ, (const bf16_t*)(F.ws + opq(WS_WUQ)) + (size_t)l * 768 * 256, T, 768, 256, F.G, F.bx, NPROJ);
              pg8::Unit u0; if (S.next(0, u0)) rs_table<256>(F, PROJ + (size_t)u0.pm * 256 * NPROJ + C_CQ, tabq);
              __syncthreads();
              pg8::EpiStoreRS E{(bf16_t*)(F.ws + opq(WS_QM)), 768, tabq}; pg8::gemm_phase<pg8::EpiStoreRS, pg8::DenseSched, false>(F.lds + RING_OFF, S, E); }
            REFRESH();
            { pg8::DenseSched S; S.init(PROJ + C_CKV, (const bf16_t*)(F.ws + opq(WS_WUKV)) + (size_t)l * 768 * 128, T, 768, 128, F.G, (F.bx + 128) % F.G, NPROJ);
              pg8::Unit u0; if (S.next(0, u0)) rs_table<128>(F, PROJ + (size_t)u0.pm * 256 * NPROJ + C_CKV, tabkv);
              __syncthreads();
              pg8::EpiStoreRS E{(bf16_t*)(F.ws + opq(WS_KVM)), 768, tabkv}; pg8::gemm_phase<pg8::EpiStoreRS, pg8::DenseSched, false>(F.lds + RING_OFF, S, E); }
        } SEAM(pb + 2);
        if (IN(pb + 3)) { REFRESH(); p_attention(F, a, l, l);
#ifdef DBG_DOUBLE_ATT
            p_attention(F, a, l, l + 4);
#endif
        } SEAM(pb + 3);
        if (IN(pb + 4)) { REFRESH();
#ifdef DBG_REP_SMALL
            for (int rep_ = 0; rep_ < 2; ++rep_) {
#else
            {
#endif

            for (int s = 0; s < 3; ++s) {
                const bf16_t* A = (const bf16_t*)(F.ws + (s == 0 ? WS_OSB : s == 1 ? WS_OMLA : WS_ODSA));
                const bf16_t* B = (const bf16_t*)(F.ws + (s == 0 ? WS_WSB : s == 1 ? WS_WMLA : WS_WDSA)) + (size_t)l * DM * (s == 2 ? 256 : 384);
                pg8::DenseSched S; S.init(A, B, T, DM, s == 2 ? 256 : 384, F.G, F.bx);
                pg8::EpiBranch E{(bf16_t*)(F.ws + opq(WS_MRG)), PROJ, C_GATE + s * DM, s == 0};
                pg8::gemm_phase<pg8::EpiBranch, pg8::DenseSched, false>(F.lds + RING_OFF, S, E);
            }
                    }
        } SEAM(pb + 4);
        if (IN(pb + 5)) { REFRESH();
            pg8::DenseSched S; S.init((const bf16_t*)(F.ws + opq(WS_MRG)), (const bf16_t*)(F.ws + opq(WS_WOUT)) + (size_t)l * DM * DM, T, DM, DM, F.G, F.bx);
            pg8::EpiResid E{(float*)(F.ws + opq(WS_X)), (const float*)(F.ws + opq(WS_MOD)) + (size_t)l * 2 * 6 * DM + 2 * DM, 0};
            pg8::gemm_phase<pg8::EpiResid, pg8::DenseSched, false>(F.lds + RING_OFF, S, E);
#ifdef DBG_REP_OUT
            { pg8::EpiResid E2 = E; E2.dofs = (size_t)1600 * MiB; pg8::gemm_phase<pg8::EpiResid, pg8::DenseSched, false>(F.lds + RING_OFF, S, E2); }
#endif
        } SEAM(pb + 5);
#endif
        if (IN(pb + 6)) { REFRESH(); p_norm2_router(F, a, l);
#ifdef DBG_REP_ROUTER
            p_norm2_router(F, a, l, (size_t)1600 * MiB, 64 + l);
#endif
        } SEAM(pb + 6);
#ifndef DBG_SKIP_MOE
        if (IN(pb + 7)) { REFRESH();
#ifdef DBG_REP_MOE
            for (int rep_ = 0; rep_ < 2; ++rep_) {
#else
            {
#endif

            const pg8::MoeTab tb = moe_tables(F, l);
            pg8::MoeSched<true, 8> S{XN, (const bf16_t*)(F.ws + opq(WS_WGU)) + (size_t)l * NEXP * 2048 * DM, (const int*)(F.ws + opq(WS_LIST)), tb, DM, F.G, F.bx, (LAS unsigned*)(F.lds + MISC_OFF + 1024)};
            pg8::EpiSwiglu E{(bf16_t*)(F.ws + opq(WS_ACT)), ((const float*)a->b_gu) + (size_t)l * NEXP * 2048, (LAS float*)(F.lds + MISC_OFF + 3072)};
            pg8::gemm_phase<pg8::EpiSwiglu, pg8::MoeSched<true, 8>, true>(F.lds + RING_OFF, S, E);
                    }
        } SEAM(pb + 7);
        if (IN(pb + 8)) { REFRESH();
#ifdef DBG_REP_MOE
            for (int rep_ = 0; rep_ < 2; ++rep_) {
#else
            {
#endif

            const pg8::MoeTab tb = moe_tables_again(F);
            pg8::MoeSched<false, 4> S{(const bf16_t*)(F.ws + opq(WS_ACT)), (const bf16_t*)(F.ws + opq(WS_WDN)) + (size_t)l * NEXP * DM * DM, nullptr, tb, DM, F.G, F.bx, (LAS unsigned*)(F.lds + MISC_OFF + 1024)};
            pg8::EpiDown E{(bf16_t*)(F.ws + opq(WS_EOUT)), ((const float*)a->b_dn) + (size_t)l * NEXP * DM, (const float*)(F.ws + opq(WS_LISTW)), (LAS float*)(F.lds + MISC_OFF + 3072)};
            pg8::gemm_phase<pg8::EpiDown, pg8::MoeSched<false, 4>, true>(F.lds + RING_OFF, S, E);
                    }
        } SEAM(pb + 8);
#endif
        if (IN(pb + 9)) { REFRESH(); const pg8::MoeTab tb = moe_tables_again(F);
#ifdef DBG_REP_COMBINE
            p_combine(F, a, l, tb, (size_t)1600 * MiB);
#endif
            p_combine(F, a, l, tb); } SEAM(pb + 9);
    }
#undef IN
#undef SEAM
#undef XN
#undef PROJ
}

#ifndef MK_MULTI
#define MK_MULTI 0
#endif
extern "C" void kernel_launch(void* const* d_in, const int* in_sizes, int n_in, void* d_out, int out_size, void* d_ws, size_t ws_size, hipStream_t stream) {
    static int grid = 0;
    if (grid == 0) {
        if (n_in != 23 || in_sizes[0] != T * DM || out_size != T * DM || ws_size < WS_END) { fprintf(stderr, "kernel_launch: unexpected shapes (n_in %d, ws %zu); nothing launched\n", n_in, ws_size); grid = -1; return; }
        int dev = 0, cus = 0, per_cu = 0;
        if (hipGetDevice(&dev) != hipSuccess || hipDeviceGetAttribute(&cus, hipDeviceAttributeMultiprocessorCount, dev) != hipSuccess) { grid = -1; return; }
        if (hipFuncSetAttribute((const void*)mk_fwd, hipFuncAttributeMaxDynamicSharedMemorySize, LDS_BYTES) != hipSuccess) { fprintf(stderr, "kernel_launch: hipFuncSetAttribute failed\n"); grid = -1; return; }
        if (hipOccupancyMaxActiveBlocksPerMultiprocessor(&per_cu, (const void*)mk_fwd, NTHR, LDS_BYTES) != hipSuccess || per_cu < 1) { fprintf(stderr, "kernel_launch: note: occupancy query says %d\n", per_cu); (void)hipGetLastError(); }
        grid = cus;
    }
    if (grid < 0) return;
    if (hipMemsetAsync((char*)d_ws + WS_CTL, 0, CTL_ZERO_BYTES, stream) != hipSuccess) return;
    Args a{};
    a.x = (gcf)d_in[0]; a.c = (gcf)d_in[1]; a.pos = (gci)d_in[2];
    a.ada_w = (gcf)d_in[3]; a.ada_b = (gcf)d_in[4]; a.norm_mix_g = (gcf)d_in[5]; a.w_in = (gcf)d_in[6];
    a.q_norm_g = (gcf)d_in[7]; a.kv_norm_g = (gcf)d_in[8]; a.w_uq = (gcf)d_in[9]; a.w_ukv = (gcf)d_in[10];
    a.w_sb_out = (gcf)d_in[11]; a.w_mla_out = (gcf)d_in[12]; a.w_dsa_out = (gcf)d_in[13]; a.w_out = (gcf)d_in[14];
    a.norm_ffn_g = (gcf)d_in[15]; a.router_w = (gcf)d_in[16]; a.router_b = (gcf)d_in[17];
    a.w_gu = (gcf)d_in[18]; a.b_gu = (gcf)d_in[19]; a.w_dn = (gcf)d_in[20]; a.b_dn = (gcf)d_in[21]; a.final_g = (gcf)d_in[22];
    a.out = (GAS float*)d_out; a.ws = (GAS unsigned char*)d_ws;
#if MK_MULTI
    for (int p = 0; p < N_PHASES; ++p) { a.ph_lo = p; a.ph_hi = p + 1; hipLaunchKernelGGL(mk_fwd, dim3(grid), dim3(NTHR), LDS_BYTES, stream, a); }
#else
    a.ph_lo = 0; a.ph_hi = N_PHASES; hipLaunchKernelGGL(mk_fwd, dim3(grid), dim3(NTHR), LDS_BYTES, stream, a);
#endif
}
```

```cpp
#include <hip/hip_runtime.h>
#include <cstdio>
#include <cstdint>

#define LAS __attribute__((address_space(3)))
#define GAS __attribute__((address_space(1)))
typedef unsigned short bf16_t;
typedef short bf16x8 __attribute__((ext_vector_type(8)));
typedef short s16x4 __attribute__((ext_vector_type(4)));
typedef float f32x2 __attribute__((ext_vector_type(2)));
typedef float f32x4 __attribute__((ext_vector_type(4)));
typedef float f32x16 __attribute__((ext_vector_type(16)));
typedef unsigned u32x2 __attribute__((ext_vector_type(2)));
typedef unsigned u32x4 __attribute__((ext_vector_type(4)));
typedef GAS unsigned gu32;
#define RLX_AGENT __ATOMIC_RELAXED, __HIP_MEMORY_SCOPE_AGENT
#define DI __device__ __forceinline__

constexpr int BATCH = 2, SEQ = 8192, DM = 1024, DEPTH = 4, T = BATCH * SEQ;
constexpr int D_IN = 5704, NPROJ = 5888;
constexpr int C_SBQ = 0, C_SBK = 384, C_SBV = 768, C_CQ = 1152, C_CKV = 1408, C_KR = 1536, C_DQ = 1568, C_DK = 1824, C_DV = 2080,
              C_IQ = 2336, C_IK = 2592, C_IW = 2624, C_GATE = 2632;
constexpr int NEXP = 32, ECAP = T;
constexpr float NORM_EPS = 1e-6f;
constexpr int NWAVES = 8, NTHR = 512;

DI unsigned f2bf(float f) { unsigned u = __builtin_bit_cast(unsigned, f); return (u + 0x7fffu + ((u >> 16) & 1u)) >> 16; }
DI unsigned pk2(float lo, float hi) { return f2bf(lo) | (f2bf(hi) << 16); }
DI float bf2f(unsigned short h) { return __builtin_bit_cast(float, (unsigned)h << 16); }
DI float bflo(unsigned w) { return __builtin_bit_cast(float, w << 16); }
DI float bfhi(unsigned w) { return __builtin_bit_cast(float, w & 0xffff0000u); }
DI unsigned cvt_pk_bf16(float lo, float hi) { unsigned r; asm volatile("v_cvt_pk_bf16_f32 %0, %1, %2" : "=v"(r) : "v"(lo), "v"(hi)); return r; }
DI float shx(float v, int o, int lane) { return __builtin_bit_cast(float, __builtin_amdgcn_ds_bpermute((lane ^ o) << 2, __builtin_bit_cast(int, v))); }
DI float shl(float v, int src) { return __builtin_bit_cast(float, __builtin_amdgcn_ds_bpermute(src << 2, __builtin_bit_cast(int, v))); }
DI unsigned long long shx64(unsigned long long v, int o, int lane) {
    const unsigned lo = (unsigned)__builtin_amdgcn_ds_bpermute((lane ^ o) << 2, (int)(unsigned)v), hi = (unsigned)__builtin_amdgcn_ds_bpermute((lane ^ o) << 2, (int)(unsigned)(v >> 32));
    return ((unsigned long long)hi << 32) | lo; }
DI float wave_sum(float v, int lane) {
#pragma unroll
    for (int o = 1; o < 64; o <<= 1) v += shx(v, o, lane);
    return v;
}
DI float zero_op() { float z = 0.f; asm volatile("" : "+v"(z)); return z; }
DI size_t opq(size_t v) { asm volatile("" : "+s"(v)); return v; }
DI float fast_sigmoid(float x) { return __builtin_amdgcn_rcpf(1.0f + __builtin_amdgcn_exp2f(-1.4426950408889634f * x)); }

namespace pg8 {
constexpr int BM = 256, BK = 64, HALF = 128, HTB = HALF * BK * 2, STAGE_BYTES = 8 * HTB, NXCD = 8, WGM = 8;
__host__ __device__ __forceinline__ int lds_byte(int r, int c) { const int st = (r >> 4) * 2 + (c >> 5), rr = r & 15, cc = c & 31, ob = rr * 64 + cc * 2; return st * 1024 + (ob ^ (((ob >> 9) & 1) << 5)); }
__host__ __device__ __forceinline__ void stage_rc(int b, int& R, int& C) { const int st = b / 1024, sb = b % 1024, swz = sb ^ (((sb >> 9) & 1) << 5); R = (st >> 1) * 16 + swz / 64; C = (st & 1) * 32 + (swz % 64) / 2; }
__host__ __device__ __forceinline__ int perm32(int rho) { const int n = rho >> 4, i = rho & 15; return 8 * (i >> 2) + 4 * n + (i & 3); }

struct Unit { int pm, pn, e, row0, nrows, par; };

struct DenseSched {
    const bf16_t* A; const bf16_t* Bt; int K; int nM, nN, nwg, G, c, lda;
    DI void init(const bf16_t* A_, const bf16_t* Bt_, int M, int N, int K_, int G_, int c_, int lda_ = 0) { A = A_; Bt = Bt_; K = K_; nM = M / BM; nN = N / BM; nwg = nM * nN; G = G_; c = c_; lda = lda_ ? lda_ : K_; }
    DI bool next(int i, Unit& u) const {
        const long L = (long)i * G + c; if (L >= nwg) return false;
        int wgid = (int)L; { const int q = nwg / NXCD, r = nwg % NXCD, xcd = wgid % NXCD, off = wgid / NXCD; wgid = (xcd < r ? xcd * (q + 1) : r * (q + 1) + (xcd - r) * q) + off; }
        const int nig = WGM * nN, gid = wgid / nig, fm = gid * WGM, gsz = (nM - fm) < WGM ? (nM - fm) : WGM;
        u.pm = fm + ((wgid % nig) % gsz); u.pn = (wgid % nig) / gsz; u.e = 0; u.row0 = u.pm * BM; u.nrows = BM; return true;
    }
    DI const char* abase(const Unit& u) const { return (const char*)A + (size_t)u.pm * BM * lda * 2; }
    DI const char* bbase(const Unit& u) const { return (const char*)Bt + (size_t)u.pn * BM * K * 2; }
    DI void aoffs(const Unit&, int R, int C, unsigned (&v)[4]) const {
#pragma unroll
        for (int m = 0; m < 4; ++m) v[m] = (unsigned)((R + 64 * m) * lda + C) * 2u;
    }
    DI void prefetch(const Unit&, int, int) const {}
    DI void aoffs_next(const Unit& u, int R, int C, unsigned (&v)[4], int) const { aoffs(u, R, C, v); }
};

template <class Epi, class Sched, bool ALIGN_EPI>
DI void gemm_phase(LAS unsigned char* lds, const Sched& S, const Epi& E) {
    int tid = threadIdx.x; asm volatile("" : "+v"(tid));
    const int wid = __builtin_amdgcn_readfirstlane(tid >> 6), lane = tid & 63, wr = wid >> 2, wc = wid & 3, fr = lane & 15, fq = lane >> 4;
    const int K = S.K, nt = K / BK;
    int sR, sC; stage_rc(tid * 16, sR, sC);
    unsigned voffB[2];
#pragma unroll
    for (int i = 0; i < 2; ++i) { const int R = sR + 64 * i; const int Rb = Epi::PERM ? ((R & ~31) + perm32(R & 31)) : R; voffB[i] = (unsigned)(Rb * K + sC) * 2u; }
    const size_t kstep = (size_t)(BK * 2);
    const size_t hstep = (size_t)HALF * K * 2;
    const unsigned ldsw = (unsigned)wid * 1024u;
    const int aoff = lds_byte(wr * 64 + fr, fq * 8), boff = lds_byte(wc * 32 + fr, fq * 8);
#define PG8_SA(b, h) (((b) * 2 + (h)) * HTB)
#define PG8_SB(b, h) ((4 + (b) * 2 + (h)) * HTB)
#define PG8_STAGEB(bufoff, gbase) do { _Pragma("unroll") for (int _i = 0; _i < 2; ++_i) \
        __builtin_amdgcn_global_load_lds((const unsigned*)((const char*)(gbase) + voffB[_i]), (LAS unsigned*)(lds + (bufoff) + ldsw + _i * 8192), 16, 0, 0); } while (0)
#define PG8_STAGEA(bufoff, gbase, v0, v1) do { \
        __builtin_amdgcn_global_load_lds((const unsigned*)((const char*)(gbase) + (v0)), (LAS unsigned*)(lds + (bufoff) + ldsw), 16, 0, 0); \
        __builtin_amdgcn_global_load_lds((const unsigned*)((const char*)(gbase) + (v1)), (LAS unsigned*)(lds + (bufoff) + ldsw + 8192), 16, 0, 0); } while (0)
#define PG8_LDA(dst, b, h) do { _Pragma("unroll") for (int m = 0; m < 4; ++m) _Pragma("unroll") for (int k = 0; k < 2; ++k) dst[m][k] = *(const LAS bf16x8*)(lds + PG8_SA(b, h) + aoff + m * 2048 + k * 1024); } while (0)
#define PG8_LDB(dst, b, h) do { _Pragma("unroll") for (int n = 0; n < 2; ++n) _Pragma("unroll") for (int k = 0; k < 2; ++k) dst[n][k] = *(const LAS bf16x8*)(lds + PG8_SB(b, h) + boff + n * 2048 + k * 1024); } while (0)
#define PG8_MMA(ai, bj, At, Bt) do { __builtin_amdgcn_s_setprio(1); _Pragma("unroll") for (int m = 0; m < 4; ++m) _Pragma("unroll") for (int n = 0; n < 2; ++n) _Pragma("unroll") for (int k = 0; k < 2; ++k) \
        acc[ai][bj][m][n] = __builtin_amdgcn_mfma_f32_16x16x32_bf16(Bt[n][k], At[m][k], acc[ai][bj][m][n], 0, 0, 0); __builtin_amdgcn_s_setprio(0); } while (0)
#define PG8_WAIT_V(n) asm volatile("s_waitcnt vmcnt(" #n ")" ::: "memory")
#define PG8_WAIT_L(n) asm volatile("s_waitcnt lgkmcnt(" #n ")" ::: "memory")
#define PG8_BAR __builtin_amdgcn_s_barrier()
#define PG8_SCHED __builtin_amdgcn_sched_barrier(0)
    Unit cur, nxt; int ui = 0;
    if (!S.next(0, cur)) return;
    f32x4 acc[2][2][4][2];
    float zz = 0.f; asm volatile("" : "+v"(zz));
#pragma unroll
    for (int a = 0; a < 2; ++a)
#pragma unroll
        for (int b = 0; b < 2; ++b)
#pragma unroll
            for (int m = 0; m < 4; ++m)
#pragma unroll
                for (int n = 0; n < 2; ++n) acc[a][b][m][n] = (f32x4){zz, zz, zz, zz};
    bf16x8 At[4][2], B0[2][2], B1[2][2];
    const char* cA = S.abase(cur); const char* cB = S.bbase(cur);
    unsigned cv[4];
    S.aoffs(cur, sR, sC, cv);
    PG8_STAGEB(PG8_SB(0, 0), cB); PG8_STAGEB(PG8_SB(0, 1), cB + hstep); PG8_STAGEA(PG8_SA(0, 0), cA, cv[0], cv[1]); PG8_STAGEA(PG8_SA(0, 1), cA, cv[2], cv[3]);
    if (wr == 1) PG8_BAR;
    PG8_WAIT_V(2); PG8_BAR;
    PG8_STAGEB(PG8_SB(1, 0), cB + kstep); PG8_STAGEA(PG8_SA(1, 0), cA + kstep, cv[0], cv[1]); PG8_STAGEB(PG8_SB(1, 1), cB + hstep + kstep);
    PG8_WAIT_V(6); PG8_BAR;
    for (;;) {
        const bool has_next = S.next(ui + 1, nxt);
        cur.par = ui & 1;
        { int t2 = threadIdx.x; asm volatile("" : "+v"(t2)); E.prefetch(cur, t2); }
        const char* nA = cA; const char* nB = cB;
        if (has_next) { nA = S.abase(nxt); nB = S.bbase(nxt); int t2 = threadIdx.x; asm volatile("" : "+v"(t2)); S.prefetch(nxt, t2, (ui + 1) & 1); }
        for (int t = 0; t < nt; t += 2) {
            const bool last = (t == nt - 2);
            const char* a1 = cA + (size_t)(t + 1) * kstep;
            const char* a2 = last ? nA : cA + (size_t)(t + 2) * kstep; const char* b2 = last ? nB : cB + (size_t)(t + 2) * kstep;
            const char* a3 = a2 + kstep; const char* b3 = b2 + kstep;
            unsigned wv[4];
#pragma unroll
            for (int m = 0; m < 4; ++m) wv[m] = cv[m];
            if (last && has_next) { int t2 = threadIdx.x; asm volatile("" : "+v"(t2)); int R2, C2; stage_rc(t2 * 16, R2, C2); S.aoffs_next(nxt, R2, C2, wv, (ui + 1) & 1); }
            const unsigned w0 = wv[0], w1 = wv[1], w2 = wv[2], w3 = wv[3];
            PG8_LDB(B0, 0, 0); PG8_LDB(B1, 0, 1); PG8_SCHED; PG8_LDA(At, 0, 0); PG8_STAGEA(PG8_SA(1, 1), a1, cv[2], cv[3]);
            PG8_WAIT_V(8); PG8_WAIT_L(0); PG8_BAR; PG8_MMA(0, 0, At, B0); PG8_MMA(0, 1, At, B1); PG8_BAR; PG8_SCHED;
            PG8_LDA(At, 0, 1); PG8_STAGEB(PG8_SB(0, 0), b2); PG8_STAGEB(PG8_SB(0, 1), b2 + hstep); PG8_STAGEA(PG8_SA(0, 0), a2, w0, w1);
            PG8_WAIT_V(8); PG8_WAIT_L(0); PG8_BAR; PG8_MMA(1, 0, At, B0); PG8_MMA(1, 1, At, B1); PG8_BAR; PG8_SCHED;
            PG8_LDB(B0, 1, 0); PG8_LDB(B1, 1, 1); PG8_SCHED; PG8_LDA(At, 1, 0); PG8_STAGEA(PG8_SA(0, 1), a2, w2, w3);
            PG8_WAIT_V(8); PG8_WAIT_L(0); PG8_BAR; PG8_MMA(0, 0, At, B0); PG8_MMA(0, 1, At, B1); PG8_BAR; PG8_SCHED;
            PG8_LDA(At, 1, 1); PG8_STAGEB(PG8_SB(1, 0), b3); PG8_STAGEB(PG8_SB(1, 1), b3 + hstep); PG8_STAGEA(PG8_SA(1, 0), a3, w0, w1);
            PG8_WAIT_V(8); PG8_WAIT_L(0); PG8_BAR; PG8_MMA(1, 0, At, B0); PG8_MMA(1, 1, At, B1); PG8_BAR; PG8_SCHED;
        }
        if constexpr (ALIGN_EPI) { if (wr == 0) PG8_BAR; }
        { int t2 = threadIdx.x; asm volatile("" : "+v"(t2)); const int l2 = t2 & 63; E(acc, cur, wr, wc, l2 & 15, l2 >> 4); }
        if (!has_next) break;
#pragma unroll
        for (int a = 0; a < 2; ++a)
#pragma unroll
            for (int b = 0; b < 2; ++b)
#pragma unroll
                for (int m = 0; m < 4; ++m)
#pragma unroll
                    for (int n = 0; n < 2; ++n) acc[a][b][m][n] = (f32x4){zz, zz, zz, zz};
        cur = nxt; cA = nA; cB = nB; ++ui;
        { int t2 = threadIdx.x; asm volatile("" : "+v"(t2)); int R2, C2; stage_rc(t2 * 16, R2, C2); S.aoffs_next(cur, R2, C2, cv, ui & 1); }
        if constexpr (ALIGN_EPI) { if (wr == 1) PG8_BAR; }
    }
    PG8_WAIT_V(0);
    if constexpr (!ALIGN_EPI) { if (wr == 0) PG8_BAR; }
    PG8_BAR;
#undef PG8_SA
#undef PG8_SB
#undef PG8_STAGEA
#undef PG8_STAGEB
#undef PG8_LDA
#undef PG8_LDB
#undef PG8_MMA
#undef PG8_WAIT_V
#undef PG8_WAIT_L
#undef PG8_BAR
#undef PG8_SCHED
}
}
constexpr size_t MiB = 1u << 20;
constexpr size_t WS_CTL = 0, CTL_ZERO_BYTES = 1 * MiB;
constexpr size_t WS_MOD   = 1 * MiB;
constexpr size_t WS_ROPE32 = 2 * MiB;
constexpr size_t WS_ROPE16 = 6 * MiB;
constexpr size_t WS_WIN   = 8 * MiB;
constexpr size_t WS_WUQ   = 56 * MiB;
constexpr size_t WS_WUKV  = 58 * MiB;
constexpr size_t WS_WSB   = 60 * MiB;
constexpr size_t WS_WMLA  = 64 * MiB;
constexpr size_t WS_WDSA  = 68 * MiB;
constexpr size_t WS_WOUT  = 72 * MiB;
constexpr size_t WS_WGU   = 80 * MiB;
constexpr size_t WS_WDN   = 592 * MiB;
constexpr size_t WS_X     = 848 * MiB;
constexpr size_t WS_XN    = 912 * MiB;
constexpr size_t WS_PROJ  = 944 * MiB;
constexpr size_t WS_CQN   = 1128 * MiB;
constexpr size_t WS_CKVN  = 1136 * MiB;
constexpr size_t WS_KR    = 1140 * MiB;
constexpr size_t WS_DK    = 1141 * MiB;
constexpr size_t WS_IK    = 1149 * MiB;
constexpr size_t WS_IW    = 1150 * MiB;
constexpr size_t WS_QM    = 1152 * MiB;
constexpr size_t WS_KVM   = 1176 * MiB;
constexpr size_t WS_OSB   = 1200 * MiB;
constexpr size_t WS_OMLA  = 1212 * MiB;
constexpr size_t WS_ODSA  = 1224 * MiB;
constexpr size_t WS_MRG   = 1232 * MiB;
constexpr size_t WS_LIST  = 1264 * MiB;
constexpr size_t WS_LISTW = 1266 * MiB;
constexpr size_t WS_TOKE  = 1268 * MiB;
constexpr size_t WS_ACT   = 1272 * MiB;
constexpr size_t WS_EOUT  = 1402 * MiB;
constexpr size_t WS_BM    = 1532 * MiB;
constexpr size_t WS_END   = 1548 * MiB;
constexpr int CW_BAR = 4096;
constexpr int CW_CNT = 8192;
constexpr int CW_QATT = 8192 + 256;
constexpr int CW_SELF = 16384;
constexpr int CW_KMAX = 8192 + 1024;

constexpr int RING_OFF = 0, RING_BYTES = 131072;
constexpr int MISC_OFF = RING_BYTES;
constexpr int LDS_BYTES = 147456;

#define XB_TMO      128
#define XB_XCNT(j)  (256  + 64 * (j))
#define XB_XSUB(j)  (1280 + 64 * (j))
#define XB_XGEN(j)  (2304 + 64 * (j))
#define XB_TOP      3328
#define XB_TOPGEN   3392
#define XCD_BAR_WORDS 3456
#define XB_SPIN_CAP (1u << 18)

__device__ __forceinline__ unsigned xb_ld(unsigned* p)              { return __hip_atomic_load(p, __ATOMIC_RELAXED, __HIP_MEMORY_SCOPE_AGENT); }
__device__ __forceinline__ unsigned xb_add(unsigned* p, unsigned v) { return __hip_atomic_fetch_add(p, v, __ATOMIC_RELAXED, __HIP_MEMORY_SCOPE_AGENT); }
__device__ __forceinline__ unsigned xb_xcc_id() { return (unsigned)__builtin_amdgcn_s_getreg((3 << 11) | 20) & 0xFu; }
#define XB_SPIN(cond, bar) do { unsigned _sp = 0; while (cond) { __builtin_amdgcn_s_sleep(1); \
    if ((++_sp & 255u) == 0u) { if (xb_ld(&(bar)[XB_TMO])) break; if (_sp > XB_SPIN_CAP) { atomicAdd(&(bar)[XB_TMO], 1u); break; } } } } while (0)

struct XcdBarrier { unsigned* bar; unsigned x; volatile LAS unsigned* st; };

__device__ __forceinline__ XcdBarrier xcd_barrier_post(unsigned* bar, volatile LAS unsigned* st) {
    XcdBarrier b; b.bar = bar; b.x = xb_xcc_id(); b.st = st;
    if (threadIdx.x == 0) (void)xb_add(&bar[XB_XCNT(b.x)], 1u);
    return b;
}
__device__ __forceinline__ void xcd_barrier_complete(unsigned* bar, unsigned x, unsigned& nloc, unsigned& nx) {
    const unsigned G = gridDim.x * gridDim.y * gridDim.z;
    unsigned sum, cnt, mine, sp = 0u;
    for (;;) {
        sum = 0u; cnt = 0u; mine = 0u;
#pragma unroll
        for (unsigned j = 0; j < 16; ++j) { const unsigned c = xb_ld(&bar[XB_XCNT(j)]); sum += c; cnt += (c > 0u) ? 1u : 0u; mine = (j == x) ? c : mine; }
        if (sum == G) break;
        __builtin_amdgcn_s_sleep(1);
        if ((++sp & 255u) == 0u) { if (xb_ld(&bar[XB_TMO])) break; if (sp > XB_SPIN_CAP) { atomicAdd(&bar[XB_TMO], 1u); break; } }
    }
    nloc = mine > 0u ? mine : 1u; nx = cnt > 0u ? cnt : 1u;
}
__device__ __forceinline__ void xcd_barrier(const XcdBarrier& b) {
    asm volatile("s_waitcnt vmcnt(0)" ::: "memory");
    __syncthreads();
    if (threadIdx.x == 0) {
        unsigned* bar = b.bar;
        __builtin_amdgcn_s_waitcnt(0);
        unsigned nloc = b.st[0], nx = b.st[1];
        if (nloc == 0u) { xcd_barrier_complete(bar, b.x, nloc, nx); b.st[0] = nloc; b.st[1] = nx; }
        const unsigned old = xb_add(&bar[XB_XSUB(b.x)], 1u);
        const unsigned gen = old / nloc;
        if (old + 1u == (gen + 1u) * nloc) {
            __builtin_amdgcn_fence(__ATOMIC_RELEASE, "agent");
            asm volatile("s_waitcnt vmcnt(0)" ::: "memory");
            const unsigned og = xb_add(&bar[XB_TOP], 1u);
            const unsigned tg = og / nx;
            if (og + 1u == (tg + 1u) * nx) xb_add(&bar[XB_TOPGEN], 1u);
            else XB_SPIN(xb_ld(&bar[XB_TOPGEN]) == tg, bar);
            __builtin_amdgcn_fence(__ATOMIC_ACQUIRE, "agent");
            xb_add(&bar[XB_XGEN(b.x)], 1u);
            asm volatile("s_waitcnt vmcnt(0)" ::: "memory");
        } else {
            XB_SPIN(xb_ld(&bar[XB_XGEN(b.x)]) == gen, bar);
            __builtin_amdgcn_fence(__ATOMIC_ACQUIRE, "agent");
            asm volatile("s_waitcnt vmcnt(0)" ::: "memory");
        }
    }
    __syncthreads();
}

typedef const GAS float* gcf; typedef const GAS int* gci;
struct Args {
    gcf x, c; gci pos;
    gcf ada_w, ada_b, norm_mix_g, w_in, q_norm_g, kv_norm_g, w_uq, w_ukv, w_sb_out, w_mla_out, w_dsa_out, w_out,
        norm_ffn_g, router_w, router_b, w_gu, b_gu, w_dn, b_dn, final_g;
    GAS float* out; GAS unsigned char* ws;
    int ph_lo, ph_hi;
};
typedef const __attribute__((address_space(4))) Args* ArgsP;
struct Frame {
    LAS unsigned char* lds;
    volatile LAS unsigned* MISC;
    gu32* ctl;
    int tid, lane, wave, G, gw, NGW, bx;
    unsigned char* ws;
};
__constant__ float INVF32[32] = {1.f, 0.749894261f, 0.562341332f, 0.421696514f, 0.316227764f, 0.237137377f, 0.177827939f, 0.133352131f, 0.100000001f, 0.0749894157f, 0.0562341325f, 0.0421696529f, 0.0316227749f, 0.0237137377f, 0.0177827943f, 0.0133352149f, 0.00999999978f, 0.00749894185f, 0.00562341325f, 0.00421696482f, 0.00316227763f, 0.00237137359f, 0.00177827943f, 0.00133352145f, 0.00100000005f, 0.000749894243f, 0.000562341302f, 0.000421696517f, 0.000316227757f, 0.00023713737f, 0.00017782794f, 0.00013335215f};
__constant__ float INVF16[16] = {1.f, 0.562341332f, 0.316227764f, 0.177827939f, 0.100000001f, 0.0562341325f, 0.0316227749f, 0.0177827943f, 0.00999999978f, 0.00562341325f, 0.00316227763f, 0.00177827943f, 0.00100000005f, 0.000562341302f, 0.000316227757f, 0.00017782794f};

DI void p0_mod(Frame& F, ArgsP a) {
    LAS float* sc = (LAS float*)(F.lds + RING_OFF);
    LAS float* part = sc + 2048;
    for (int i = F.tid; i < 2048; i += NTHR) { const float v = ((const float*)a->c)[i]; sc[i] = v * fast_sigmoid(v); }
    __syncthreads();
    float* MOD = (float*)(F.ws + opq(WS_MOD));
    for (int task = F.bx; task < DEPTH * 96; task += F.G) {
        const int l = task / 96, n = (task % 96) * 64 + F.lane;
        const float* W = ((const float*)a->ada_w) + (size_t)l * DM * 6 * DM + n;
        float a0 = 0.f, a1 = 0.f; const int kb = F.wave * 128;
#pragma unroll 8
        for (int k = 0; k < 128; ++k) { const float w = W[(size_t)(kb + k) * (6 * DM)]; a0 = __builtin_fmaf(sc[kb + k], w, a0); a1 = __builtin_fmaf(sc[1024 + kb + k], w, a1); }
        part[(F.wave * 2 + 0) * 64 + F.lane] = a0; part[(F.wave * 2 + 1) * 64 + F.lane] = a1;
        __syncthreads();
        if (F.wave < 2) { float s = ((const float*)a->ada_b)[l * 6 * DM + n];
#pragma unroll
            for (int w = 0; w < 8; ++w) s += part[(w * 2 + F.wave) * 64 + F.lane];
            MOD[(size_t)(l * 2 + F.wave) * 6 * DM + n] = s; }
        __syncthreads();
    }
}
DI void p0_rope(Frame& F, ArgsP a) {
    float* R32 = (float*)(F.ws + opq(WS_ROPE32)); float* R16 = (float*)(F.ws + opq(WS_ROPE16));
    const int gt = F.bx * NTHR + F.tid, NT = F.G * NTHR;
    for (int i = gt; i < T * 32; i += NT) { const int t = i >> 5, f = i & 31; const float ang = (float)((const int*)a->pos)[t] * INVF32[f]; R32[i] = cosf(ang); R32[T * 32 + i] = sinf(ang); }
    for (int i = gt; i < T * 16; i += NT) { const int t = i >> 4, f = i & 15; const float ang = (float)((const int*)a->pos)[t] * INVF16[f]; R16[i] = cosf(ang); R16[T * 16 + i] = sinf(ang); }
}
struct CvtItem { const float* W; bf16_t* WT; int ld, nvalid, K, Ndst, mode, item; };
constexpr int CV_IN = (NPROJ / 32) * 16, CV_UQ = 0, CV_UKV = 0, CV_SB = 32 * 6, CV_MLA = 32 * 6, CV_DSA = 32 * 4, CV_OUT = 32 * 16, CV_GU = 64 * 16, CV_DN = 32 * 16;
constexpr int CV_SMALL = CV_IN + CV_UQ + CV_UKV + CV_SB + CV_MLA + CV_DSA + CV_OUT, CV_EXP = NEXP * (CV_GU + CV_DN);
constexpr int CV_UNIT = 96, N_CVT = CV_EXP / CV_UNIT;
DI void cvt_decode_small(CvtItem& c, Frame& F, ArgsP a, int it) {
    const int l = it / CV_SMALL; int r = it % CV_SMALL;
    if (r < CV_IN)  { c = CvtItem{((const float*)a->w_in) + (size_t)l * DM * D_IN, (bf16_t*)(F.ws + opq(WS_WIN)) + (size_t)l * NPROJ * DM, D_IN, D_IN, DM, NPROJ, 0, r}; return; } r -= CV_IN;
    if (r < CV_UQ)  { c = CvtItem{((const float*)a->w_uq) + (size_t)l * 256 * 576, (bf16_t*)(F.ws + opq(WS_WUQ)) + (size_t)l * 768 * 256, 576, 576, 256, 768, 0, r}; return; } r -= CV_UQ;
    if (r < CV_UKV) { c = CvtItem{((const float*)a->w_ukv) + (size_t)l * 128 * 768, (bf16_t*)(F.ws + opq(WS_WUKV)) + (size_t)l * 768 * 128, 768, 768, 128, 768, 0, r}; return; } r -= CV_UKV;
    if (r < CV_SB)  { c = CvtItem{((const float*)a->w_sb_out) + (size_t)l * 384 * DM, (bf16_t*)(F.ws + opq(WS_WSB)) + (size_t)l * DM * 384, DM, DM, 384, DM, 0, r}; return; } r -= CV_SB;
    if (r < CV_MLA) { c = CvtItem{((const float*)a->w_mla_out) + (size_t)l * 384 * DM, (bf16_t*)(F.ws + opq(WS_WMLA)) + (size_t)l * DM * 384, DM, DM, 384, DM, 0, r}; return; } r -= CV_MLA;
    if (r < CV_DSA) { c = CvtItem{((const float*)a->w_dsa_out) + (size_t)l * 256 * DM, (bf16_t*)(F.ws + opq(WS_WDSA)) + (size_t)l * DM * 256, DM, DM, 256, DM, 0, r}; return; } r -= CV_DSA;
    c = CvtItem{((const float*)a->w_out) + (size_t)l * DM * DM, (bf16_t*)(F.ws + opq(WS_WOUT)) + (size_t)l * DM * DM, DM, DM, DM, DM, 0, r};
}
DI void cvt_decode_expert(CvtItem& c, Frame& F, ArgsP a, int l, int r) {
    if (r < NEXP * CV_GU) { const int e = r / CV_GU; c = CvtItem{((const float*)a->w_gu) + (size_t)(l * NEXP + e) * DM * 2048, (bf16_t*)(F.ws + opq(WS_WGU)) + (size_t)(l * NEXP + e) * 2048 * DM, 2048, 2048, DM, 2048, 1, r % CV_GU}; return; } r -= NEXP * CV_GU;
    { const int e = r / CV_DN; c = CvtItem{((const float*)a->w_dn) + (size_t)(l * NEXP + e) * DM * DM, (bf16_t*)(F.ws + opq(WS_WDN)) + (size_t)(l * NEXP + e) * DM * DM, DM, DM, DM, DM, 0, r % CV_DN}; }
}
DI void cvt_load(f32x4 (&v)[8], const CvtItem& c, int lane) {
    const int nblk = c.Ndst / 32, kb = c.item / nblk, nb = c.item % nblk, k0 = 64 * kb, n0 = 32 * nb, quad = lane & 7;
    int col; if (c.mode == 0) col = n0 + 4 * quad; else col = (quad < 4) ? (n0 / 2 + 4 * quad) : (1024 + n0 / 2 + 4 * (quad - 4));
    const bool ok = (c.mode != 0) || (col < c.nvalid);
#pragma unroll
    for (int i = 0; i < 8; ++i) { const int row = (lane >> 3) + 8 * i; const float z0 = zero_op(); v[i] = (f32x4){z0, z0, z0, z0}; if (ok) v[i] = *(const f32x4*)(c.W + (size_t)(k0 + row) * c.ld + col); }
}
DI void cvt_store(const f32x4 (&v)[8], const CvtItem& c, LAS float* scr, int lane) {
    const int nblk = c.Ndst / 32, kb = c.item / nblk, nb = c.item % nblk, k0 = 64 * kb, n0 = 32 * nb, quad = lane & 7;
#pragma unroll
    for (int i = 0; i < 8; ++i) { const int row = (lane >> 3) + 8 * i; LAS float* d = scr + row * 33 + 4 * quad; d[0] = v[i][0]; d[1] = v[i][1]; d[2] = v[i][2]; d[3] = v[i][3]; }
    asm volatile("s_waitcnt lgkmcnt(0)" ::: "memory");
    const int cc = lane & 7;
#pragma unroll
    for (int j = 0; j < 4; ++j) { const int nn = (lane >> 3) + 8 * j; const int slot = (c.mode == 0) ? nn : ((nn & 1) * 16 + (nn >> 1)); const LAS float* s = scr + (8 * cc) * 33 + slot;
        u32x4 o; o.x = cvt_pk_bf16(s[0 * 33], s[1 * 33]); o.y = cvt_pk_bf16(s[2 * 33], s[3 * 33]); o.z = cvt_pk_bf16(s[4 * 33], s[5 * 33]); o.w = cvt_pk_bf16(s[6 * 33], s[7 * 33]);
        *(u32x4*)(c.WT + (size_t)(n0 + nn) * c.K + k0 + 8 * cc) = o; }
    asm volatile("s_waitcnt lgkmcnt(0)" ::: "memory");
}
DI void p0_convert_up(Frame& F, ArgsP a) {
    const int gt = F.bx * NTHR + F.tid, NT_ = F.G * NTHR;
    bf16_t* WUQ = (bf16_t*)(F.ws + opq(WS_WUQ)); bf16_t* WUKV = (bf16_t*)(F.ws + opq(WS_WUKV));
    for (int i = gt; i < DEPTH * 256 * 768; i += NT_) { const int n = i % 768, k = (i / 768) % 256, l = i / (768 * 256);
        const float v = n < 576 ? ((const float*)a->w_uq)[((size_t)l * 256 + k) * 576 + n] * ((const float*)a->q_norm_g)[l * 256 + k] : 0.f;
        WUQ[((size_t)l * 768 + n) * 256 + k] = (bf16_t)f2bf(v); }
    for (int i = gt; i < DEPTH * 128 * 768; i += NT_) { const int n = i % 768, k = (i / 768) % 128, l = i / (768 * 128);
        const float v = ((const float*)a->w_ukv)[((size_t)l * 128 + k) * 768 + n] * ((const float*)a->kv_norm_g)[l * 128 + k];
        WUKV[((size_t)l * 768 + n) * 128 + k] = (bf16_t)f2bf(v); }
}
DI void p0_convert(Frame& F, ArgsP a) {
    LAS float* scr = (LAS float*)(F.lds + RING_OFF + 16384 + F.wave * 12288);
    constexpr int NIT = DEPTH * CV_SMALL;
    f32x4 va[8], vb[8]; CvtItem ca, cb;
    int it = F.gw;
    if (it < NIT) { cvt_decode_small(ca, F, a, it); cvt_load(va, ca, F.lane); }
    while (it < NIT) {
        const int it1 = it + F.NGW;
        if (it1 < NIT) { cvt_decode_small(cb, F, a, it1); cvt_load(vb, cb, F.lane); }
        cvt_store(va, ca, scr, F.lane);
        if (it1 >= NIT) break;
        const int it2 = it1 + F.NGW;
        if (it2 < NIT) { cvt_decode_small(ca, F, a, it2); cvt_load(va, ca, F.lane); }
        cvt_store(vb, cb, scr, F.lane);
        it = it2;
    }
}
DI void cvt_unit(Frame& F, ArgsP a, int l, int cu) {
    LAS float* scr = (LAS float*)(F.lds + RING_OFF + F.wave * 12288);
    const int base = cu * CV_UNIT + F.wave; constexpr int NK = CV_UNIT / NWAVES;
    f32x4 va[8], vb[8], vc[8], vd[8]; CvtItem ca, cb, cc, cd;
    cvt_decode_expert(ca, F, a, l, base); cvt_load(va, ca, F.lane);
    cvt_decode_expert(cb, F, a, l, base + 8); cvt_load(vb, cb, F.lane);
    cvt_decode_expert(cc, F, a, l, base + 16); cvt_load(vc, cc, F.lane);
#pragma unroll 1
    for (int k = 0; k < NK; k += 4) {
        cvt_decode_expert(cd, F, a, l, base + 8 * (k + 3)); cvt_load(vd, cd, F.lane);
        cvt_store(va, ca, scr, F.lane);
        if (k + 4 < NK) { cvt_decode_expert(ca, F, a, l, base + 8 * (k + 4)); cvt_load(va, ca, F.lane); }
        cvt_store(vb, cb, scr, F.lane);
        if (k + 4 < NK) { cvt_decode_expert(cb, F, a, l, base + 8 * (k + 5)); cvt_load(vb, cb, F.lane); }
        cvt_store(vc, cc, scr, F.lane);
        if (k + 4 < NK) { cvt_decode_expert(cc, F, a, l, base + 8 * (k + 6)); cvt_load(vc, cc, F.lane); }
        cvt_store(vd, cd, scr, F.lane);
    }
}

struct RowCoef { f32x4 a[4], b[4]; };
DI void load_coef(RowCoef& c, const float* g, const float* sh, const float* sc, int lane) {
    f32x4 gg[4], ss[4];
#pragma unroll
    for (int j = 0; j < 4; ++j) { const int o = 4 * lane + 256 * j; gg[j] = *(const f32x4*)(g + o); ss[j] = *(const f32x4*)(sc + o); c.b[j] = *(const f32x4*)(sh + o); }
    __builtin_amdgcn_sched_barrier(0);
#pragma unroll
    for (int j = 0; j < 4; ++j) c.a[j] = gg[j] * (ss[j] + 1.0f);
}
DI float row_rstd(const f32x4 (&v)[4], int lane) {
    float s = 0.f;
#pragma unroll
    for (int j = 0; j < 4; ++j) s += (v[j].x * v[j].x + v[j].y * v[j].y) + (v[j].z * v[j].z + v[j].w * v[j].w);
    return 1.0f / sqrtf(wave_sum(s, lane) * (1.0f / DM) + NORM_EPS);
}
DI void store_xn(bf16_t* xn_row, const f32x4 (&h)[4], int lane) {
#pragma unroll
    for (int j = 0; j < 4; ++j) { u32x2 w; w.x = pk2(h[j].x, h[j].y); w.y = pk2(h[j].z, h[j].w); *(u32x2*)(xn_row + 4 * lane + 256 * j) = w; }
}
DI void p_norm_first(Frame& F, ArgsP a) {
    const float* MOD = (const float*)(F.ws + opq(WS_MOD)); float* X = (float*)(F.ws + opq(WS_X)); bf16_t* XN = (bf16_t*)(F.ws + opq(WS_XN));
    constexpr int RPW = 8;
    for (int r0 = F.gw * RPW; r0 < T; r0 += F.NGW * RPW) {
        const int b = r0 / SEQ; const float* mod = MOD + (size_t)(0 * 2 + b) * 6 * DM;
        RowCoef c; load_coef(c, ((const float*)a->norm_mix_g), mod + 0 * DM, mod + 1 * DM, F.lane);
        for (int r = r0; r < r0 + RPW; ++r) {
            f32x4 v[4];
#pragma unroll
            for (int j = 0; j < 4; ++j) v[j] = *(const f32x4*)(((const float*)a->x) + (size_t)r * DM + 4 * F.lane + 256 * j);
            const float rstd = row_rstd(v, F.lane);
            f32x4 h[4];
#pragma unroll
            for (int j = 0; j < 4; ++j) { *(f32x4*)(X + (size_t)r * DM + 4 * F.lane + 256 * j) = v[j]; h[j] = v[j] * rstd * c.a[j] + c.b[j]; }
            store_xn(XN + (size_t)r * DM, h, F.lane);
        }
    }
}
template <int NC> DI void rs_table(Frame& F, const bf16_t* src, LAS float* tab) {
    constexpr int LPR = NC / 8, RPI = 64 / LPR, NI = 32 / RPI;
    const int lane = F.lane, sub = lane / LPR, cl = lane % LPR;
    u32x4 v[NI];
#pragma unroll
    for (int j = 0; j < NI; ++j) v[j] = *(const u32x4*)(src + (size_t)(32 * F.wave + RPI * j + sub) * NPROJ + 8 * cl);
#pragma unroll
    for (int j = 0; j < NI; ++j) { float s = 0.f;
#pragma unroll
        for (int p = 0; p < 4; ++p) { const float x0 = bflo(v[j][p]), x1 = bfhi(v[j][p]); s = __builtin_fmaf(x0, x0, s); s = __builtin_fmaf(x1, x1, s); }
#pragma unroll
        for (int o = 1; o < LPR; o <<= 1) s += shx(s, o, lane);
        if (cl == 0) tab[32 * F.wave + RPI * j + sub] = 1.0f / sqrtf(s * (1.0f / NC) + NORM_EPS); }
}
DI void p_post1(Frame& F, ArgsP a, int l) {
    const bf16_t* PROJ = (const bf16_t*)(F.ws + opq(WS_PROJ));
    bf16_t* KR = (bf16_t*)(F.ws + opq(WS_KR));
    bf16_t* DK = (bf16_t*)(F.ws + opq(WS_DK)); bf16_t* IK = (bf16_t*)(F.ws + opq(WS_IK)); float* IW = (float*)(F.ws + opq(WS_IW));
    const float* C32 = (const float*)(F.ws + opq(WS_ROPE32)); const float* S32 = C32 + (size_t)T * 32;
    const float* C16 = (const float*)(F.ws + opq(WS_ROPE16)); const float* S16 = C16 + (size_t)T * 16;
    const int lane = F.lane;
    float kmx0 = 0.f, kmx1 = 0.f;
    const int hd = lane >> 4, i2 = 2 * (lane & 15), i1 = lane & 15; const bool second = lane >= 16;
    constexpr int RB = 8;
    for (int r0 = F.gw; r0 < T; r0 += RB * F.NGW) {
        unsigned w1[RB], w2[RB]; f32x2 cs[RB], sn[RB]; float x1[RB], x2[RB], c16[RB], s16[RB], iw[RB];
#pragma unroll
        for (int j = 0; j < RB; ++j) { const int r = r0 + j * F.NGW; const float z0 = zero_op();
            w1[j] = 0u; w2[j] = 0u; cs[j] = (f32x2){z0, z0}; sn[j] = (f32x2){z0, z0}; x1[j] = z0; x2[j] = z0; c16[j] = z0; s16[j] = z0; iw[j] = z0;
            if (r < T) { const bf16_t* p = PROJ + (size_t)r * NPROJ;
                { const bf16_t* q = p + C_DK + hd * 64; w1[j] = *(const unsigned*)(q + i2); w2[j] = *(const unsigned*)(q + 32 + i2); }
                cs[j] = *(const f32x2*)(C32 + (size_t)r * 32 + i2); sn[j] = *(const f32x2*)(S32 + (size_t)r * 32 + i2);
                if (lane < 32) { const bf16_t* q = p + (second ? C_IK : C_KR); x1[j] = bf2f(q[i1]); x2[j] = bf2f(q[i1 + 16]); c16[j] = C16[(size_t)r * 16 + i1]; s16[j] = S16[(size_t)r * 16 + i1]; }
                if (lane < 8) iw[j] = bf2f(p[C_IW + lane]); } }
#pragma unroll
        for (int j = 0; j < RB; ++j) { const int r = r0 + j * F.NGW;
            if (r < T) {
            { const float a0 = bflo(w1[j]), a1 = bfhi(w1[j]), b0 = bflo(w2[j]), b1 = bfhi(w2[j]);
              bf16_t* o = DK + (size_t)r * 256 + hd * 64;
              *(unsigned*)(o + i2) = pk2(a0 * cs[j].x - b0 * sn[j].x, a1 * cs[j].y - b1 * sn[j].y); *(unsigned*)(o + 32 + i2) = pk2(b0 * cs[j].x + a0 * sn[j].x, b1 * cs[j].y + a1 * sn[j].y); }
            float kn2 = 0.f;
            if (lane < 32) { bf16_t* o = (second ? IK : KR) + (size_t)r * 32; o[i1] = (bf16_t)f2bf(x1[j] * c16[j] - x2[j] * s16[j]); o[i1 + 16] = (bf16_t)f2bf(x2[j] * c16[j] + x1[j] * s16[j]);
              kn2 = second ? (x1[j] * x1[j] + x2[j] * x2[j]) : 0.f; }
            kn2 = wave_sum(kn2, lane);
            if (r < SEQ) kmx0 = fmaxf(kmx0, kn2); else kmx1 = fmaxf(kmx1, kn2);
            if (lane < 8) IW[(size_t)r * 8 + lane] = iw[j] * 0.0625f;
            } }
    }
    if (lane == 0) { F.MISC[32 + F.wave] = __builtin_bit_cast(unsigned, kmx0); F.MISC[40 + F.wave] = __builtin_bit_cast(unsigned, kmx1); }
    __syncthreads();
    if (F.tid < 2) { unsigned m = 0u; for (int w = 0; w < NWAVES; ++w) { const unsigned v = F.MISC[32 + 8 * F.tid + w]; m = v > m ? v : m; }
        atomicMax((unsigned*)(F.ctl + CW_KMAX + 64 * (l * 2 + F.tid)), m); }
}
namespace pg8 {
struct EpiStore {
    static constexpr bool PERM = true;
    DI void prefetch(const Unit&, int) const {}
    bf16_t* O; int ld;
    DI void operator()(const f32x4 (&acc)[2][2][4][2], const Unit& u, int wr, int wc, int fr, int fq) const {
        const int row0 = u.pm * BM + wr * 64 + fr, col0 = u.pn * BM + wc * 32 + 8 * fq;
#pragma unroll
        for (int ai = 0; ai < 2; ++ai)
#pragma unroll
            for (int m = 0; m < 4; ++m) { bf16_t* rowp = O + (size_t)(row0 + ai * HALF + m * 16) * ld + col0;
#pragma unroll
                for (int bj = 0; bj < 2; ++bj) { const f32x4 v0 = acc[ai][bj][m][0], v1 = acc[ai][bj][m][1];
                    u32x4 w; w.x = cvt_pk_bf16(v0[0], v0[1]); w.y = cvt_pk_bf16(v0[2], v0[3]); w.z = cvt_pk_bf16(v1[0], v1[1]); w.w = cvt_pk_bf16(v1[2], v1[3]);
                    *(u32x4*)(rowp + bj * HALF) = w; } }
    }
};
struct EpiStoreRS {
    static constexpr bool PERM = true;
    DI void prefetch(const Unit&, int) const {}
    bf16_t* O; int ld; LAS const float* rs;
    DI void operator()(const f32x4 (&acc)[2][2][4][2], const Unit& u, int wr, int wc, int fr, int fq) const {
        const int row0 = u.pm * BM + wr * 64 + fr, col0 = u.pn * BM + wc * 32 + 8 * fq;
#pragma unroll
        for (int ai = 0; ai < 2; ++ai)
#pragma unroll
            for (int m = 0; m < 4; ++m) { bf16_t* rowp = O + (size_t)(row0 + ai * HALF + m * 16) * ld + col0; const float s = rs[wr * 64 + fr + ai * HALF + m * 16];
#pragma unroll
                for (int bj = 0; bj < 2; ++bj) { const f32x4 v0 = acc[ai][bj][m][0] * s, v1 = acc[ai][bj][m][1] * s;
                    u32x4 w; w.x = cvt_pk_bf16(v0[0], v0[1]); w.y = cvt_pk_bf16(v0[2], v0[3]); w.z = cvt_pk_bf16(v1[0], v1[1]); w.w = cvt_pk_bf16(v1[2], v1[3]);
                    *(u32x4*)(rowp + bj * HALF) = w; } }
    }
};
struct EpiBranch {
    static constexpr bool PERM = true;
    DI void prefetch(const Unit&, int) const {}
    bf16_t* MRG; const bf16_t* PROJ; int gate0; int first;
    DI void operator()(const f32x4 (&acc)[2][2][4][2], const Unit& u, int wr, int wc, int fr, int fq) const {
        const int row0 = u.pm * BM + wr * 64 + fr, col0 = u.pn * BM + wc * 32 + 8 * fq;
#pragma unroll
        for (int ai = 0; ai < 2; ++ai) {
                u32x4 gl[4][2], pv[4][2];
#pragma unroll
                for (int m = 0; m < 4; ++m) { const size_t row = (size_t)(row0 + ai * HALF + m * 16);
#pragma unroll
                    for (int bj = 0; bj < 2; ++bj) { gl[m][bj] = *(const u32x4*)(PROJ + row * NPROJ + gate0 + col0 + bj * HALF);
                        if (!first) pv[m][bj] = *(const u32x4*)(MRG + row * DM + col0 + bj * HALF); else pv[m][bj] = (u32x4){0u, 0u, 0u, 0u}; } }
                __builtin_amdgcn_sched_barrier(0);
#pragma unroll
                for (int m = 0; m < 4; ++m) { const size_t row = (size_t)(row0 + ai * HALF + m * 16);
#pragma unroll
                    for (int bj = 0; bj < 2; ++bj) { const f32x4 v0 = acc[ai][bj][m][0], v1 = acc[ai][bj][m][1]; const u32x4 g_ = gl[m][bj], p_ = pv[m][bj];
                        bf16_t* mp_ = MRG + row * DM + col0 + bj * HALF;
                        float o[8];
                        o[0] = fast_sigmoid(bflo(g_.x)) * v0[0]; o[1] = fast_sigmoid(bfhi(g_.x)) * v0[1]; o[2] = fast_sigmoid(bflo(g_.y)) * v0[2]; o[3] = fast_sigmoid(bfhi(g_.y)) * v0[3];
                        o[4] = fast_sigmoid(bflo(g_.z)) * v1[0]; o[5] = fast_sigmoid(bfhi(g_.z)) * v1[1]; o[6] = fast_sigmoid(bflo(g_.w)) * v1[2]; o[7] = fast_sigmoid(bfhi(g_.w)) * v1[3];
                        if (!first) { o[0] += bflo(p_.x); o[1] += bfhi(p_.x); o[2] += bflo(p_.y); o[3] += bfhi(p_.y); o[4] += bflo(p_.z); o[5] += bfhi(p_.z); o[6] += bflo(p_.w); o[7] += bfhi(p_.w); }
                        u32x4 w; w.x = cvt_pk_bf16(o[0], o[1]); w.y = cvt_pk_bf16(o[2], o[3]); w.z = cvt_pk_bf16(o[4], o[5]); w.w = cvt_pk_bf16(o[6], o[7]);
                        *(u32x4*)mp_ = w; } }
            }
    }
};
struct EpiResid {
    static constexpr bool PERM = false;
    DI void prefetch(const Unit&, int) const {}
    float* X; const float* gvec; size_t dofs;
    DI void operator()(const f32x4 (&acc)[2][2][4][2], const Unit& u, int wr, int wc, int fr, int fq) const {
        const int row0 = u.pm * BM + wr * 64 + fr, col0 = u.pn * BM + wc * 32 + 4 * fq; const float* g = gvec + (size_t)((u.pm * BM) / SEQ) * 6 * DM;
#pragma unroll
        for (int bj = 0; bj < 2; ++bj) { f32x4 gv[2];
#pragma unroll
            for (int n = 0; n < 2; ++n) gv[n] = *(const f32x4*)(g + col0 + bj * HALF + n * 16);
            f32x4 xv[2][4][2];
#pragma unroll
            for (int ai = 0; ai < 2; ++ai)
#pragma unroll
                for (int m = 0; m < 4; ++m)
#pragma unroll
                    for (int n = 0; n < 2; ++n) xv[ai][m][n] = *(const f32x4*)(X + (size_t)(row0 + ai * HALF + m * 16) * DM + col0 + bj * HALF + n * 16);
            __builtin_amdgcn_sched_barrier(0);
#pragma unroll
            for (int ai = 0; ai < 2; ++ai)
#pragma unroll
                for (int m = 0; m < 4; ++m)
#pragma unroll
                    for (int n = 0; n < 2; ++n) { float* xp = X + (size_t)(row0 + ai * HALF + m * 16) * DM + col0 + bj * HALF + n * 16;
                        *(f32x4*)((char*)xp + dofs) = xv[ai][m][n] + gv[n] * acc[ai][bj][m][n]; } }
    }
};
struct MoeTab { LAS const int* cnt; LAS const int* tpre; LAS const int* off; LAS const int* xe; LAS const int* xt; };
template <bool GATHER, int NCOLT> struct MoeSched {
    const bf16_t* A; const bf16_t* Bt; const int* list; MoeTab tb; int K, G, c; LAS unsigned* ltab;
    DI bool next(int i, Unit& u) const {
        const int GX = G >> 3, x = c & 7, j = c >> 3; if (j >= GX) return false;
        LAS const int* xt = tb.xt + x * 5;
        const int L = i * GX + j; if (L >= __builtin_amdgcn_readfirstlane(xt[4]) * NCOLT) return false;
        const int tile = L / NCOLT; u.pn = L % NCOLT; int k = 0; while (__builtin_amdgcn_readfirstlane(xt[k + 1]) <= tile) ++k;
        const int e = __builtin_amdgcn_readfirstlane(tb.xe[x * 4 + k]), tp = __builtin_amdgcn_readfirstlane(xt[k]);
        const int of = __builtin_amdgcn_readfirstlane(tb.off[e]), cn = __builtin_amdgcn_readfirstlane(tb.cnt[e]);
        u.e = e; u.pm = (tile - tp) * BM; u.row0 = of + u.pm; const int left = cn - u.pm; u.nrows = left < BM ? left : BM; return true;
    }
    DI const char* abase(const Unit& u) const { return GATHER ? (const char*)A : (const char*)A + (size_t)u.row0 * K * 2; }
    DI const char* bbase(const Unit& u) const { return (const char*)Bt + ((size_t)u.e * NCOLT * BM + (size_t)u.pn * BM) * K * 2; }
    DI void aoffs(const Unit& u, int R, int C, unsigned (&v)[4]) const {
#pragma unroll
        for (int m = 0; m < 4; ++m) { int rr = R + 64 * m;
            if (GATHER) { rr = rr < u.nrows ? rr : 0; rr = list[u.e * ECAP + u.pm + rr]; }
            v[m] = (unsigned)(rr * K + C) * 2u; }
    }
    DI void prefetch(const Unit& u, int tid, int par) const {
        if (GATHER) { if (tid < 256) { const int rr = tid < u.nrows ? tid : 0;
            __builtin_amdgcn_global_load_lds((const unsigned*)(list + u.e * ECAP + u.pm + rr), (LAS unsigned*)(ltab + par * 256 + (tid & ~63)), 4, 0, 0); } }
    }
    DI void aoffs_next(const Unit& u, int R, int C, unsigned (&v)[4], int par) const {
        if (GATHER) {
#pragma unroll
            for (int m = 0; m < 4; ++m) v[m] = (unsigned)((int)ltab[par * 256 + R + 64 * m] * K + C) * 2u;
        } else aoffs(u, R, C, v);
    }
};
struct EpiSwiglu {
    static constexpr bool PERM = true;
    bf16_t* ACT; const float* bgu; LAS float* etab;
    DI void prefetch(const Unit& u, int tid) const {
        if (tid < 64) { const float* bg = bgu + (size_t)u.e * 2048 + u.pn * 128 + (tid < 32 ? 4 * tid : 1024 + 4 * (tid - 32));
            __builtin_amdgcn_global_load_lds((const unsigned*)bg, (LAS unsigned*)(etab + u.par * 256), 16, 0, 0); }
    }
    DI void operator()(const f32x4 (&acc)[2][2][4][2], const Unit& u, int wr, int wc, int fr, int fq) const {
        const int r0 = wr * 64 + fr, c0 = u.pn * BM + wc * 32 + 8 * fq; LAS const float* tb_ = etab + u.par * 256;
        f32x4 bgate[2], bup[2];
#pragma unroll
        for (int bj = 0; bj < 2; ++bj) { const int jj = wc * 16 + 4 * fq + bj * 64; bgate[bj] = *(LAS const f32x4*)(tb_ + jj); bup[bj] = *(LAS const f32x4*)(tb_ + 128 + jj); }
#pragma unroll
        for (int bj = 0; bj < 2; ++bj) { const int j0 = (c0 + bj * HALF) >> 1;
#pragma unroll
            for (int ai = 0; ai < 2; ++ai)
#pragma unroll
                for (int m = 0; m < 4; ++m) { const int r = r0 + ai * HALF + m * 16; const f32x4 v0 = acc[ai][bj][m][0], v1 = acc[ai][bj][m][1];
                    float g[4] = {v0[0] + bgate[bj][0], v0[2] + bgate[bj][1], v1[0] + bgate[bj][2], v1[2] + bgate[bj][3]};
                    float p[4] = {v0[1] + bup[bj][0], v0[3] + bup[bj][1], v1[1] + bup[bj][2], v1[3] + bup[bj][3]};
                    float o[4];
#pragma unroll
                    for (int k = 0; k < 4; ++k) { const float gg = fminf(g[k], 7.0f), uu = fminf(fmaxf(p[k], -7.0f), 7.0f); o[k] = (uu + 1.0f) * (gg * fast_sigmoid(1.702f * gg)); }
                    if (r < u.nrows) { u32x2 w; w.x = cvt_pk_bf16(o[0], o[1]); w.y = cvt_pk_bf16(o[2], o[3]); *(u32x2*)(ACT + (size_t)(u.row0 + r) * DM + j0) = w; } } }
    }
};
struct EpiDown {
    static constexpr bool PERM = true;
    bf16_t* EOUT; const float* bdn; const float* listw; LAS float* etab;
    DI void prefetch(const Unit& u, int tid) const {
        if (tid < 128) { const float* src = tid < 64 ? bdn + (size_t)u.e * DM + u.pn * BM + 4 * tid : listw + (size_t)u.e * ECAP + u.pm + 4 * (tid - 64);
            __builtin_amdgcn_global_load_lds((const unsigned*)src, (LAS unsigned*)(etab + u.par * 512 + (tid & 64) * 4), 16, 0, 0); }
    }
    DI void operator()(const f32x4 (&acc)[2][2][4][2], const Unit& u, int wr, int wc, int fr, int fq) const {
        const int r0 = wr * 64 + fr, c0 = u.pn * BM + wc * 32 + 8 * fq; LAS const float* tb_ = etab + u.par * 512;
        f32x4 b0[2], b1[2]; float cw[2][4];
#pragma unroll
        for (int bj = 0; bj < 2; ++bj) { const int cc = wc * 32 + 8 * fq + bj * HALF; b0[bj] = *(LAS const f32x4*)(tb_ + cc); b1[bj] = *(LAS const f32x4*)(tb_ + cc + 4); }
#pragma unroll
        for (int ai = 0; ai < 2; ++ai)
#pragma unroll
            for (int m = 0; m < 4; ++m) cw[ai][m] = tb_[256 + r0 + ai * HALF + m * 16];
#pragma unroll
        for (int ai = 0; ai < 2; ++ai)
#pragma unroll
            for (int m = 0; m < 4; ++m) { const int r = r0 + ai * HALF + m * 16;
                if (r < u.nrows) {
#pragma unroll
                    for (int bj = 0; bj < 2; ++bj) {
                        const f32x4 v0 = (acc[ai][bj][m][0] + b0[bj]) * cw[ai][m], v1 = (acc[ai][bj][m][1] + b1[bj]) * cw[ai][m];
                        u32x4 w; w.x = cvt_pk_bf16(v0[0], v0[1]); w.y = cvt_pk_bf16(v0[2], v0[3]); w.z = cvt_pk_bf16(v1[0], v1[1]); w.w = cvt_pk_bf16(v1[2], v1[3]);
                        *(u32x4*)(EOUT + (size_t)(u.row0 + r) * DM + c0 + bj * HALF) = w; } } }
    }
};
}

DI pg8::MoeTab moe_tables_again(Frame& F) {
    pg8::MoeTab tb; tb.cnt = (LAS int*)(F.MISC + 64); tb.tpre = (LAS int*)(F.MISC + 100); tb.off = (LAS int*)(F.MISC + 140); tb.xe = (LAS int*)(F.MISC + 176); tb.xt = (LAS int*)(F.MISC + 208);
    __syncthreads();
    return tb;
}
DI pg8::MoeTab moe_tables(Frame& F, int l) {
    LAS int* cnt = (LAS int*)(F.MISC + 64); LAS int* tpre = (LAS int*)(F.MISC + 100); LAS int* off = (LAS int*)(F.MISC + 140);
    LAS int* xe = (LAS int*)(F.MISC + 176); LAS int* xt = (LAS int*)(F.MISC + 208);
    __syncthreads();
    if (F.tid < NEXP) cnt[F.tid] = (int)__hip_atomic_load(F.ctl + CW_CNT + l * NEXP + F.tid, RLX_AGENT);
    __syncthreads();
    if (F.tid == 0) { int tp = 0, so = 0; for (int e = 0; e < NEXP; ++e) { tpre[e] = tp; off[e] = so; tp += (cnt[e] + 255) >> 8; so += cnt[e]; } tpre[NEXP] = tp; off[NEXP] = so; }
    if (F.tid >= 64 && F.tid < 64 + NEXP) {
        const int e = F.tid - 64, tl = (cnt[e] + 255) >> 8; int r = 0;
        for (int o = 0; o < NEXP; ++o) { const int to = (cnt[o] + 255) >> 8; r += (to > tl || (to == tl && o < e)) ? 1 : 0; }
        const int grp = r >> 3, pos = r & 7, x = (grp & 1) ? 7 - pos : pos; xe[x * 4 + grp] = e; }
    __syncthreads();
    if (F.tid < 8) { int s = 0; for (int k = 0; k < 4; ++k) { xt[F.tid * 5 + k] = s; s += (cnt[xe[F.tid * 4 + k]] + 255) >> 8; } xt[F.tid * 5 + 4] = s; }
    __syncthreads();
    pg8::MoeTab tb; tb.cnt = cnt; tb.tpre = tpre; tb.off = off; tb.xe = xe; tb.xt = xt; return tb;
}
DI unsigned f_sortable(float f) { const unsigned b = __builtin_bit_cast(unsigned, f); return b ^ ((b >> 31) ? 0xFFFFFFFFu : 0x80000000u); }
DI void p_norm2_router(Frame& F, ArgsP a, int l, size_t dofs = 0, int cslot = -1) {
    if (cslot < 0) cslot = l;
    LAS float* WT = (LAS float*)(F.lds + RING_OFF);
    { const float* rw = ((const float*)a->router_w) + (size_t)l * DM * NEXP;
#pragma unroll
      for (int ch = 0; ch < 2; ++ch) { const int k = 128 * F.wave + 64 * ch + F.lane; f32x4 w[8];
#pragma unroll
          for (int e4 = 0; e4 < 8; ++e4) w[e4] = *(const f32x4*)(rw + (size_t)k * NEXP + 4 * e4);
#pragma unroll
          for (int e4 = 0; e4 < 8; ++e4) { WT[(4 * e4 + 0) * DM + k] = w[e4].x; WT[(4 * e4 + 1) * DM + k] = w[e4].y; WT[(4 * e4 + 2) * DM + k] = w[e4].z; WT[(4 * e4 + 3) * DM + k] = w[e4].w; } } }
    __syncthreads();
    const float* MOD = (const float*)(F.ws + opq(WS_MOD)); const float* X = (const float*)(F.ws + opq(WS_X)); bf16_t* XN = (bf16_t*)(F.ws + opq(WS_XN) + dofs);
    int* LIST = (int*)(F.ws + opq(WS_LIST) + dofs); float* LISTW = (float*)(F.ws + opq(WS_LISTW) + dofs); int* TOKE = (int*)(F.ws + opq(WS_TOKE) + dofs);
    volatile LAS unsigned* RENT = (volatile LAS unsigned*)(F.lds + MISC_OFF + 1024);
    if (F.tid < NEXP) F.MISC[64 + F.tid] = 0u;
    const int lane = F.lane; const int e_mine = lane >> 1;
    const float rb = ((const float*)a->router_b)[l * NEXP + e_mine];
    constexpr int RPW = 8;
    const int rstride = F.NGW * RPW, riters = (T + rstride - 1) / rstride;
    for (int rit = 0; rit < riters; ++rit) {
        const int r0 = F.gw * RPW + rit * rstride; const bool ract = r0 < T;
        if (ract) {
        const int b = r0 / SEQ; const float* mod = MOD + (size_t)(l * 2 + b) * 6 * DM;
        RowCoef c; load_coef(c, ((const float*)a->norm_ffn_g) + l * DM, mod + 3 * DM, mod + 4 * DM, lane);
        f32x4 nx[4];
#pragma unroll
        for (int j = 0; j < 4; ++j) nx[j] = *(const f32x4*)(X + (size_t)r0 * DM + 4 * lane + 256 * j);
        for (int r = r0; r < r0 + RPW; ++r) {
            f32x4 h[4];
#pragma unroll
            for (int j = 0; j < 4; ++j) h[j] = nx[j];
            if (r + 1 < r0 + RPW) {
#pragma unroll
                for (int j = 0; j < 4; ++j) nx[j] = *(const f32x4*)(X + (size_t)(r + 1) * DM + 4 * lane + 256 * j); }
            const float rstd = row_rstd(h, lane);
#pragma unroll
            for (int j = 0; j < 4; ++j) h[j] = h[j] * rstd * c.a[j] + c.b[j];
            store_xn(XN + (size_t)r * DM, h, lane);
            float v[32];
#pragma unroll
            for (int e = 0; e < 32; ++e) { float s = 0.f;
#pragma unroll
                for (int j = 0; j < 4; ++j) { const f32x4 w = *(const LAS f32x4*)(WT + e * DM + 4 * lane + 256 * j); s += (h[j].x * w.x + h[j].y * w.y) + (h[j].z * w.z + h[j].w * w.w); }
                v[e] = s; if ((e & 3) == 3) __builtin_amdgcn_sched_barrier(0); }
            float a16[16], a8[8], a4[4], a2[2], a1;
            { const bool up = lane & 32;
#pragma unroll
              for (int i = 0; i < 16; ++i) { const float keep = up ? v[16 + i] : v[i], send = up ? v[i] : v[16 + i]; a16[i] = keep + shx(send, 32, lane); } }
            { const bool up = lane & 16;
#pragma unroll
              for (int i = 0; i < 8; ++i) { const float keep = up ? a16[8 + i] : a16[i], send = up ? a16[i] : a16[8 + i]; a8[i] = keep + shx(send, 16, lane); } }
            { const bool up = lane & 8;
#pragma unroll
              for (int i = 0; i < 4; ++i) { const float keep = up ? a8[4 + i] : a8[i], send = up ? a8[i] : a8[4 + i]; a4[i] = keep + shx(send, 8, lane); } }
            { const bool up = lane & 4;
#pragma unroll
              for (int i = 0; i < 2; ++i) { const float keep = up ? a4[2 + i] : a4[i], send = up ? a4[i] : a4[2 + i]; a2[i] = keep + shx(send, 4, lane); } }
            { const bool up = lane & 2; const float keep = up ? a2[1] : a2[0], send = up ? a2[0] : a2[1]; a1 = keep + shx(send, 2, lane); }
            a1 += shx(a1, 1, lane);
            const float logit = a1 + rb;
            int te[4]; float tv[4];
            { const unsigned ks = f_sortable(logit); int rank = 0;
#pragma unroll
              for (int eo = 0; eo < 32; ++eo) { const unsigned ko = (unsigned)__builtin_amdgcn_ds_bpermute(eo << 3, (int)ks); rank += (ko > ks || (ko == ks && eo < e_mine)) ? 1 : 0; }
#pragma unroll
              for (int k = 0; k < 4; ++k) { const unsigned long long mk = __ballot(rank == k && !(lane & 1)); const int src = __builtin_ctzll(mk | (1ull << 63)); te[k] = src >> 1; tv[k] = shl(logit, src); } }
            const float e1 = __expf(tv[1] - tv[0]), e2 = __expf(tv[2] - tv[0]), e3 = __expf(tv[3] - tv[0]); const float inv = 1.0f / (1.0f + e1 + e2 + e3);
            if (lane < 4) {
                const int ek = lane == 0 ? te[0] : lane == 1 ? te[1] : lane == 2 ? te[2] : te[3];
                const float wk = (lane == 0 ? 1.0f : lane == 1 ? e1 : lane == 2 ? e2 : e3) * inv;
                const unsigned lr = __hip_atomic_fetch_add((LAS unsigned*)(F.MISC + 64 + ek), 1u, __ATOMIC_RELAXED, __HIP_MEMORY_SCOPE_WORKGROUP);
                RENT[((F.wave * RPW + (r - r0)) * 4 + lane) * 2] = (unsigned)ek | (lr << 8); RENT[((F.wave * RPW + (r - r0)) * 4 + lane) * 2 + 1] = __builtin_bit_cast(unsigned, wk);
            }
        }
        }
        __syncthreads();
        if (F.tid < NEXP) { const unsigned c = F.MISC[64 + F.tid]; F.MISC[96 + F.tid] = c ? __hip_atomic_fetch_add(F.ctl + CW_CNT + cslot * NEXP + F.tid, c, RLX_AGENT) : 0u; F.MISC[64 + F.tid] = 0u; }
        __syncthreads();
        if (ract && lane < 4 * RPW) { const int ri = lane >> 2, k = lane & 3, r = r0 + ri;
            const unsigned en = RENT[((F.wave * RPW + ri) * 4 + k) * 2]; const int ek = en & 0xff; const int rank = (int)(F.MISC[96 + ek] + (en >> 8));
            LIST[ek * ECAP + rank] = r; LISTW[ek * ECAP + rank] = __builtin_bit_cast(float, RENT[((F.wave * RPW + ri) * 4 + k) * 2 + 1]); TOKE[r * 4 + k] = ek | (rank << 8); }
        __syncthreads();
    }
}
DI void p_combine(Frame& F, ArgsP a, int l, const pg8::MoeTab& tb, size_t dofs = 0) {
    const float* MOD = (const float*)(F.ws + opq(WS_MOD)); const float* X = (const float*)(F.ws + opq(WS_X)); float* XO = (float*)(F.ws + opq(WS_X) + dofs); bf16_t* XN = (bf16_t*)(F.ws + opq(WS_XN) + dofs);
    const bf16_t* EOUT = (const bf16_t*)(F.ws + opq(WS_EOUT)); const int* TOKE = (const int*)(F.ws + opq(WS_TOKE));
    const int lane = F.lane; const bool lastl = (l == DEPTH - 1);
    constexpr int RPW = 8;
    for (int r0 = F.gw * RPW; r0 < T; r0 += F.NGW * RPW) {
        const int b = r0 / SEQ; const float* mod = MOD + (size_t)(l * 2 + b) * 6 * DM;
        f32x4 gf[4];
#pragma unroll
        for (int j = 0; j < 4; ++j) gf[j] = *(const f32x4*)(mod + 5 * DM + 4 * lane + 256 * j);
        RowCoef c;
        if (!lastl) { const float* modn = MOD + (size_t)((l + 1) * 2 + b) * 6 * DM; load_coef(c, ((const float*)a->norm_mix_g) + (l + 1) * DM, modn + 0 * DM, modn + 1 * DM, lane); }
        else {
#pragma unroll
            for (int j = 0; j < 4; ++j) { c.a[j] = *(const f32x4*)(((const float*)a->final_g) + 4 * lane + 256 * j); const float z0 = zero_op(); c.b[j] = (f32x4){z0, z0, z0, z0}; } }
        int myslot = 0;
        if (lane < 4 * RPW) { const int te = TOKE[(size_t)r0 * 4 + lane]; myslot = tb.off[te & 0xff] + (te >> 8); }
        u32x2 ne[4][4]; f32x4 nx[4];
#define CB_LOAD(r_) do { _Pragma("unroll") for (int k = 0; k < 4; ++k) { const int slot = __builtin_amdgcn_readlane(myslot, 4 * ((r_) - r0) + k); const bf16_t* ep = EOUT + (size_t)slot * DM; \
            _Pragma("unroll") for (int j = 0; j < 4; ++j) ne[k][j] = *(const u32x2*)(ep + 4 * lane + 256 * j); } \
            _Pragma("unroll") for (int j = 0; j < 4; ++j) nx[j] = *(const f32x4*)(X + (size_t)(r_) * DM + 4 * lane + 256 * j); } while (0)
        f32x4 v[4]; u32x2 ce[4][4];
#pragma unroll 1
        for (int r = r0; r < r0 + RPW; ++r) {
            if (r == r0) {
#pragma unroll
                for (int ri = 0; ri < 1; ++ri) CB_LOAD(r0); }
#pragma unroll
            for (int k = 0; k < 4; ++k)
#pragma unroll
                for (int j = 0; j < 4; ++j) ce[k][j] = ne[k][j];
#pragma unroll
            for (int j = 0; j < 4; ++j) v[j] = nx[j];
            if (r + 1 < r0 + RPW) CB_LOAD(r + 1);
            f32x4 y[4];
#pragma unroll
            for (int j = 0; j < 4; ++j) { const float z0 = zero_op(); y[j] = (f32x4){z0, z0, z0, z0}; }
#ifndef DBG_SKIP_MOE
#pragma unroll
            for (int k = 0; k < 4; ++k)
#pragma unroll
                for (int j = 0; j < 4; ++j) { const u32x2 w = ce[k][j]; y[j].x += bflo(w.x); y[j].y += bfhi(w.x); y[j].z += bflo(w.y); y[j].w += bfhi(w.y); }
#endif
#pragma unroll
            for (int j = 0; j < 4; ++j) v[j] = v[j] + gf[j] * y[j];
            const float rstd = row_rstd(v, lane);
            f32x4 h[4];
#pragma unroll
            for (int j = 0; j < 4; ++j) h[j] = v[j] * rstd * c.a[j] + c.b[j];
            if (!lastl) {
#pragma unroll
                for (int j = 0; j < 4; ++j) *(f32x4*)(XO + (size_t)r * DM + 4 * lane + 256 * j) = v[j];
                store_xn(XN + (size_t)r * DM, h, lane);
            } else {
#pragma unroll
                for (int j = 0; j < 4; ++j) *(f32x4*)((dofs ? XO : (float*)a->out) + (size_t)r * DM + 4 * lane + 256 * j) = h[j];
            }
        }
    }
}
DI f32x16 mfma32(bf16x8 a, bf16x8 b, f32x16 c) { return __builtin_amdgcn_mfma_f32_32x32x16_bf16(a, b, c, 0, 0, 0); }
typedef short v4i16_t __attribute__((ext_vector_type(4)));
DI s16x4 tr_read(LAS const unsigned char* p) { return __builtin_bit_cast(s16x4, __builtin_amdgcn_ds_read_tr16_b64_v4i16((LAS v4i16_t*)p)); }
DI int crow(int reg, int h) { return (reg & 3) + 8 * (reg >> 2) + 4 * h; }
template <int S> DI bf16x8 pack8(const f32x16& x) {
    u32x4 p; p.x = cvt_pk_bf16(x[8 * S + 0], x[8 * S + 1]); p.y = cvt_pk_bf16(x[8 * S + 2], x[8 * S + 3]); p.z = cvt_pk_bf16(x[8 * S + 4], x[8 * S + 5]); p.w = cvt_pk_bf16(x[8 * S + 6], x[8 * S + 7]);
    return __builtin_bit_cast(bf16x8, p);
}
DI bf16x8 scale8(bf16x8 v, float s) {
    u32x4 w = __builtin_bit_cast(u32x4, v); u32x4 o;
    o.x = pk2(bflo(w.x) * s, bfhi(w.x) * s); o.y = pk2(bflo(w.y) * s, bfhi(w.y) * s); o.z = pk2(bflo(w.z) * s, bfhi(w.z) * s); o.w = pk2(bflo(w.w) * s, bfhi(w.w) * s);
    return __builtin_bit_cast(bf16x8, o);
}
struct Rope8 { float c[8], d[8]; };
DI void rope_load(Rope8& r, const float* cs, const float* sn) {
    const f32x4 c0 = *(const f32x4*)cs, c1 = *(const f32x4*)(cs + 4), s0 = *(const f32x4*)sn, s1 = *(const f32x4*)(sn + 4);
#pragma unroll
    for (int j = 0; j < 4; ++j) { r.c[j] = c0[j]; r.c[4 + j] = c1[j]; r.d[j] = s0[j]; r.d[4 + j] = s1[j]; }
}
DI void rope_apply(bf16x8& a, bf16x8& b, const Rope8& r, float s) {
    const u32x4 wa = __builtin_bit_cast(u32x4, a), wb = __builtin_bit_cast(u32x4, b); u32x4 oa, ob;
#pragma unroll
    for (int p = 0; p < 4; ++p) { const float a0 = bflo(wa[p]), a1 = bfhi(wa[p]), b0 = bflo(wb[p]), b1 = bfhi(wb[p]);
        oa[p] = pk2((a0 * r.c[2 * p] - b0 * r.d[2 * p]) * s, (a1 * r.c[2 * p + 1] - b1 * r.d[2 * p + 1]) * s);
        ob[p] = pk2((b0 * r.c[2 * p] + a0 * r.d[2 * p]) * s, (b1 * r.c[2 * p + 1] + a1 * r.d[2 * p + 1]) * s); }
    asm volatile("" : "+v"(oa), "+v"(ob));
    a = __builtin_bit_cast(bf16x8, oa); b = __builtin_bit_cast(bf16x8, ob);
}
DI void rope8(bf16x8& a, bf16x8& b, const float* cs, const float* sn, float s) { Rope8 r; rope_load(r, cs, sn); rope_apply(a, b, r, s); }
template <int KB2, int PST = 4096> DI void pv_block(f32x16 (&o)[2], const f32x16& p, LAS const unsigned char* vs, int lane) {
    const int hi = lane >> 5, i16 = lane & 15, q4 = i16 >> 2, p4 = i16 & 3, blk = (lane >> 4) & 1;
    const bf16x8 pb0 = pack8<0>(p), pb1 = pack8<1>(p);
    LAS const unsigned char* base = vs + (32 * KB2 + 4 * hi + q4) * 64 + (16 * blk + 4 * p4) * 2;
#pragma unroll
    for (int dh = 0; dh < 2; ++dh) {
        const s16x4 l0 = tr_read(base + dh * PST), h0 = tr_read(base + dh * PST + 8 * 64), l1 = tr_read(base + dh * PST + 16 * 64), h1 = tr_read(base + dh * PST + 24 * 64);
        const bf16x8 v0 = __builtin_shufflevector(l0, h0, 0, 1, 2, 3, 4, 5, 6, 7), v1 = __builtin_shufflevector(l1, h1, 0, 1, 2, 3, 4, 5, 6, 7);
        o[dh] = mfma32(v0, pb0, o[dh]); o[dh] = mfma32(v1, pb1, o[dh]);
    }
}
DI void store_ot(bf16_t* orow, const f32x16 (&o)[2], float sc, int hi) {
#pragma unroll
    for (int dh = 0; dh < 2; ++dh)
#pragma unroll
        for (int g = 0; g < 4; ++g) { u32x2 w; w.x = pk2(o[dh][4 * g] * sc, o[dh][4 * g + 1] * sc); w.y = pk2(o[dh][4 * g + 2] * sc, o[dh][4 * g + 3] * sc);
            *(u32x2*)(orow + 32 * dh + 8 * g + 4 * hi) = w; }
}
DI float max3f(float a, float b, float c) { float r; asm("v_max3_f32 %0, %1, %2, %3" : "=v"(r) : "v"(a), "v"(b), "v"(c)); return r; }
DI float rowmax32(const f32x16& A, const f32x16& B) {
    float m = max3f(A[0], B[0], A[1]), n = max3f(B[1], A[2], B[2]);
#pragma unroll
    for (int i = 3; i < 15; i += 2) { m = max3f(m, A[i], B[i]); n = max3f(n, A[i + 1], B[i + 1]); }
    return max3f(m, n, fmaxf(A[15], B[15]));
}
DI void raise_ref(f32x16& p0, f32x16& p1, f32x16 (&o)[2], f32x16& negm, float& m_ref, float& l_run, bool& init, float mx, int lane) {
    mx = fmaxf(mx, shx(mx, 32, lane)); const float dl = init ? fmaxf(mx, 0.f) : mx; init = true;
    m_ref += dl; const float alpha = __builtin_amdgcn_exp2f(-dl); l_run *= alpha;
#pragma unroll
    for (int i = 0; i < 16; ++i) { o[0][i] *= alpha; o[1][i] *= alpha; p0[i] -= dl; p1[i] -= dl; negm[i] = -m_ref; }
}
template <int BIT> DI float mask_bit(float e, unsigned word) {
    unsigned m; asm("v_bfe_i32 %0, %1, %2, 1" : "=v"(m) : "v"(word), "n"(BIT));
    return __builtin_bit_cast(float, __builtin_bit_cast(unsigned, e) & m);
}
constexpr int AT_KS = 13312, AT_K0 = 0, AT_V0 = 2 * AT_KS, AT_VS = 8192;

DI void mla_unit(Frame& F, int b, int h, int qb) {
    const bf16_t* QM = (const bf16_t*)(F.ws + opq(WS_QM)); const bf16_t* KVM = (const bf16_t*)(F.ws + opq(WS_KVM)); const bf16_t* KR = (const bf16_t*)(F.ws + opq(WS_KR)); bf16_t* OUT = (bf16_t*)(F.ws + opq(WS_OMLA));
    const float* C16 = (const float*)(F.ws + opq(WS_ROPE16)); const float* S16 = C16 + (size_t)T * 16;
    const int tid = F.tid, lane = F.lane, r32 = lane & 31, hi = lane >> 5, w = F.wave;
    const int qw = qb * 256 + 32 * w; const size_t row = (size_t)b * SEQ + qw + r32;
    constexpr float QS = 0.10206207261596577f * 1.4426950408889634f;
    bf16x8 qf[6];
    { const bf16_t* qp = QM + row * 768 + h * 96 + 8 * hi;
#pragma unroll
      for (int s = 0; s < 6; ++s) qf[s] = *(const bf16x8*)(qp + 16 * s);
#pragma unroll
      for (int s = 0; s < 4; ++s) qf[s] = scale8(qf[s], QS);
      rope8(qf[4], qf[5], C16 + row * 16 + 8 * hi, S16 + row * 16 + 8 * hi, QS); }
    const int NS = 2 * (qb + 1), cw = 4 * qb + (w >> 1);
    constexpr int MK = 4 * AT_KS;
    const int kr = tid >> 3, c8 = tid & 7, kr2 = (tid >> 2) & 63, c4 = tid & 3, rp = tid >> 8;
    const bf16_t* gk = KVM + ((size_t)b * SEQ + kr) * 768 + h * 128 + 8 * c8;
    const bf16_t* gr = KR + ((size_t)b * SEQ + rp * 64 + kr2) * 32 + 8 * c4;
    const int lk = kr * 208 + c8 * 16, lr = rp * AT_KS + kr2 * 208 + 128 + c4 * 16, lv = (c8 >> 2) * 4096 + kr * 64 + (c8 & 3) * 16;
    LAS unsigned char* L = F.lds + RING_OFF;
    u32x4 rkA, rvA, rkB, rvB, rr;
#define MLA_LOAD(s) do { const bf16_t* g_ = gk + (size_t)(s) * 128 * 768; rkA = *(const u32x4*)g_; rvA = *(const u32x4*)(g_ + 64); rkB = *(const u32x4*)(g_ + 64 * 768); rvB = *(const u32x4*)(g_ + 64 * 768 + 64); rr = *(const u32x4*)(gr + (size_t)(s) * 128 * 32); } while (0)
#define MLA_WRITE(bf) do { LAS unsigned char* k_ = L + (bf) * 2 * AT_KS; LAS unsigned char* v_ = L + MK + (bf) * 2 * AT_VS; *(LAS u32x4*)(k_ + lk) = rkA; *(LAS u32x4*)(v_ + lv) = rvA; *(LAS u32x4*)(k_ + AT_KS + lk) = rkB; *(LAS u32x4*)(v_ + AT_VS + lv) = rvB; *(LAS u32x4*)(k_ + lr) = rr; } while (0)
    MLA_LOAD(0); MLA_WRITE(0);
    __syncthreads();
    float m_ref = 0.f, l_run = 0.f; bool init = false; f32x16 o[2], negm; const float zz0 = zero_op();
#pragma unroll
    for (int i = 0; i < 16; ++i) { o[0][i] = zz0; o[1][i] = zz0; negm[i] = zz0; }
    for (int s = 0; s < NS; ++s) {
        const int bf = s & 1;
        if (s + 1 < NS) MLA_LOAD(s + 1);
#pragma unroll
        for (int u2 = 0; u2 < 2; ++u2) {
            if (2 * s + u2 <= cw) {
                f32x16 p0, p1;
                LAS const unsigned char* kb = L + (bf * 2 + u2) * AT_KS + r32 * 208 + hi * 16;
#pragma unroll
                for (int s6 = 0; s6 < 6; ++s6) { const bf16x8 a0 = *(LAS const bf16x8*)(kb + 32 * s6), a1 = *(LAS const bf16x8*)(kb + 32 * 208 + 32 * s6); p0 = mfma32(a0, qf[s6], s6 == 0 ? negm : p0); p1 = mfma32(a1, qf[s6], s6 == 0 ? negm : p1); }
                asm volatile("s_nop 15\n\ts_nop 7" : "+v"(p0), "+v"(p1));
                const float mx = rowmax32(p0, p1);
                if (!init || __any(mx > 8.0f)) raise_ref(p0, p1, o, negm, m_ref, l_run, init, mx, lane);
                float ls0 = 0.f, one = 1.0f; asm volatile("" : "+v"(one));
#pragma unroll
                for (int i = 0; i < 16; ++i) { p0[i] = __builtin_amdgcn_exp2f(p0[i]); p1[i] = __builtin_amdgcn_exp2f(p1[i]); ls0 = __builtin_fmaf(p0[i], one, ls0); ls0 = __builtin_fmaf(p1[i], one, ls0); }
                l_run += ls0;
                LAS const unsigned char* vs = L + MK + (bf * 2 + u2) * AT_VS;
                pv_block<0>(o, p0, vs, lane); pv_block<1>(o, p1, vs, lane);
            }
        }
        if (s + 1 < NS) MLA_WRITE(bf ^ 1);
        __syncthreads();
    }
#undef MLA_LOAD
#undef MLA_WRITE
    const float lt = l_run + shx(l_run, 32, lane);
#ifdef DBG_ZERO_MLA
    store_ot(OUT + row * 384 + h * 64, o, zz0, hi);
#else
    store_ot(OUT + row * 384 + h * 64, o, 1.0f / lt, hi);
#endif
}

DI void sb_unit(Frame& F, int b, int h, int qb) {
    const bf16_t* PROJ = (const bf16_t*)(F.ws + opq(WS_PROJ)); bf16_t* OUT = (bf16_t*)(F.ws + opq(WS_OSB));
    const int tid = F.tid, lane = F.lane, r32 = lane & 31, hi = lane >> 5, w = F.wave;
    const int qw = qb * 256 + 32 * w, qg = qw + r32; const size_t row = (size_t)b * SEQ + qg;
    bf16x8 qf[4];
    { const bf16_t* qp = PROJ + row * NPROJ + C_SBQ + h * 64 + 8 * hi;
#pragma unroll
      for (int s = 0; s < 4; ++s) qf[s] = *(const bf16x8*)(qp + 16 * s); }
    const int t_hi = 4 * qb + 3, cw = 4 * qb + (w >> 1);
    const int kr = tid >> 3, c8 = tid & 7;
    const bf16_t* gk = PROJ + ((size_t)b * SEQ + kr) * NPROJ + C_SBK + h * 64 + 8 * c8;
    const bf16_t* gv = PROJ + ((size_t)b * SEQ + kr) * NPROJ + C_SBV + h * 64 + 8 * c8;
    const int lk = kr * 144 + c8 * 16, lv = (c8 >> 2) * 4096 + kr * 64 + (c8 & 3) * 16;
    LAS unsigned char* L = F.lds + RING_OFF;
    volatile LAS unsigned* dflag = F.MISC + 16;
    u32x4 rk, rv;
#define SB_LOAD(t) do { rk = *(const u32x4*)(gk + (size_t)(t) * 64 * NPROJ); rv = *(const u32x4*)(gv + (size_t)(t) * 64 * NPROJ); } while (0)
#define SB_WRITE(bf) do { *(LAS u32x4*)(L + AT_K0 + (bf) * AT_KS + lk) = rk; *(LAS u32x4*)(L + AT_V0 + (bf) * AT_VS + lv) = rv; } while (0)
    SB_LOAD(t_hi); SB_WRITE(0);
    __syncthreads();
    float carry = 0.f; bool done = false; f32x16 o[2]; const float zz0 = zero_op();
#pragma unroll
    for (int i = 0; i < 16; ++i) { o[0][i] = zz0; o[1][i] = zz0; }
    int kt = t_hi;
    for (int it = 0;; ++it, --kt) {
        const int bf = it & 1;
        if (kt > 0) SB_LOAD(kt - 1);
        if (kt <= cw && !done) {
            f32x16 z[2];
#pragma unroll
            for (int i = 0; i < 16; ++i) { z[0][i] = zz0; z[1][i] = zz0; }
            LAS const unsigned char* kb = L + AT_K0 + bf * AT_KS + r32 * 144 + hi * 16;
#pragma unroll
            for (int s = 0; s < 4; ++s) { const bf16x8 a0 = *(LAS const bf16x8*)(kb + 32 * s), a1 = *(LAS const bf16x8*)(kb + 32 * 144 + 32 * s); z[0] = mfma32(a0, qf[s], z[0]); z[1] = mfma32(a1, qf[s], z[1]); }
            const int kbase = 64 * kt;
            float own[8];
#pragma unroll
            for (int kb2 = 0; kb2 < 2; ++kb2)
#pragma unroll
                for (int g = 0; g < 4; ++g) {
                    float lsv[4];
#pragma unroll
                    for (int j = 0; j < 4; ++j) { const int i = 4 * g + j; const float zz = z[kb2][i] * 0.125f; const int key = kbase + 32 * kb2 + crow(i, hi);
                        const float sp = fmaxf(zz, 0.f) + 0.6931471805599453f * __builtin_amdgcn_logf(1.0f + __builtin_amdgcn_exp2f(-1.4426950408889634f * fabsf(zz)));
                        const bool valid = key < qg; lsv[j] = valid ? -sp : 0.f; z[kb2][i] = valid ? (zz - sp) : -INFINITY; }
                    const float e2 = lsv[3], e1 = e2 + lsv[2], e0 = e1 + lsv[1];
                    z[kb2][4 * g + 2] += e2; z[kb2][4 * g + 1] += e1; z[kb2][4 * g + 0] += e0;
                    own[4 * kb2 + g] = e0 + lsv[0];
                }
            float par[8];
#pragma unroll
            for (int g = 0; g < 8; ++g) par[g] = shx(own[g], 32, lane);
            float so = 0.f, sp_ = 0.f;
#pragma unroll
            for (int g = 7; g >= 0; --g) {
                const float off = carry + so + (hi ? sp_ : sp_ + par[g]);
#pragma unroll
                for (int j = 0; j < 4; ++j) { const int kb2 = g >> 2, i = 4 * (g & 3) + j; z[kb2][i] = __builtin_amdgcn_exp2f(1.4426950408889634f * (z[kb2][i] + off)); }
                so += own[g]; sp_ += par[g];
            }
            carry += hi ? (sp_ + so) : (so + sp_);
            LAS const unsigned char* vs = L + AT_V0 + bf * AT_VS;
            pv_block<0>(o, z[0], vs, lane); pv_block<1>(o, z[1], vs, lane);
            done = __all(carry < -104.0f);
        }
        if (lane == 0) dflag[bf * 8 + w] = (done || kt == 0) ? 1u : 0u;
        if (kt > 0) SB_WRITE(bf ^ 1);
        __syncthreads();
        if (kt == 0) break;
        bool alld = true;
#pragma unroll
        for (int i = 0; i < 8; ++i) alld = alld && (dflag[bf * 8 + i] != 0u);
        if (alld) break;
    }
#undef SB_LOAD
#undef SB_WRITE
#ifdef DBG_ZERO_SB
    store_ot(OUT + row * 384 + h * 64, o, zz0, hi);
#else
    store_ot(OUT + row * 384 + h * 64, o, 1.0f, hi);
#endif
}
constexpr int DS_HIST = 0, DS_BITS = 65536, DS_VST = 98304, DS_NB = 512, DS_CAP = 256, DS_TOPK = 256;
constexpr int DM_ABOVE = 160, DM_CNT = 192;
constexpr int DL_INV = DS_VST, DL_OFF = DS_VST + 3 * 128, DL_BIN = DS_VST + 6 * 128;

DI int ds_bin(float s, float inv, float off) { const float t = __builtin_fmaf(s, inv, off); return (int)__builtin_amdgcn_fmed3f(t, 0.f, (float)(DS_NB - 1)); }

DI void ds_scores(float (&sc)[16], const bf16x8 k0, const bf16x8 k1, const bf16x8 (&qt)[2], const bf16x8 (&qi)[8][2], const float (&wh)[8], float zz0) {
    f32x16 z;
#pragma unroll
    for (int i = 0; i < 16; ++i) z[i] = zz0;
    f32x16 lin = mfma32(k0, qt[0], z); lin = mfma32(k1, qt[1], lin);
    f32x16 cur = mfma32(k0, qi[0][0], z); cur = mfma32(k1, qi[0][1], cur);
#pragma unroll
    for (int i = 0; i < 16; ++i) sc[i] = lin[i];
    __builtin_amdgcn_sched_barrier(0);
#pragma unroll
    for (int h = 0; h < 8; ++h) {
        f32x16 nxt = cur;
        if (h < 7) { nxt = mfma32(k0, qi[h + 1][0], z); nxt = mfma32(k1, qi[h + 1][1], nxt); }
#pragma unroll
        for (int i = 0; i < 16; ++i) sc[i] = __builtin_fmaf(wh[h], __builtin_fabsf(cur[i]), sc[i]);
        cur = nxt;
        __builtin_amdgcn_sched_barrier(0);
    }
    asm volatile("" : "+v"(sc[0]), "+v"(sc[1]), "+v"(sc[2]), "+v"(sc[3]), "+v"(sc[4]), "+v"(sc[5]), "+v"(sc[6]), "+v"(sc[7]));
    asm volatile("" : "+v"(sc[8]), "+v"(sc[9]), "+v"(sc[10]), "+v"(sc[11]), "+v"(sc[12]), "+v"(sc[13]), "+v"(sc[14]), "+v"(sc[15]));
}

DI void dsa_select_unit(Frame& F, int b, int qt_, int l) {
    const bf16_t* PROJ = (const bf16_t*)(F.ws + opq(WS_PROJ)); const bf16_t* IK = (const bf16_t*)(F.ws + opq(WS_IK));
    const float* IW = (const float*)(F.ws + opq(WS_IW));
    const float* C16 = (const float*)(F.ws + opq(WS_ROPE16)); const float* S16 = C16 + (size_t)T * 16;
    const int tid = F.tid, lane = F.lane, r32 = lane & 31, hi = lane >> 5, w = F.wave;
    const int q0 = qt_ * 32, chunk = q0 >> 6, NK = 64 * (chunk + 1), nblk = NK >> 5;
    const size_t row = (size_t)b * SEQ + q0 + r32, krow0 = (size_t)b * SEQ;
    LAS unsigned char* L = F.lds + RING_OFF;
    LAS unsigned* HIST = (LAS unsigned*)(L + DS_HIST); LAS unsigned* BITS = (LAS unsigned*)(L + DS_BITS);
    volatile LAS unsigned* M = F.MISC;
    const float zz0 = zero_op();
    { unsigned z0 = 0u; asm volatile("" : "+v"(z0));
      for (int i = tid; i < (DS_BITS + 32768) / 16; i += NTHR) *(LAS u32x4*)(L + i * 16) = (u32x4){z0, z0, z0, z0}; }
    if (NK <= DS_TOPK) {
        __syncthreads();
        for (int i = tid; i < nblk * 32; i += NTHR) BITS[i] = 0xFFFFFFFFu;
        __syncthreads();
    } else {
        bf16x8 qi[8][2], qt[2]; float wh[8];
        float B = 0.f;
        { const bf16_t* qp = PROJ + row * NPROJ + C_IQ + 8 * hi;
          Rope8 rp; rope_load(rp, C16 + row * 16 + 8 * hi, S16 + row * 16 + 8 * hi);
          const f32x4 w0 = *(const f32x4*)(IW + row * 8), w1 = *(const f32x4*)(IW + row * 8 + 4);
          wh[0] = 0.5f * w0[0]; wh[1] = 0.5f * w0[1]; wh[2] = 0.5f * w0[2]; wh[3] = 0.5f * w0[3]; wh[4] = 0.5f * w1[0]; wh[5] = 0.5f * w1[1]; wh[6] = 0.5f * w1[2]; wh[7] = 0.5f * w1[3];
          float ql[2][8];
#pragma unroll
          for (int s = 0; s < 2; ++s)
#pragma unroll
              for (int j = 0; j < 8; ++j) ql[s][j] = zz0;
#pragma unroll
          for (int h = 0; h < 8; ++h) { qi[h][0] = *(const bf16x8*)(qp + 32 * h); qi[h][1] = *(const bf16x8*)(qp + 32 * h + 16); }
          __builtin_amdgcn_sched_barrier(0);
#pragma unroll
          for (int h = 0; h < 8; ++h) {
              rope_apply(qi[h][0], qi[h][1], rp, 1.0f);
              float n2 = 0.f;
#pragma unroll
              for (int s = 0; s < 2; ++s)
#pragma unroll
                  for (int j = 0; j < 8; ++j) { const float v = bf2f((unsigned short)qi[h][s][j]); n2 = __builtin_fmaf(v, v, n2); ql[s][j] = __builtin_fmaf(wh[h], v, ql[s][j]); }
              n2 += shx(n2, 32, lane); B += 2.0f * fabsf(wh[h]) * sqrtf(n2);
              __builtin_amdgcn_sched_barrier(0); }
#pragma unroll
          for (int s = 0; s < 2; ++s) { u32x4 p; p.x = pk2(ql[s][0], ql[s][1]); p.y = pk2(ql[s][2], ql[s][3]); p.z = pk2(ql[s][4], ql[s][5]); p.w = pk2(ql[s][6], ql[s][7]); asm volatile("" : "+v"(p)); qt[s] = __builtin_bit_cast(bf16x8, p); } }
        { const float kmax = sqrtf(__builtin_bit_cast(float, __hip_atomic_load(F.ctl + CW_KMAX + 64 * (l * 2 + b), RLX_AGENT)));
          B = fmaxf(B * kmax * 1.03f, 1e-20f);
          if (w == 0 && hi == 0) { ((LAS float*)(L + DL_INV))[r32] = 1024.0f / B; ((LAS float*)(L + DL_OFF))[r32] = 256.0f; M[DM_ABOVE + r32] = 0u; } }
        __syncthreads();
        const bf16_t* kbase = IK + (krow0 + r32) * 32 + 8 * hi;
#define DS_LOADK(K0_, K1_, kb_) do { const bf16_t* kp_ = kbase + (size_t)(kb_) * 32 * 32; K0_ = *(const bf16x8*)kp_; K1_ = *(const bf16x8*)(kp_ + 16); } while (0)
        int lev = 0;
        for (;;) {
            float pinv[3], poff[3]; int pbin[3];
#pragma unroll
            for (int v = 0; v < 3; ++v) { pinv[v] = ((LAS float*)(L + DL_INV))[v * 32 + r32]; poff[v] = ((LAS float*)(L + DL_OFF))[v * 32 + r32]; pbin[v] = ((LAS int*)(L + DL_BIN))[v * 32 + r32]; }
#ifdef DBG_REP_S1
            for (int rep_ = 0; rep_ < 2; ++rep_)
#endif
            {
#ifdef DBG_REP_S1
                if (rep_) { __syncthreads(); unsigned z0 = 0u; asm volatile("" : "+v"(z0)); for (int i = tid; i < 65536 / 16; i += NTHR) *(LAS u32x4*)(L + DS_HIST + i * 16) = (u32x4){z0, z0, z0, z0}; __syncthreads(); }
#endif
                bf16x8 c0, c1, n0, n1; c0 = c1 = n0 = n1 = qt[0];
                if (w < nblk) DS_LOADK(c0, c1, w);
                if (lev == 0) {
                    const float inv0 = pinv[0], off0 = poff[0];
                    for (int kb = w; kb < nblk; kb += NWAVES) {
                        if (kb + NWAVES < nblk) DS_LOADK(n0, n1, kb + NWAVES);
                        float sc[16]; ds_scores(sc, c0, c1, qt, qi, wh, zz0);
#pragma unroll
                        for (int i = 0; i < 16; ++i) { const int bin = ds_bin(sc[i], inv0, off0);
                            __hip_atomic_fetch_add((LAS unsigned*)((LAS unsigned char*)HIST + (bin << 7) + (r32 << 2)), 1u, __ATOMIC_RELAXED, __HIP_MEMORY_SCOPE_WORKGROUP); }
                        c0 = n0; c1 = n1;
                    }
                } else {
                    for (int kb = w; kb < nblk; kb += NWAVES) {
                        if (kb + NWAVES < nblk) DS_LOADK(n0, n1, kb + NWAVES);
                        float sc[16]; ds_scores(sc, c0, c1, qt, qi, wh, zz0);
#pragma unroll
                        for (int i = 0; i < 16; ++i) { int bin = ds_bin(sc[i], pinv[0], poff[0]); bool in = (bin == pbin[0]); bin = ds_bin(sc[i], pinv[1], poff[1]);
                            if (lev >= 2) { in = in && (bin == pbin[1]); bin = ds_bin(sc[i], pinv[2], poff[2]); }
                            if (in) __hip_atomic_fetch_add(HIST + bin * 32 + r32, 1u, __ATOMIC_RELAXED, __HIP_MEMORY_SCOPE_WORKGROUP); }
                        c0 = n0; c1 = n1;
                    }
                }
            }
            __syncthreads();
#pragma unroll 1
            for (int sq = 0; sq < 4; ++sq) {
                int lane = F.lane; asm volatile("" : "+v"(lane));
                const int q = 4 * w + sq; unsigned hw[8]; unsigned mysum = 0;
#pragma unroll
                for (int i = 0; i < 8; ++i) { hw[i] = HIST[(8 * lane + i) * 32 + q]; mysum += hw[i]; }
                unsigned suf = mysum;
#pragma unroll
                for (int o = 1; o < 64; o <<= 1) { const unsigned t = (unsigned)__builtin_amdgcn_ds_bpermute(((lane + o) & 63) << 2, (int)suf); if (lane + o < 64) suf += t; }
                const unsigned above0 = M[DM_ABOVE + q]; const unsigned need = DS_TOPK - above0;
                const unsigned long long bal = __ballot(suf >= need);
                const int Ls = 63 - __builtin_clzll(bal | 1ull);
                const unsigned sufL = (unsigned)__builtin_amdgcn_ds_bpermute(Ls << 2, (int)suf), sumL = (unsigned)__builtin_amdgcn_ds_bpermute(Ls << 2, (int)mysum);
                unsigned acc = sufL - sumL; int bstar = 8 * Ls; unsigned cstar = 0;
#pragma unroll
                for (int i = 7; i >= 0; --i) { const unsigned c = (unsigned)__builtin_amdgcn_ds_bpermute(Ls << 2, (int)hw[i]);
                    if (cstar == 0u) { if (acc + c >= need) { bstar = 8 * Ls + i; cstar = c; } else acc += c; } }
                if (lane == 0) { ((LAS int*)(L + DL_BIN))[lev * 32 + q] = bstar; M[DM_ABOVE + q] = above0 + acc; M[DM_CNT + q] = cstar; }
            }
            __syncthreads();
            unsigned mxc = 0;
#pragma unroll 1
            for (int q = 0; q < 32; ++q) { const unsigned c = M[DM_CNT + q]; mxc = c > mxc ? c : mxc; }
            if (mxc <= (unsigned)DS_CAP || lev == 2) break;
            if (w == 0 && hi == 0) { const float pinv_ = ((LAS float*)(L + DL_INV))[lev * 32 + r32], poff_ = ((LAS float*)(L + DL_OFF))[lev * 32 + r32]; const int pb_ = ((LAS int*)(L + DL_BIN))[lev * 32 + r32];
                ((LAS float*)(L + DL_INV))[(lev + 1) * 32 + r32] = pinv_ * 511.5f; ((LAS float*)(L + DL_OFF))[(lev + 1) * 32 + r32] = (poff_ - (float)pb_) * 511.5f; }
            { unsigned z0 = 0u; asm volatile("" : "+v"(z0));
              for (int i = tid; i < 65536 / 16; i += NTHR) *(LAS u32x4*)(L + DS_HIST + i * 16) = (u32x4){z0, z0, z0, z0}; }
            ++lev;
            __syncthreads();
        }
        __syncthreads();
        if (tid < 32) M[DM_CNT + tid] = 0u;
        __syncthreads();
        {
            float pinv[3], poff[3]; int pbin[3];
#pragma unroll
            for (int v = 0; v < 3; ++v) { pinv[v] = ((LAS float*)(L + DL_INV))[v * 32 + r32]; poff[v] = ((LAS float*)(L + DL_OFF))[v * 32 + r32]; pbin[v] = ((LAS int*)(L + DL_BIN))[v * 32 + r32]; }
            LAS unsigned long long* CAND = (LAS unsigned long long*)(L + DS_HIST);
#define DS_SELBLK(K0_, K1_, kb_) do { float sc[16]; ds_scores(sc, K0_, K1_, qt, qi, wh, zz0); \
            unsigned word = 0u; const unsigned kinv = 0xFFFFu - (unsigned)((kb_) * 32 + 4 * hi); \
            _Pragma("unroll") for (int i = 0; i < 16; ++i) { \
                int bin = ds_bin(sc[i], pinv[0], poff[0]); bool sel = bin > pbin[0], eq = bin == pbin[0]; \
                if (lev >= 1) { bin = ds_bin(sc[i], pinv[1], poff[1]); sel = sel || (eq && bin > pbin[1]); eq = eq && bin == pbin[1]; } \
                if (lev >= 2) { bin = ds_bin(sc[i], pinv[2], poff[2]); sel = sel || (eq && bin > pbin[2]); eq = eq && bin == pbin[2]; } \
                if (sel) word |= 1u << crow(i, 0); \
                if (eq) { const unsigned slot = __hip_atomic_fetch_add((LAS unsigned*)(M + DM_CNT + r32), 1u, __ATOMIC_RELAXED, __HIP_MEMORY_SCOPE_WORKGROUP); \
                    if (slot < (unsigned)DS_CAP) CAND[r32 * DS_CAP + slot] = ((unsigned long long)f_sortable(sc[i]) << 32) | (unsigned)(kinv - (unsigned)crow(i, 0)); } } \
            word <<= 4 * hi; \
            if (word) __hip_atomic_fetch_or(BITS + (kb_) * 32 + r32, word, __ATOMIC_RELAXED, __HIP_MEMORY_SCOPE_WORKGROUP); } while (0)
#ifdef DBG_REP_S2
            for (int rep_ = 0; rep_ < 2; ++rep_)
#endif
            {
#ifdef DBG_REP_S2
                if (rep_) { __syncthreads(); if (tid < 32) M[DM_CNT + tid] = 0u; __syncthreads(); }
#endif
                bf16x8 c0, c1, n0, n1; c0 = c1 = n0 = n1 = qt[0];
                if (w < nblk) DS_LOADK(c0, c1, w);
                if (lev == 0) {
                    const float inv0 = pinv[0], off0 = poff[0];
                    const float T1 = pbin[0] >= DS_NB - 1 ? INFINITY : (float)(pbin[0] + 1), T0 = pbin[0] <= 0 ? -INFINITY : (float)pbin[0];
                    for (int kb = w; kb < nblk; kb += NWAVES) {
                        if (kb + NWAVES < nblk) DS_LOADK(n0, n1, kb + NWAVES);
                        float sc[16]; ds_scores(sc, c0, c1, qt, qi, wh, zz0);
                        unsigned cb = 0u; const unsigned kinv = 0xFFFFu - (unsigned)(kb * 32 + 4 * hi);
#pragma unroll
                        for (int i = 15; i >= 0; --i) { const float t = __builtin_fmaf(sc[i], inv0, off0); const bool sel = t >= T1, eq = (t >= T0) && !sel;
                            cb = cb * 2u + (sel ? 1u : 0u);
                            if (eq) { const unsigned slot = __hip_atomic_fetch_add((LAS unsigned*)(M + DM_CNT + r32), 1u, __ATOMIC_RELAXED, __HIP_MEMORY_SCOPE_WORKGROUP);
                                if (slot < (unsigned)DS_CAP) CAND[r32 * DS_CAP + slot] = ((unsigned long long)f_sortable(sc[i]) << 32) | (unsigned)(kinv - (unsigned)crow(i, 0)); } }
                        unsigned word = (cb & 0xFu) | ((cb & 0xF0u) << 4) | ((cb & 0xF00u) << 8) | ((cb & 0xF000u) << 12);
                        word <<= 4 * hi;
                        if (word) __hip_atomic_fetch_or(BITS + kb * 32 + r32, word, __ATOMIC_RELAXED, __HIP_MEMORY_SCOPE_WORKGROUP);
                        c0 = n0; c1 = n1;
                    }
                } else
                for (int kb = w; kb < nblk; kb += NWAVES) {
                    if (kb + NWAVES < nblk) DS_LOADK(n0, n1, kb + NWAVES);
                    DS_SELBLK(c0, c1, kb);
                    c0 = n0; c1 = n1;
                }
            }
#undef DS_SELBLK
            __syncthreads();
#ifdef DBG_REP_RES
            for (int rep_ = 0; rep_ < 2; ++rep_)
#endif
#pragma unroll 1
            for (int sq = 0; sq < 4; ++sq) {
                int lane = F.lane; asm volatile("" : "+v"(lane));
                const int q = 4 * w + sq; unsigned cnt = M[DM_CNT + q]; cnt = cnt < (unsigned)DS_CAP ? cnt : (unsigned)DS_CAP;
                const unsigned need = DS_TOPK - M[DM_ABOVE + q];
                const unsigned cnt4 = cnt & ~3u;
                for (unsigned i = lane; i < cnt; i += 64) { const unsigned long long ki = CAND[q * DS_CAP + i]; unsigned rank = 0; unsigned j = 0;
                    for (; j < cnt4; j += 4) { const unsigned long long x0 = CAND[q * DS_CAP + j], x1 = CAND[q * DS_CAP + j + 1], x2 = CAND[q * DS_CAP + j + 2], x3 = CAND[q * DS_CAP + j + 3];
                        rank += (x0 > ki ? 1u : 0u) + (x1 > ki ? 1u : 0u) + (x2 > ki ? 1u : 0u) + (x3 > ki ? 1u : 0u); }
                    for (; j < cnt; ++j) rank += (CAND[q * DS_CAP + j] > ki) ? 1u : 0u;
                    if (rank < need) { const unsigned key = 0xFFFFu - (unsigned)(ki & 0xFFFFull); __hip_atomic_fetch_or(BITS + (key >> 5) * 32 + q, 1u << (key & 31), __ATOMIC_RELAXED, __HIP_MEMORY_SCOPE_WORKGROUP); } }
            }
            __syncthreads();
        }
#undef DS_LOADK
    }
    {
        unsigned* BM = (unsigned*)(F.ws + opq(WS_BM)) + (size_t)b * 256 * SEQ + q0;
        for (int i = tid; i < nblk * 32; i += NTHR) __hip_atomic_store(BM + (size_t)(i >> 5) * SEQ + (i & 31), BITS[i], RLX_AGENT);
        asm volatile("s_waitcnt vmcnt(0)" ::: "memory");
        __syncthreads();
        if (tid == 0) __hip_atomic_store(F.ctl + CW_SELF + b * 256 + qt_, (unsigned)(l + 1), RLX_AGENT);
    }
}

DI void dsa_attn_unit(Frame& F, int b, int hd, int qb, int l) {
    const bf16_t* PROJ = (const bf16_t*)(F.ws + opq(WS_PROJ)); const bf16_t* DK = (const bf16_t*)(F.ws + opq(WS_DK)); bf16_t* OUT = (bf16_t*)(F.ws + opq(WS_ODSA));
    const float* C32 = (const float*)(F.ws + opq(WS_ROPE32)); const float* S32 = C32 + (size_t)T * 32;
    const int tid = F.tid, lane = F.lane, r32 = lane & 31, hi = lane >> 5, w = F.wave;
    const int qw = qb * 256 + 32 * w; const size_t row = (size_t)b * SEQ + qw + r32;
    if (w == 0) { unsigned sp = 0;
        for (;;) { const unsigned fv = lane < 8 ? __hip_atomic_load(F.ctl + CW_SELF + b * 256 + 8 * qb + lane, RLX_AGENT) : (unsigned)(l + 1);
            if (__all(fv == (unsigned)(l + 1)) || ++sp > (1u << 22)) break; __builtin_amdgcn_s_sleep(2); }
        __builtin_amdgcn_fence(__ATOMIC_ACQUIRE, "agent"); }
    asm volatile("s_waitcnt vmcnt(0)" ::: "memory");
    __syncthreads();
    constexpr float QS = 0.125f * 1.4426950408889634f;
    bf16x8 qf[4];
    { const bf16_t* qp = PROJ + row * NPROJ + C_DQ + hd * 64 + 8 * hi;
#pragma unroll
      for (int s = 0; s < 4; ++s) qf[s] = *(const bf16x8*)(qp + 16 * s);
      rope8(qf[0], qf[2], C32 + row * 32 + 8 * hi, S32 + row * 32 + 8 * hi, QS); rope8(qf[1], qf[3], C32 + row * 32 + 16 + 8 * hi, S32 + row * 32 + 16 + 8 * hi, QS); }
    const int NT = 4 * (qb + 1), cw = 4 * qb + (w >> 1);
    const int kr = tid >> 3, c8 = tid & 7;
    const bf16_t* gk = DK + ((size_t)b * SEQ + kr) * 256 + hd * 64 + 8 * c8;
    const bf16_t* gv = PROJ + ((size_t)b * SEQ + kr) * NPROJ + C_DV + hd * 64 + 8 * c8;
    const unsigned* bm = (const unsigned*)(F.ws + opq(WS_BM)) + (size_t)b * 256 * SEQ + qw + r32;
    const int lk = kr * 144 + c8 * 16, lv = (c8 >> 2) * 4096 + kr * 64 + (c8 & 3) * 16;
    LAS unsigned char* L = F.lds + RING_OFF;
    constexpr int MK = 4 * AT_KS;
    u32x4 rkA, rvA, rkB, rvB; unsigned nA0, nA1, nB0, nB1;
#define DA_LOAD(t) do { rkA = *(const u32x4*)(gk + (size_t)(t) * 64 * 256); rvA = *(const u32x4*)(gv + (size_t)(t) * 64 * NPROJ); \
        rkB = *(const u32x4*)(gk + (size_t)((t) + 1) * 64 * 256); rvB = *(const u32x4*)(gv + (size_t)((t) + 1) * 64 * NPROJ); \
        nA0 = __hip_atomic_load(bm + (size_t)(2 * (t)) * SEQ, RLX_AGENT); nA1 = __hip_atomic_load(bm + (size_t)(2 * (t) + 1) * SEQ, RLX_AGENT); \
        nB0 = __hip_atomic_load(bm + (size_t)(2 * (t) + 2) * SEQ, RLX_AGENT); nB1 = __hip_atomic_load(bm + (size_t)(2 * (t) + 3) * SEQ, RLX_AGENT); } while (0)
#define DA_WRITE(bf) do { LAS unsigned char* k_ = L + (bf) * 2 * AT_KS; LAS unsigned char* v_ = L + MK + (bf) * 2 * AT_VS; \
        *(LAS u32x4*)(k_ + lk) = rkA; *(LAS u32x4*)(v_ + lv) = rvA; *(LAS u32x4*)(k_ + AT_KS + lk) = rkB; *(LAS u32x4*)(v_ + AT_VS + lv) = rvB; } while (0)
    DA_LOAD(0); DA_WRITE(0);
    unsigned cA0 = nA0, cA1 = nA1, cB0 = nB0, cB1 = nB1;
    __syncthreads();
    float m_ref = 0.f, l_run = 0.f; bool init = false; f32x16 o[2], negm; const float zz0 = zero_op();
#pragma unroll
    for (int i = 0; i < 16; ++i) { o[0][i] = zz0; o[1][i] = zz0; negm[i] = zz0; }
    for (int t = 0; t < NT; t += 2) {
        const int bf = (t >> 1) & 1;
        if (t + 2 < NT) DA_LOAD(t + 2);
#pragma unroll
        for (int u2 = 0; u2 < 2; ++u2) {
        if (t + u2 <= cw) {
            const unsigned wd0 = (u2 ? cB0 : cA0) >> (4 * hi), wd1 = (u2 ? cB1 : cA1) >> (4 * hi);
            f32x16 p0, p1;
            LAS const unsigned char* kb = L + (bf * 2 + u2) * AT_KS + r32 * 144 + hi * 16;
#pragma unroll
            for (int s = 0; s < 4; ++s) { const bf16x8 a0 = *(LAS const bf16x8*)(kb + 32 * s), a1 = *(LAS const bf16x8*)(kb + 32 * 144 + 32 * s); p0 = mfma32(a0, qf[s], s == 0 ? negm : p0); p1 = mfma32(a1, qf[s], s == 0 ? negm : p1); }
            asm volatile("s_nop 15\n\ts_nop 7" : "+v"(p0), "+v"(p1));
            const float mx = rowmax32(p0, p1);
            if (!init || __any(mx > 8.0f)) raise_ref(p0, p1, o, negm, m_ref, l_run, init, mx, lane);
            float ls0 = 0.f, one = 1.0f; asm volatile("" : "+v"(one));
#define DA_E(i) do { p0[i] = mask_bit<((i) & 3) + 8 * ((i) >> 2)>(__builtin_amdgcn_exp2f(p0[i]), wd0); p1[i] = mask_bit<((i) & 3) + 8 * ((i) >> 2)>(__builtin_amdgcn_exp2f(p1[i]), wd1); ls0 = __builtin_fmaf(p0[i], one, ls0); ls0 = __builtin_fmaf(p1[i], one, ls0); } while (0)
            DA_E(0); DA_E(1); DA_E(2); DA_E(3); DA_E(4); DA_E(5); DA_E(6); DA_E(7); DA_E(8); DA_E(9); DA_E(10); DA_E(11); DA_E(12); DA_E(13); DA_E(14); DA_E(15);
#undef DA_E
            l_run += ls0;
            LAS const unsigned char* vs = L + MK + (bf * 2 + u2) * AT_VS;
            pv_block<0>(o, p0, vs, lane); pv_block<1>(o, p1, vs, lane);
        }
        }
        if (t + 2 < NT) { DA_WRITE(bf ^ 1); cA0 = nA0; cA1 = nA1; cB0 = nB0; cB1 = nB1; }
        __syncthreads();
    }
#undef DA_LOAD
#undef DA_WRITE
    const float lt = l_run + shx(l_run, 32, lane);
    store_ot(OUT + row * 256 + hd * 64, o, 1.0f / lt, hi);
}
constexpr int N_SEL = T / 32, N_MLA = BATCH * 6 * 32, N_DSAA = BATCH * 4 * 32, N_SB = BATCH * 6 * 32, N_ATT = N_SEL + N_MLA + N_DSAA + N_SB;
DI void p_attention(Frame& F, ArgsP a, int l, int qslot) {
    for (;;) {
        __syncthreads();
        if (F.tid == 0) F.MISC[12] = __hip_atomic_fetch_add(F.ctl + CW_QATT + 64 * qslot, 1u, RLX_AGENT);
        __syncthreads();
        int u = (int)F.MISC[12];
        if (u >= N_ATT + N_CVT) break;
        { int t_ = threadIdx.x; asm volatile("" : "+v"(t_)); F.tid = t_; F.lane = t_ & 63; }
        if (u < 3 * N_CVT) { const int q3 = u / 3; if (u - 3 * q3 == 2) { cvt_unit(F, a, l, q3); continue; } u -= q3; } else u -= N_CVT;
        if (u < N_SEL) { const int qt = 255 - u / 2, b = u & 1; dsa_select_unit(F, b, qt, l); }
        else if (u < N_SEL + N_MLA + N_DSAA) {
            const int v = u - N_SEL, qb = 31 - v / 20, r = v % 20;
            if (r < 8) dsa_attn_unit(F, r / 4, r % 4, qb, l); else mla_unit(F, (r - 8) / 6, (r - 8) % 6, qb);
        }
        else { const int v = u - N_SEL - N_MLA - N_DSAA; const int qb = 31 - v / 12, bh = v % 12; sb_unit(F, bh / 6, bh % 6, qb); }
    }
}

constexpr int PH_PER_LAYER = 10, N_PHASES = 2 + DEPTH * PH_PER_LAYER;
__global__ void __launch_bounds__(NTHR, 2) mk_fwd(Args a_unused) {
    ArgsP a = (ArgsP)__builtin_amdgcn_kernarg_segment_ptr();
    extern __shared__ __attribute__((aligned(16))) unsigned char lds_raw[];
    Frame F;
    F.lds = (LAS unsigned char*)lds_raw; F.MISC = (volatile LAS unsigned*)(F.lds + MISC_OFF);
    F.tid = threadIdx.x; F.lane = F.tid & 63; F.wave = __builtin_amdgcn_readfirstlane(F.tid >> 6);
    F.G = gridDim.x; F.bx = blockIdx.x; F.gw = blockIdx.x * NWAVES + F.wave; F.NGW = F.G * NWAVES; F.ws = (unsigned char*)a->ws; F.ctl = (gu32*)((unsigned char*)a->ws + WS_CTL);
    for (int u = F.tid; u < 256; u += NTHR) F.MISC[u] = 0u;
    __syncthreads();
    const int lo = a->ph_lo, hi = a->ph_hi;
    const bool one = (hi - lo) > 1;
    XcdBarrier bar; bar.bar = (unsigned*)(F.ctl + CW_BAR); bar.x = 0; bar.st = nullptr;
    if (one) bar = xcd_barrier_post((unsigned*)(F.ctl + CW_BAR), F.MISC + 8);
#define IN(k) (lo <= (k) && (k) < hi)
#define XN ((bf16_t*)(F.ws + opq(WS_XN)))
#define PROJ ((bf16_t*)(F.ws + opq(WS_PROJ)))
#define REFRESH() do { int t_ = threadIdx.x; asm volatile("" : "+v"(t_)); F.tid = t_; F.lane = t_ & 63; size_t z_ = 0; asm volatile("" : "+s"(z_)); a = (ArgsP)__builtin_amdgcn_kernarg_segment_ptr(); asm volatile("" : "+s"(a)); F.ws = (unsigned char*)a->ws + z_; F.ctl = (gu32*)(F.ws + opq(WS_CTL)); { LAS unsigned char* l_ = (LAS unsigned char*)lds_raw; asm volatile("" : "+s"(l_)); F.lds = l_; F.MISC = (volatile LAS unsigned*)(l_ + MISC_OFF); } \
    int b_ = blockIdx.x; asm volatile("" : "+s"(b_)); F.bx = b_; F.gw = b_ * NWAVES + F.wave; } while (0)
#ifdef DBG_DOUBLE_BAR
#define SEAM(k) do { if (IN(k) && IN((k) + 1)) { XcdBarrier b2_ = bar; size_t z_ = 0; asm volatile("" : "+s"(z_)); b2_.bar = (unsigned*)((unsigned char*)a->ws + z_ + WS_CTL) + CW_BAR; xcd_barrier(b2_); xcd_barrier(b2_); } } while (0)
#else
#define SEAM(k) do { if (IN(k) && IN((k) + 1)) { XcdBarrier b2_ = bar; size_t z_ = 0; asm volatile("" : "+s"(z_)); b2_.bar = (unsigned*)((unsigned char*)a->ws + z_ + WS_CTL) + CW_BAR; xcd_barrier(b2_); } } while (0)
#endif

    if (IN(0)) { REFRESH(); p0_mod(F, a); p0_rope(F, a); p0_convert(F, a); p0_convert_up(F, a);
#ifdef DBG_DOUBLE_P0
        p0_convert(F, a);
#endif
    } SEAM(0);
    if (IN(1)) { REFRESH(); p_norm_first(F, a); } SEAM(1);

    for (int l = 0; l < DEPTH; ++l) {
        const int pb = 2 + l * PH_PER_LAYER;
#ifndef DBG_SKIP_MIXER
        if (IN(pb + 0)) { REFRESH();
#ifdef DBG_REP_GIN
            for (int rep_ = 0; rep_ < 2; ++rep_) {
#else
            {
#endif

            pg8::DenseSched S; S.init(XN, (const bf16_t*)(F.ws + opq(WS_WIN)) + (size_t)l * NPROJ * DM, T, NPROJ, DM, F.G, F.bx);
            pg8::EpiStore E{PROJ, NPROJ};
            pg8::gemm_phase<pg8::EpiStore, pg8::DenseSched, true>(F.lds + RING_OFF, S, E);
                    }
        } SEAM(pb + 0);
        if (IN(pb + 2)) { REFRESH();
            p_post1(F, a, l);
            LAS float* tabq = (LAS float*)(F.lds + MISC_OFF + 1024); LAS float* tabkv = tabq + 256;
            { pg8::DenseSched S; S.init(PROJ + C_CQ, (const bf16_t*)(F.ws + opq(WS_WUQ)) + (size_t)l * 768 * 256, T, 768, 256, F.G, F.bx, NPROJ);
              pg8::Unit u0; if (S.next(0, u0)) rs_table<256>(F, PROJ + (size_t)u0.pm * 256 * NPROJ + C_CQ, tabq);
              __syncthreads();
              pg8::EpiStoreRS E{(bf16_t*)(F.ws + opq(WS_QM)), 768, tabq}; pg8::gemm_phase<pg8::EpiStoreRS, pg8::DenseSched, false>(F.lds + RING_OFF, S, E); }
            REFRESH();
            { pg8::DenseSched S; S.init(PROJ + C_CKV, (const bf16_t*)(F.ws + opq(WS_WUKV)) + (size_t)l * 768 * 128, T, 768, 128, F.G, (F.bx + 128) % F.G, NPROJ);
              pg8::Unit u0; if (S.next(0, u0)) rs_table<128>(F, PROJ + (size_t)u0.pm * 256 * NPROJ + C_CKV, tabkv);
              __syncthreads();
              pg8::EpiStoreRS E{(bf16_t*)(F.ws + opq(WS_KVM)), 768, tabkv}; pg8::gemm_phase<pg8::EpiStoreRS, pg8::DenseSched, false>(F.lds + RING_OFF, S, E); }
        } SEAM(pb + 2);
        if (IN(pb + 3)) { REFRESH(); p_attention(F, a, l, l);
#ifdef DBG_DOUBLE_ATT
            p_attention(F, a, l, l + 4);
#endif
        } SEAM(pb + 3);
        if (IN(pb + 4)) { REFRESH();
#ifdef DBG_REP_SMALL
            for (int rep_ = 0; rep_ < 2; ++rep_) {
#else
            {
#endif

            for (int s = 0; s < 3; ++s) {
                const bf16_t* A = (const bf16_t*)(F.ws + (s == 0 ? WS_OSB : s == 1 ? WS_OMLA : WS_ODSA));
                const bf16_t* B = (const bf16_t*)(F.ws + (s == 0 ? WS_WSB : s == 1 ? WS_WMLA : WS_WDSA)) + (size_t)l * DM * (s == 2 ? 256 : 384);
                pg8::DenseSched S; S.init(A, B, T, DM, s == 2 ? 256 : 384, F.G, F.bx);
                pg8::EpiBranch E{(bf16_t*)(F.ws + opq(WS_MRG)), PROJ, C_GATE + s * DM, s == 0};
                pg8::gemm_phase<pg8::EpiBranch, pg8::DenseSched, false>(F.lds + RING_OFF, S, E);
            }
                    }
        } SEAM(pb + 4);
        if (IN(pb + 5)) { REFRESH();
            pg8::DenseSched S; S.init((const bf16_t*)(F.ws + opq(WS_MRG)), (const bf16_t*)(F.ws + opq(WS_WOUT)) + (size_t)l * DM * DM, T, DM, DM, F.G, F.bx);
            pg8::EpiResid E{(float*)(F.ws + opq(WS_X)), (const float*)(F.ws + opq(WS_MOD)) + (size_t)l * 2 * 6 * DM + 2 * DM, 0};
            pg8::gemm_phase<pg8::EpiResid, pg8::DenseSched, false>(F.lds + RING_OFF, S, E);
#ifdef DBG_REP_OUT
            { pg8::EpiResid E2 = E; E2.dofs = (size_t)1600 * MiB; pg8::gemm_phase<pg8::EpiResid, pg8::DenseSched, false>(F.lds + RING_OFF, S, E2); }
#endif
        } SEAM(pb + 5);
#endif
        if (IN(pb + 6)) { REFRESH(); p_norm2_router(F, a, l);
#ifdef DBG_REP_ROUTER
            p_norm2_router(F, a, l, (size_t)1600 * MiB, 64 + l);
#endif
        } SEAM(pb + 6);
#ifndef DBG_SKIP_MOE
        if (IN(pb + 7)) { REFRESH();
#ifdef DBG_REP_MOE
            for (int rep_ = 0; rep_ < 2; ++rep_) {
#else
            {
#endif

            const pg8::MoeTab tb = moe_tables(F, l);
            pg8::MoeSched<true, 8> S{XN, (const bf16_t*)(F.ws + opq(WS_WGU)) + (size_t)l * NEXP * 2048 * DM, (const int*)(F.ws + opq(WS_LIST)), tb, DM, F.G, F.bx, (LAS unsigned*)(F.lds + MISC_OFF + 1024)};
            pg8::EpiSwiglu E{(bf16_t*)(F.ws + opq(WS_ACT)), ((const float*)a->b_gu) + (size_t)l * NEXP * 2048, (LAS float*)(F.lds + MISC_OFF + 3072)};
            pg8::gemm_phase<pg8::EpiSwiglu, pg8::MoeSched<true, 8>, true>(F.lds + RING_OFF, S, E);
                    }
        } SEAM(pb + 7);
        if (IN(pb + 8)) { REFRESH();
#ifdef DBG_REP_MOE
            for (int rep_ = 0; rep_ < 2; ++rep_) {
#else
            {
#endif

            const pg8::MoeTab tb = moe_tables_again(F);
            pg8::MoeSched<false, 4> S{(const bf16_t*)(F.ws + opq(WS_ACT)), (const bf16_t*)(F.ws + opq(WS_WDN)) + (size_t)l * NEXP * DM * DM, nullptr, tb, DM, F.G, F.bx, (LAS unsigned*)(F.lds + MISC_OFF + 1024)};
            pg8::EpiDown E{(bf16_t*)(F.ws + opq(WS_EOUT)), ((const float*)a->b_dn) + (size_t)l * NEXP * DM, (const float*)(F.ws + opq(WS_LISTW)), (LAS float*)(F.lds + MISC_OFF + 3072)};
            pg8::gemm_phase<pg8::EpiDown, pg8::MoeSched<false, 4>, true>(F.lds + RING_OFF, S, E);
                    }
        } SEAM(pb + 8);
#endif
        if (IN(pb + 9)) { REFRESH(); const pg8::MoeTab tb = moe_tables_again(F);
#ifdef DBG_REP_COMBINE
            p_combine(F, a, l, tb, (size_t)1600 * MiB);
#endif
            p_combine(F, a, l, tb); } SEAM(pb + 9);
    }
#undef IN
#undef SEAM
#undef XN
#undef PROJ
}

#ifndef MK_MULTI
#define MK_MULTI 0
#endif
extern "C" void kernel_launch(void* const* d_in, const int* in_sizes, int n_in, void* d_out, int out_size, void* d_ws, size_t ws_size, hipStream_t stream) {
    static int grid = 0;
    if (grid == 0) {
        if (n_in != 23 || in_sizes[0] != T * DM || out_size != T * DM || ws_size < WS_END) { fprintf(stderr, "kernel_launch: unexpected shapes (n_in %d, ws %zu); nothing launched\n", n_in, ws_size); grid = -1; return; }
        int dev = 0, cus = 0, per_cu = 0;
        if (hipGetDevice(&dev) != hipSuccess || hipDeviceGetAttribute(&cus, hipDeviceAttributeMultiprocessorCount, dev) != hipSuccess) { grid = -1; return; }
        if (hipFuncSetAttribute((const void*)mk_fwd, hipFuncAttributeMaxDynamicSharedMemorySize, LDS_BYTES) != hipSuccess) { fprintf(stderr, "kernel_launch: hipFuncSetAttribute failed\n"); grid = -1; return; }
        if (hipOccupancyMaxActiveBlocksPerMultiprocessor(&per_cu, (const void*)mk_fwd, NTHR, LDS_BYTES) != hipSuccess || per_cu < 1) { fprintf(stderr, "kernel_launch: note: occupancy query says %d\n", per_cu); (void)hipGetLastError(); }
        grid = cus;
    }
    if (grid < 0) return;
    if (hipMemsetAsync((char*)d_ws + WS_CTL, 0, CTL_ZERO_BYTES, stream) != hipSuccess) return;
    Args a{};
    a.x = (gcf)d_in[0]; a.c = (gcf)d_in[1]; a.pos = (gci)d_in[2];
    a.ada_w = (gcf)d_in[3]; a.ada_b = (gcf)d_in[4]; a.norm_mix_g = (gcf)d_in[5]; a.w_in = (gcf)d_in[6];
    a.q_norm_g = (gcf)d_in[7]; a.kv_norm_g = (gcf)d_in[8]; a.w_uq = (gcf)d_in[9]; a.w_ukv = (gcf)d_in[10];
    a.w_sb_out = (gcf)d_in[11]; a.w_mla_out = (gcf)d_in[12]; a.w_dsa_out = (gcf)d_in[13]; a.w_out = (gcf)d_in[14];
    a.norm_ffn_g = (gcf)d_in[15]; a.router_w = (gcf)d_in[16]; a.router_b = (gcf)d_in[17];
    a.w_gu = (gcf)d_in[18]; a.b_gu = (gcf)d_in[19]; a.w_dn = (gcf)d_in[20]; a.b_dn = (gcf)d_in[21]; a.final_g = (gcf)d_in[22];
    a.out = (GAS float*)d_out; a.ws = (GAS unsigned char*)d_ws;
#if MK_MULTI
    for (int p = 0; p < N_PHASES; ++p) { a.ph_lo = p; a.ph_hi = p + 1; hipLaunchKernelGGL(mk_fwd, dim3(grid), dim3(NTHR), LDS_BYTES, stream, a); }
#else
    a.ph_lo = 0; a.ph_hi = N_PHASES; hipLaunchKernelGGL(mk_fwd, dim3(grid), dim3(NTHR), LDS_BYTES, stream, a);
#endif
}
```

```cpp
#include <hip/hip_runtime.h>
#include <cstdio>
#include <cstdint>

#define LAS __attribute__((address_space(3)))
#define GAS __attribute__((address_space(1)))
typedef unsigned short bf16_t;
typedef short bf16x8 __attribute__((ext_vector_type(8)));
typedef short s16x4 __attribute__((ext_vector_type(4)));
typedef float f32x2 __attribute__((ext_vector_type(2)));
typedef float f32x4 __attribute__((ext_vector_type(4)));
typedef float f32x16 __attribute__((ext_vector_type(16)));
typedef unsigned u32x2 __attribute__((ext_vector_type(2)));
typedef unsigned u32x4 __attribute__((ext_vector_type(4)));
typedef GAS unsigned gu32;
#define RLX_AGENT __ATOMIC_RELAXED, __HIP_MEMORY_SCOPE_AGENT
#define DI __device__ __forceinline__

constexpr int BATCH = 2, SEQ = 8192, DM = 1024, DEPTH = 4, T = BATCH * SEQ;
constexpr int D_IN = 5704, NPROJ = 5888;
constexpr int C_SBQ = 0, C_SBK = 384, C_SBV = 768, C_CQ = 1152, C_CKV = 1408, C_KR = 1536, C_DQ = 1568, C_DK = 1824, C_DV = 2080,
              C_IQ = 2336, C_IK = 2592, C_IW = 2624, C_GATE = 2632;
constexpr int NEXP = 32, ECAP = T;
constexpr float NORM_EPS = 1e-6f;
constexpr int NWAVES = 8, NTHR = 512;

DI unsigned f2bf(float f) { unsigned u = __builtin_bit_cast(unsigned, f); return (u + 0x7fffu + ((u >> 16) & 1u)) >> 16; }
DI unsigned pk2(float lo, float hi) { return f2bf(lo) | (f2bf(hi) << 16); }
DI float bf2f(unsigned short h) { return __builtin_bit_cast(float, (unsigned)h << 16); }
DI float bflo(unsigned w) { return __builtin_bit_cast(float, w << 16); }
DI float bfhi(unsigned w) { return __builtin_bit_cast(float, w & 0xffff0000u); }
DI unsigned cvt_pk_bf16(float lo, float hi) { unsigned r; asm volatile("v_cvt_pk_bf16_f32 %0, %1, %2" : "=v"(r) : "v"(lo), "v"(hi)); return r; }
DI float shx(float v, int o, int lane) { return __builtin_bit_cast(float, __builtin_amdgcn_ds_bpermute((lane ^ o) << 2, __builtin_bit_cast(int, v))); }
DI float shl(float v, int src) { return __builtin_bit_cast(float, __builtin_amdgcn_ds_bpermute(src << 2, __builtin_bit_cast(int, v))); }
DI unsigned long long shx64(unsigned long long v, int o, int lane) {
    const unsigned lo = (unsigned)__builtin_amdgcn_ds_bpermute((lane ^ o) << 2, (int)(unsigned)v), hi = (unsigned)__builtin_amdgcn_ds_bpermute((lane ^ o) << 2, (int)(unsigned)(v >> 32));
    return ((unsigned long long)hi << 32) | lo; }
DI float wave_sum(float v, int lane) {
#pragma unroll
    for (int o = 1; o < 64; o <<= 1) v += shx(v, o, lane);
    return v;
}
DI float zero_op() { float z = 0.f; asm volatile("" : "+v"(z)); return z; }
DI size_t opq(size_t v) { asm volatile("" : "+s"(v)); return v; }
DI float fast_sigmoid(float x) { return __builtin_amdgcn_rcpf(1.0f + __builtin_amdgcn_exp2f(-1.4426950408889634f * x)); }

namespace pg8 {
constexpr int BM = 256, BK = 64, HALF = 128, HTB = HALF * BK * 2, STAGE_BYTES = 8 * HTB, NXCD = 8, WGM = 8;
__host__ __device__ __forceinline__ int lds_byte(int r, int c) { const int st = (r >> 4) * 2 + (c >> 5), rr = r & 15, cc = c & 31, ob = rr * 64 + cc * 2; return st * 1024 + (ob ^ (((ob >> 9) & 1) << 5)); }
__host__ __device__ __forceinline__ void stage_rc(int b, int& R, int& C) { const int st = b / 1024, sb = b % 1024, swz = sb ^ (((sb >> 9) & 1) << 5); R = (st >> 1) * 16 + swz / 64; C = (st & 1) * 32 + (swz % 64) / 2; }
__host__ __device__ __forceinline__ int perm32(int rho) { const int n = rho >> 4, i = rho & 15; return 8 * (i >> 2) + 4 * n + (i & 3); }

struct Unit { int pm, pn, e, row0, nrows, par; };

struct DenseSched {
    const bf16_t* A; const bf16_t* Bt; int K; int nM, nN, nwg, G, c, lda;
    DI void init(const bf16_t* A_, const bf16_t* Bt_, int M, int N, int K_, int G_, int c_, int lda_ = 0) { A = A_; Bt = Bt_; K = K_; nM = M / BM; nN = N / BM; nwg = nM * nN; G = G_; c = c_; lda = lda_ ? lda_ : K_; }
    DI bool next(int i, Unit& u) const {
        const long L = (long)i * G + c; if (L >= nwg) return false;
        int wgid = (int)L; { const int q = nwg / NXCD, r = nwg % NXCD, xcd = wgid % NXCD, off = wgid / NXCD; wgid = (xcd < r ? xcd * (q + 1) : r * (q + 1) + (xcd - r) * q) + off; }
        const int nig = WGM * nN, gid = wgid / nig, fm = gid * WGM, gsz = (nM - fm) < WGM ? (nM - fm) : WGM;
        u.pm = fm + ((wgid % nig) % gsz); u.pn = (wgid % nig) / gsz; u.e = 0; u.row0 = u.pm * BM; u.nrows = BM; return true;
    }
    DI const char* abase(const Unit& u) const { return (const char*)A + (size_t)u.pm * BM * lda * 2; }
    DI const char* bbase(const Unit& u) const { return (const char*)Bt + (size_t)u.pn * BM * K * 2; }
    DI void aoffs(const Unit&, int R, int C, unsigned (&v)[4]) const {
#pragma unroll
        for (int m = 0; m < 4; ++m) v[m] = (unsigned)((R + 64 * m) * lda + C) * 2u;
    }
    DI void prefetch(const Unit&, int, int) const {}
    DI void aoffs_next(const Unit& u, int R, int C, unsigned (&v)[4], int) const { aoffs(u, R, C, v); }
};

template <class Epi, class Sched, bool ALIGN_EPI>
DI void gemm_phase(LAS unsigned char* lds, const Sched& S, const Epi& E) {
    int tid = threadIdx.x; asm volatile("" : "+v"(tid));
    const int wid = __builtin_amdgcn_readfirstlane(tid >> 6), lane = tid & 63, wr = wid >> 2, wc = wid & 3, fr = lane & 15, fq = lane >> 4;
    const int K = S.K, nt = K / BK;
    int sR, sC; stage_rc(tid * 16, sR, sC);
    unsigned voffB[2];
#pragma unroll
    for (int i = 0; i < 2; ++i) { const int R = sR + 64 * i; const int Rb = Epi::PERM ? ((R & ~31) + perm32(R & 31)) : R; voffB[i] = (unsigned)(Rb * K + sC) * 2u; }
    const size_t kstep = (size_t)(BK * 2);
    const size_t hstep = (size_t)HALF * K * 2;
    const unsigned ldsw = (unsigned)wid * 1024u;
    const int aoff = lds_byte(wr * 64 + fr, fq * 8), boff = lds_byte(wc * 32 + fr, fq * 8);
#define PG8_SA(b, h) (((b) * 2 + (h)) * HTB)
#define PG8_SB(b, h) ((4 + (b) * 2 + (h)) * HTB)
#define PG8_STAGEB(bufoff, gbase) do { _Pragma("unroll") for (int _i = 0; _i < 2; ++_i) \
        __builtin_amdgcn_global_load_lds((const unsigned*)((const char*)(gbase) + voffB[_i]), (LAS unsigned*)(lds + (bufoff) + ldsw + _i * 8192), 16, 0, 0); } while (0)
#define PG8_STAGEA(bufoff, gbase, v0, v1) do { \
        __builtin_amdgcn_global_load_lds((const unsigned*)((const char*)(gbase) + (v0)), (LAS unsigned*)(lds + (bufoff) + ldsw), 16, 0, 0); \
        __builtin_amdgcn_global_load_lds((const unsigned*)((const char*)(gbase) + (v1)), (LAS unsigned*)(lds + (bufoff) + ldsw + 8192), 16, 0, 0); } while (0)
#define PG8_LDA(dst, b, h) do { _Pragma("unroll") for (int m = 0; m < 4; ++m) _Pragma("unroll") for (int k = 0; k < 2; ++k) dst[m][k] = *(const LAS bf16x8*)(lds + PG8_SA(b, h) + aoff + m * 2048 + k * 1024); } while (0)
#define PG8_LDB(dst, b, h) do { _Pragma("unroll") for (int n = 0; n < 2; ++n) _Pragma("unroll") for (int k = 0; k < 2; ++k) dst[n][k] = *(const LAS bf16x8*)(lds + PG8_SB(b, h) + boff + n * 2048 + k * 1024); } while (0)
#define PG8_MMA(ai, bj, At, Bt) do { __builtin_amdgcn_s_setprio(1); _Pragma("unroll") for (int m = 0; m < 4; ++m) _Pragma("unroll") for (int n = 0; n < 2; ++n) _Pragma("unroll") for (int k = 0; k < 2; ++k) \
        acc[ai][bj][m][n] = __builtin_amdgcn_mfma_f32_16x16x32_bf16(Bt[n][k], At[m][k], acc[ai][bj][m][n], 0, 0, 0); __builtin_amdgcn_s_setprio(0); } while (0)
#define PG8_WAIT_V(n) asm volatile("s_waitcnt vmcnt(" #n ")" ::: "memory")
#define PG8_WAIT_L(n) asm volatile("s_waitcnt lgkmcnt(" #n ")" ::: "memory")
#define PG8_BAR __builtin_amdgcn_s_barrier()
#define PG8_SCHED __builtin_amdgcn_sched_barrier(0)
    Unit cur, nxt; int ui = 0;
    if (!S.next(0, cur)) return;
    f32x4 acc[2][2][4][2];
    float zz = 0.f; asm volatile("" : "+v"(zz));
#pragma unroll
    for (int a = 0; a < 2; ++a)
#pragma unroll
        for (int b = 0; b < 2; ++b)
#pragma unroll
            for (int m = 0; m < 4; ++m)
#pragma unroll
                for (int n = 0; n < 2; ++n) acc[a][b][m][n] = (f32x4){zz, zz, zz, zz};
    bf16x8 At[4][2], B0[2][2], B1[2][2];
    const char* cA = S.abase(cur); const char* cB = S.bbase(cur);
    unsigned cv[4];
    S.aoffs(cur, sR, sC, cv);
    PG8_STAGEB(PG8_SB(0, 0), cB); PG8_STAGEB(PG8_SB(0, 1), cB + hstep); PG8_STAGEA(PG8_SA(0, 0), cA, cv[0], cv[1]); PG8_STAGEA(PG8_SA(0, 1), cA, cv[2], cv[3]);
    if (wr == 1) PG8_BAR;
    PG8_WAIT_V(2); PG8_BAR;
    PG8_STAGEB(PG8_SB(1, 0), cB + kstep); PG8_STAGEA(PG8_SA(1, 0), cA + kstep, cv[0], cv[1]); PG8_STAGEB(PG8_SB(1, 1), cB + hstep + kstep);
    PG8_WAIT_V(6); PG8_BAR;
    for (;;) {
        const bool has_next = S.next(ui + 1, nxt);
        cur.par = ui & 1;
        { int t2 = threadIdx.x; asm volatile("" : "+v"(t2)); E.prefetch(cur, t2); }
        const char* nA = cA; const char* nB = cB;
        if (has_next) { nA = S.abase(nxt); nB = S.bbase(nxt); int t2 = threadIdx.x; asm volatile("" : "+v"(t2)); S.prefetch(nxt, t2, (ui + 1) & 1); }
        for (int t = 0; t < nt; t += 2) {
            const bool last = (t == nt - 2);
            const char* a1 = cA + (size_t)(t + 1) * kstep;
            const char* a2 = last ? nA : cA + (size_t)(t + 2) * kstep; const char* b2 = last ? nB : cB + (size_t)(t + 2) * kstep;
            const char* a3 = a2 + kstep; const char* b3 = b2 + kstep;
            unsigned wv[4];
#pragma unroll
            for (int m = 0; m < 4; ++m) wv[m] = cv[m];
            if (last && has_next) { int t2 = threadIdx.x; asm volatile("" : "+v"(t2)); int R2, C2; stage_rc(t2 * 16, R2, C2); S.aoffs_next(nxt, R2, C2, wv, (ui + 1) & 1); }
            const unsigned w0 = wv[0], w1 = wv[1], w2 = wv[2], w3 = wv[3];
            PG8_LDB(B0, 0, 0); PG8_LDB(B1, 0, 1); PG8_SCHED; PG8_LDA(At, 0, 0); PG8_STAGEA(PG8_SA(1, 1), a1, cv[2], cv[3]);
            PG8_WAIT_V(8); PG8_WAIT_L(0); PG8_BAR; PG8_MMA(0, 0, At, B0); PG8_MMA(0, 1, At, B1); PG8_BAR; PG8_SCHED;
            PG8_LDA(At, 0, 1); PG8_STAGEB(PG8_SB(0, 0), b2); PG8_STAGEB(PG8_SB(0, 1), b2 + hstep); PG8_STAGEA(PG8_SA(0, 0), a2, w0, w1);
            PG8_WAIT_V(8); PG8_WAIT_L(0); PG8_BAR; PG8_MMA(1, 0, At, B0); PG8_MMA(1, 1, At, B1); PG8_BAR; PG8_SCHED;
            PG8_LDB(B0, 1, 0); PG8_LDB(B1, 1, 1); PG8_SCHED; PG8_LDA(At, 1, 0); PG8_STAGEA(PG8_SA(0, 1), a2, w2, w3);
            PG8_WAIT_V(8); PG8_WAIT_L(0); PG8_BAR; PG8_MMA(0, 0, At, B0); PG8_MMA(0, 1, At, B1); PG8_BAR; PG8_SCHED;
            PG8_LDA(At, 1, 1); PG8_STAGEB(PG8_SB(1, 0), b3); PG8_STAGEB(PG8_SB(1, 1), b3 + hstep); PG8_STAGEA(PG8_SA(1, 0), a3, w0, w1);
            PG8_WAIT_V(8); PG8_WAIT_L(0); PG8_BAR; PG8_MMA(1, 0, At, B0); PG8_MMA(1, 1, At, B1); PG8_BAR; PG8_SCHED;
        }
        if constexpr (ALIGN_EPI) { if (wr == 0) PG8_BAR; }
        { int t2 = threadIdx.x; asm volatile("" : "+v"(t2)); const int l2 = t2 & 63; E(acc, cur, wr, wc, l2 & 15, l2 >> 4); }
        if (!has_next) break;
#pragma unroll
        for (int a = 0; a < 2; ++a)
#pragma unroll
            for (int b = 0; b < 2; ++b)
#pragma unroll
                for (int m = 0; m < 4; ++m)
#pragma unroll
                    for (int n = 0; n < 2; ++n) acc[a][b][m][n] = (f32x4){zz, zz, zz, zz};
        cur = nxt; cA = nA; cB = nB; ++ui;
        { int t2 = threadIdx.x; asm volatile("" : "+v"(t2)); int R2, C2; stage_rc(t2 * 16, R2, C2); S.aoffs_next(cur, R2, C2, cv, ui & 1); }
        if constexpr (ALIGN_EPI) { if (wr == 1) PG8_BAR; }
    }
    PG8_WAIT_V(0);
    if constexpr (!ALIGN_EPI) { if (wr == 0) PG8_BAR; }
    PG8_BAR;
#undef PG8_SA
#undef PG8_SB
#undef PG8_STAGEA
#undef PG8_STAGEB
#undef PG8_LDA
#undef PG8_LDB
#undef PG8_MMA
#undef PG8_WAIT_V
#undef PG8_WAIT_L
#undef PG8_BAR
#undef PG8_SCHED
}
}
constexpr size_t MiB = 1u << 20;
constexpr size_t WS_CTL = 0, CTL_ZERO_BYTES = 1 * MiB;
constexpr size_t WS_MOD   = 1 * MiB;
constexpr size_t WS_ROPE32 = 2 * MiB;
constexpr size_t WS_ROPE16 = 6 * MiB;
constexpr size_t WS_WIN   = 8 * MiB;
constexpr size_t WS_WUQ   = 56 * MiB;
constexpr size_t WS_WUKV  = 58 * MiB;
constexpr size_t WS_WSB   = 60 * MiB;
constexpr size_t WS_WMLA  = 64 * MiB;
constexpr size_t WS_WDSA  = 68 * MiB;
constexpr size_t WS_WOUT  = 72 * MiB;
constexpr size_t WS_WGU   = 80 * MiB;
constexpr size_t WS_WDN   = 592 * MiB;
constexpr size_t WS_X     = 848 * MiB;
constexpr size_t WS_XN    = 912 * MiB;
constexpr size_t WS_PROJ  = 944 * MiB;
constexpr size_t WS_CQN   = 1128 * MiB;
constexpr size_t WS_CKVN  = 1136 * MiB;
constexpr size_t WS_KR    = 1140 * MiB;
constexpr size_t WS_DK    = 1141 * MiB;
constexpr size_t WS_IK    = 1149 * MiB;
constexpr size_t WS_IW    = 1150 * MiB;
constexpr size_t WS_QM    = 1152 * MiB;
constexpr size_t WS_KVM   = 1176 * MiB;
constexpr size_t WS_OSB   = 1200 * MiB;
constexpr size_t WS_OMLA  = 1212 * MiB;
constexpr size_t WS_ODSA  = 1224 * MiB;
constexpr size_t WS_MRG   = 1232 * MiB;
constexpr size_t WS_LIST  = 1264 * MiB;
constexpr size_t WS_LISTW = 1266 * MiB;
constexpr size_t WS_TOKE  = 1268 * MiB;
constexpr size_t WS_ACT   = 1272 * MiB;
constexpr size_t WS_EOUT  = 1402 * MiB;
constexpr size_t WS_BM    = 1532 * MiB;
constexpr size_t WS_END   = 1548 * MiB;
constexpr int CW_BAR = 4096;
constexpr int CW_CNT = 8192;
constexpr int CW_QATT = 8192 + 256;
constexpr int CW_SELF = 16384;
constexpr int CW_KMAX = 8192 + 1024;

constexpr int RING_OFF = 0, RING_BYTES = 131072;
constexpr int MISC_OFF = RING_BYTES;
constexpr int LDS_BYTES = 147456;

#define XB_TMO      128
#define XB_XCNT(j)  (256  + 64 * (j))
#define XB_XSUB(j)  (1280 + 64 * (j))
#define XB_XGEN(j)  (2304 + 64 * (j))
#define XB_TOP      3328
#define XB_TOPGEN   3392
#define XCD_BAR_WORDS 3456
#define XB_SPIN_CAP (1u << 18)

__device__ __forceinline__ unsigned xb_ld(unsigned* p)              { return __hip_atomic_load(p, __ATOMIC_RELAXED, __HIP_MEMORY_SCOPE_AGENT); }
__device__ __forceinline__ unsigned xb_add(unsigned* p, unsigned v) { return __hip_atomic_fetch_add(p, v, __ATOMIC_RELAXED, __HIP_MEMORY_SCOPE_AGENT); }
__device__ __forceinline__ unsigned xb_xcc_id() { return (unsigned)__builtin_amdgcn_s_getreg((3 << 11) | 20) & 0xFu; }
#define XB_SPIN(cond, bar) do { unsigned _sp = 0; while (cond) { __builtin_amdgcn_s_sleep(1); \
    if ((++_sp & 255u) == 0u) { if (xb_ld(&(bar)[XB_TMO])) break; if (_sp > XB_SPIN_CAP) { atomicAdd(&(bar)[XB_TMO], 1u); break; } } } } while (0)

struct XcdBarrier { unsigned* bar; unsigned x; volatile LAS unsigned* st; };

__device__ __forceinline__ XcdBarrier xcd_barrier_post(unsigned* bar, volatile LAS unsigned* st) {
    XcdBarrier b; b.bar = bar; b.x = xb_xcc_id(); b.st = st;
    if (threadIdx.x == 0) (void)xb_add(&bar[XB_XCNT(b.x)], 1u);
    return b;
}
__device__ __forceinline__ void xcd_barrier_complete(unsigned* bar, unsigned x, unsigned& nloc, unsigned& nx) {
    const unsigned G = gridDim.x * gridDim.y * gridDim.z;
    unsigned sum, cnt, mine, sp = 0u;
    for (;;) {
        sum = 0u; cnt = 0u; mine = 0u;
#pragma unroll
        for (unsigned j = 0; j < 16; ++j) { const unsigned c = xb_ld(&bar[XB_XCNT(j)]); sum += c; cnt += (c > 0u) ? 1u : 0u; mine = (j == x) ? c : mine; }
        if (sum == G) break;
        __builtin_amdgcn_s_sleep(1);
        if ((++sp & 255u) == 0u) { if (xb_ld(&bar[XB_TMO])) break; if (sp > XB_SPIN_CAP) { atomicAdd(&bar[XB_TMO], 1u); break; } }
    }
    nloc = mine > 0u ? mine : 1u; nx = cnt > 0u ? cnt : 1u;
}
__device__ __forceinline__ void xcd_barrier(const XcdBarrier& b) {
    asm volatile("s_waitcnt vmcnt(0)" ::: "memory");
    __syncthreads();
    if (threadIdx.x == 0) {
        unsigned* bar = b.bar;
        __builtin_amdgcn_s_waitcnt(0);
        unsigned nloc = b.st[0], nx = b.st[1];
        if (nloc == 0u) { xcd_barrier_complete(bar, b.x, nloc, nx); b.st[0] = nloc; b.st[1] = nx; }
        const unsigned old = xb_add(&bar[XB_XSUB(b.x)], 1u);
        const unsigned gen = old / nloc;
        if (old + 1u == (gen + 1u) * nloc) {
            __builtin_amdgcn_fence(__ATOMIC_RELEASE, "agent");
            asm volatile("s_waitcnt vmcnt(0)" ::: "memory");
            const unsigned og = xb_add(&bar[XB_TOP], 1u);
            const unsigned tg = og / nx;
            if (og + 1u == (tg + 1u) * nx) xb_add(&bar[XB_TOPGEN], 1u);
            else XB_SPIN(xb_ld(&bar[XB_TOPGEN]) == tg, bar);
            __builtin_amdgcn_fence(__ATOMIC_ACQUIRE, "agent");
            xb_add(&bar[XB_XGEN(b.x)], 1u);
            asm volatile("s_waitcnt vmcnt(0)" ::: "memory");
        } else {
            XB_SPIN(xb_ld(&bar[XB_XGEN(b.x)]) == gen, bar);
            __builtin_amdgcn_fence(__ATOMIC_ACQUIRE, "agent");
            asm volatile("s_waitcnt vmcnt(0)" ::: "memory");
        }
    }
    __syncthreads();
}

typedef const GAS float* gcf; typedef const GAS int* gci;
struct Args {
    gcf x, c; gci pos;
    gcf ada_w, ada_b, norm_mix_g, w_in, q_norm_g, kv_norm_g, w_uq, w_ukv, w_sb_out, w_mla_out, w_dsa_out, w_out,
        norm_ffn_g, router_w, router_b, w_gu, b_gu, w_dn, b_dn, final_g;
    GAS float* out; GAS unsigned char* ws;
    int ph_lo, ph_hi;
};
typedef const __attribute__((address_space(4))) Args* ArgsP;
struct Frame {
    LAS unsigned char* lds;
    volatile LAS unsigned* MISC;
    gu32* ctl;
    int tid, lane, wave, G, gw, NGW, bx;
    unsigned char* ws;
};
__constant__ float INVF32[32] = {1.f, 0.749894261f, 0.562341332f, 0.421696514f, 0.316227764f, 0.237137377f, 0.177827939f, 0.133352131f, 0.100000001f, 0.0749894157f, 0.0562341325f, 0.0421696529f, 0.0316227749f, 0.0237137377f, 0.0177827943f, 0.0133352149f, 0.00999999978f, 0.00749894185f, 0.00562341325f, 0.00421696482f, 0.00316227763f, 0.00237137359f, 0.00177827943f, 0.00133352145f, 0.00100000005f, 0.000749894243f, 0.000562341302f, 0.000421696517f, 0.000316227757f, 0.00023713737f, 0.00017782794f, 0.00013335215f};
__constant__ float INVF16[16] = {1.f, 0.562341332f, 0.316227764f, 0.177827939f, 0.100000001f, 0.0562341325f, 0.0316227749f, 0.0177827943f, 0.00999999978f, 0.00562341325f, 0.00316227763f, 0.00177827943f, 0.00100000005f, 0.000562341302f, 0.000316227757f, 0.00017782794f};

DI void p0_mod(Frame& F, ArgsP a) {
    LAS float* sc = (LAS float*)(F.lds + RING_OFF);
    LAS float* part = sc + 2048;
    for (int i = F.tid; i < 2048; i += NTHR) { const float v = ((const float*)a->c)[i]; sc[i] = v * fast_sigmoid(v); }
    __syncthreads();
    float* MOD = (float*)(F.ws + opq(WS_MOD));
    for (int task = F.bx; task < DEPTH * 96; task += F.G) {
        const int l = task / 96, n = (task % 96) * 64 + F.lane;
        const float* W = ((const float*)a->ada_w) + (size_t)l * DM * 6 * DM + n;
        float a0 = 0.f, a1 = 0.f; const int kb = F.wave * 128;
#pragma unroll 8
        for (int k = 0; k < 128; ++k) { const float w = W[(size_t)(kb + k) * (6 * DM)]; a0 = __builtin_fmaf(sc[kb + k], w, a0); a1 = __builtin_fmaf(sc[1024 + kb + k], w, a1); }
        part[(F.wave * 2 + 0) * 64 + F.lane] = a0; part[(F.wave * 2 + 1) * 64 + F.lane] = a1;
        __syncthreads();
        if (F.wave < 2) { float s = ((const float*)a->ada_b)[l * 6 * DM + n];
#pragma unroll
            for (int w = 0; w < 8; ++w) s += part[(w * 2 + F.wave) * 64 + F.lane];
            MOD[(size_t)(l * 2 + F.wave) * 6 * DM + n] = s; }
        __syncthreads();
    }
}
DI void p0_rope(Frame& F, ArgsP a) {
    float* R32 = (float*)(F.ws + opq(WS_ROPE32)); float* R16 = (float*)(F.ws + opq(WS_ROPE16));
    const int gt = F.bx * NTHR + F.tid, NT = F.G * NTHR;
    for (int i = gt; i < T * 32; i += NT) { const int t = i >> 5, f = i & 31; const float ang = (float)((const int*)a->pos)[t] * INVF32[f]; R32[i] = cosf(ang); R32[T * 32 + i] = sinf(ang); }
    for (int i = gt; i < T * 16; i += NT) { const int t = i >> 4, f = i & 15; const float ang = (float)((const int*)a->pos)[t] * INVF16[f]; R16[i] = cosf(ang); R16[T * 16 + i] = sinf(ang); }
}
struct CvtItem { const float* W; bf16_t* WT; int ld, nvalid, K, Ndst, mode, item; };
constexpr int CV_IN = (NPROJ / 32) * 16, CV_UQ = 0, CV_UKV = 0, CV_SB = 32 * 6, CV_MLA = 32 * 6, CV_DSA = 32 * 4, CV_OUT = 32 * 16, CV_GU = 64 * 16, CV_DN = 32 * 16;
constexpr int CV_SMALL = CV_IN + CV_UQ + CV_UKV + CV_SB + CV_MLA + CV_DSA + CV_OUT, CV_EXP = NEXP * (CV_GU + CV_DN);
constexpr int CV_UNIT = 96, N_CVT = CV_EXP / CV_UNIT;
DI void cvt_decode_small(CvtItem& c, Frame& F, ArgsP a, int it) {
    const int l = it / CV_SMALL; int r = it % CV_SMALL;
    if (r < CV_IN)  { c = CvtItem{((const float*)a->w_in) + (size_t)l * DM * D_IN, (bf16_t*)(F.ws + opq(WS_WIN)) + (size_t)l * NPROJ * DM, D_IN, D_IN, DM, NPROJ, 0, r}; return; } r -= CV_IN;
    if (r < CV_UQ)  { c = CvtItem{((const float*)a->w_uq) + (size_t)l * 256 * 576, (bf16_t*)(F.ws + opq(WS_WUQ)) + (size_t)l * 768 * 256, 576, 576, 256, 768, 0, r}; return; } r -= CV_UQ;
    if (r < CV_UKV) { c = CvtItem{((const float*)a->w_ukv) + (size_t)l * 128 * 768, (bf16_t*)(F.ws + opq(WS_WUKV)) + (size_t)l * 768 * 128, 768, 768, 128, 768, 0, r}; return; } r -= CV_UKV;
    if (r < CV_SB)  { c = CvtItem{((const float*)a->w_sb_out) + (size_t)l * 384 * DM, (bf16_t*)(F.ws + opq(WS_WSB)) + (size_t)l * DM * 384, DM, DM, 384, DM, 0, r}; return; } r -= CV_SB;
    if (r < CV_MLA) { c = CvtItem{((const float*)a->w_mla_out) + (size_t)l * 384 * DM, (bf16_t*)(F.ws + opq(WS_WMLA)) + (size_t)l * DM * 384, DM, DM, 384, DM, 0, r}; return; } r -= CV_MLA;
    if (r < CV_DSA) { c = CvtItem{((const float*)a->w_dsa_out) + (size_t)l * 256 * DM, (bf16_t*)(F.ws + opq(WS_WDSA)) + (size_t)l * DM * 256, DM, DM, 256, DM, 0, r}; return; } r -= CV_DSA;
    c = CvtItem{((const float*)a->w_out) + (size_t)l * DM * DM, (bf16_t*)(F.ws + opq(WS_WOUT)) + (size_t)l * DM * DM, DM, DM, DM, DM, 0, r};
}
DI void cvt_decode_expert(CvtItem& c, Frame& F, ArgsP a, int l, int r) {
    if (r < NEXP * CV_GU) { const int e = r / CV_GU; c = CvtItem{((const float*)a->w_gu) + (size_t)(l * NEXP + e) * DM * 2048, (bf16_t*)(F.ws + opq(WS_WGU)) + (size_t)(l * NEXP + e) * 2048 * DM, 2048, 2048, DM, 2048, 1, r % CV_GU}; return; } r -= NEXP * CV_GU;
    { const int e = r / CV_DN; c = CvtItem{((const float*)a->w_dn) + (size_t)(l * NEXP + e) * DM * DM, (bf16_t*)(F.ws + opq(WS_WDN)) + (size_t)(l * NEXP + e) * DM * DM, DM, DM, DM, DM, 0, r % CV_DN}; }
}
DI void cvt_load(f32x4 (&v)[8], const CvtItem& c, int lane) {
    const int nblk = c.Ndst / 32, kb = c.item / nblk, nb = c.item % nblk, k0 = 64 * kb, n0 = 32 * nb, quad = lane & 7;
    int col; if (c.mode == 0) col = n0 + 4 * quad; else col = (quad < 4) ? (n0 / 2 + 4 * quad) : (1024 + n0 / 2 + 4 * (quad - 4));
    const bool ok = (c.mode != 0) || (col < c.nvalid);
#pragma unroll
    for (int i = 0; i < 8; ++i) { const int row = (lane >> 3) + 8 * i; const float z0 = zero_op(); v[i] = (f32x4){z0, z0, z0, z0}; if (ok) v[i] = *(const f32x4*)(c.W + (size_t)(k0 + row) * c.ld + col); }
}
DI void cvt_store(const f32x4 (&v)[8], const CvtItem& c, LAS float* scr, int lane) {
    const int nblk = c.Ndst / 32, kb = c.item / nblk, nb = c.item % nblk, k0 = 64 * kb, n0 = 32 * nb, quad = lane & 7;
#pragma unroll
    for (int i = 0; i < 8; ++i) { const int row = (lane >> 3) + 8 * i; LAS float* d = scr + row * 33 + 4 * quad; d[0] = v[i][0]; d[1] = v[i][1]; d[2] = v[i][2]; d[3] = v[i][3]; }
    asm volatile("s_waitcnt lgkmcnt(0)" ::: "memory");
    const int cc = lane & 7;
#pragma unroll
    for (int j = 0; j < 4; ++j) { const int nn = (lane >> 3) + 8 * j; const int slot = (c.mode == 0) ? nn : ((nn & 1) * 16 + (nn >> 1)); const LAS float* s = scr + (8 * cc) * 33 + slot;
        u32x4 o; o.x = cvt_pk_bf16(s[0 * 33], s[1 * 33]); o.y = cvt_pk_bf16(s[2 * 33], s[3 * 33]); o.z = cvt_pk_bf16(s[4 * 33], s[5 * 33]); o.w = cvt_pk_bf16(s[6 * 33], s[7 * 33]);
        *(u32x4*)(c.WT + (size_t)(n0 + nn) * c.K + k0 + 8 * cc) = o; }
    asm volatile("s_waitcnt lgkmcnt(0)" ::: "memory");
}
DI void p0_convert_up(Frame& F, ArgsP a) {
    const int gt = F.bx * NTHR + F.tid, NT_ = F.G * NTHR;
    bf16_t* WUQ = (bf16_t*)(F.ws + opq(WS_WUQ)); bf16_t* WUKV = (bf16_t*)(F.ws + opq(WS_WUKV));
    for (int i = gt; i < DEPTH * 256 * 768; i += NT_) { const int n = i % 768, k = (i / 768) % 256, l = i / (768 * 256);
        const float v = n < 576 ? ((const float*)a->w_uq)[((size_t)l * 256 + k) * 576 + n] * ((const float*)a->q_norm_g)[l * 256 + k] : 0.f;
        WUQ[((size_t)l * 768 + n) * 256 + k] = (bf16_t)f2bf(v); }
    for (int i = gt; i < DEPTH * 128 * 768; i += NT_) { const int n = i % 768, k = (i / 768) % 128, l = i / (768 * 128);
        const float v = ((const float*)a->w_ukv)[((size_t)l * 128 + k) * 768 + n] * ((const float*)a->kv_norm_g)[l * 128 + k];
        WUKV[((size_t)l * 768 + n) * 128 + k] = (bf16_t)f2bf(v); }
}
DI void p0_convert(Frame& F, ArgsP a) {
    LAS float* scr = (LAS float*)(F.lds + RING_OFF + 16384 + F.wave * 12288);
    constexpr int NIT = DEPTH * CV_SMALL;
    f32x4 va[8], vb[8]; CvtItem ca, cb;
    int it = F.gw;
    if (it < NIT) { cvt_decode_small(ca, F, a, it); cvt_load(va, ca, F.lane); }
    while (it < NIT) {
        const int it1 = it + F.NGW;
        if (it1 < NIT) { cvt_decode_small(cb, F, a, it1); cvt_load(vb, cb, F.lane); }
        cvt_store(va, ca, scr, F.lane);
        if (it1 >= NIT) break;
        const int it2 = it1 + F.NGW;
        if (it2 < NIT) { cvt_decode_small(ca, F, a, it2); cvt_load(va, ca, F.lane); }
        cvt_store(vb, cb, scr, F.lane);
        it = it2;
    }
}
DI void cvt_unit(Frame& F, ArgsP a, int l, int cu) {
    LAS float* scr = (LAS float*)(F.lds + RING_OFF + F.wave * 12288);
    const int base = cu * CV_UNIT + F.wave; constexpr int NK = CV_UNIT / NWAVES;
    f32x4 va[8], vb[8], vc[8], vd[8]; CvtItem ca, cb, cc, cd;
    cvt_decode_expert(ca, F, a, l, base); cvt_load(va, ca, F.lane);
    cvt_decode_expert(cb, F, a, l, base + 8); cvt_load(vb, cb, F.lane);
    cvt_decode_expert(cc, F, a, l, base + 16); cvt_load(vc, cc, F.lane);
#pragma unroll 1
    for (int k = 0; k < NK; k += 4) {
        cvt_decode_expert(cd, F, a, l, base + 8 * (k + 3)); cvt_load(vd, cd, F.lane);
        cvt_store(va, ca, scr, F.lane);
        if (k + 4 < NK) { cvt_decode_expert(ca, F, a, l, base + 8 * (k + 4)); cvt_load(va, ca, F.lane); }
        cvt_store(vb, cb, scr, F.lane);
        if (k + 4 < NK) { cvt_decode_expert(cb, F, a, l, base + 8 * (k + 5)); cvt_load(vb, cb, F.lane); }
        cvt_store(vc, cc, scr, F.lane);
        if (k + 4 < NK) { cvt_decode_expert(cc, F, a, l, base + 8 * (k + 6)); cvt_load(vc, cc, F.lane); }
        cvt_store(vd, cd, scr, F.lane);
    }
}

struct RowCoef { f32x4 a[4], b[4]; };
DI void load_coef(RowCoef& c, const float* g, const float* sh, const float* sc, int lane) {
    f32x4 gg[4], ss[4];
#pragma unroll
    for (int j = 0; j < 4; ++j) { const int o = 4 * lane + 256 * j; gg[j] = *(const f32x4*)(g + o); ss[j] = *(const f32x4*)(sc + o); c.b[j] = *(const f32x4*)(sh + o); }
    __builtin_amdgcn_sched_barrier(0);
#pragma unroll
    for (int j = 0; j < 4; ++j) c.a[j] = gg[j] * (ss[j] + 1.0f);
}
DI float row_rstd(const f32x4 (&v)[4], int lane) {
    float s = 0.f;
#pragma unroll
    for (int j = 0; j < 4; ++j) s += (v[j].x * v[j].x + v[j].y * v[j].y) + (v[j].z * v[j].z + v[j].w * v[j].w);
    return 1.0f / sqrtf(wave_sum(s, lane) * (1.0f / DM) + NORM_EPS);
}
DI void store_xn(bf16_t* xn_row, const f32x4 (&h)[4], int lane) {
#pragma unroll
    for (int j = 0; j < 4; ++j) { u32x2 w; w.x = pk2(h[j].x, h[j].y); w.y = pk2(h[j].z, h[j].w); *(u32x2*)(xn_row + 4 * lane + 256 * j) = w; }
}
DI void p_norm_first(Frame& F, ArgsP a) {
    const float* MOD = (const float*)(F.ws + opq(WS_MOD)); bf16_t* XN = (bf16_t*)(F.ws + opq(WS_XN));
    constexpr int RPW = 8;
    for (int r0 = F.gw * RPW; r0 < T; r0 += F.NGW * RPW) {
        const int b = r0 / SEQ; const float* mod = MOD + (size_t)(0 * 2 + b) * 6 * DM;
        RowCoef c; load_coef(c, ((const float*)a->norm_mix_g), mod + 0 * DM, mod + 1 * DM, F.lane);
        for (int r = r0; r < r0 + RPW; ++r) {
            f32x4 v[4];
#pragma unroll
            for (int j = 0; j < 4; ++j) v[j] = *(const f32x4*)(((const float*)a->x) + (size_t)r * DM + 4 * F.lane + 256 * j);
            const float rstd = row_rstd(v, F.lane);
            f32x4 h[4];
#pragma unroll
            for (int j = 0; j < 4; ++j) h[j] = v[j] * rstd * c.a[j] + c.b[j];
            store_xn(XN + (size_t)r * DM, h, F.lane);
        }
    }
}
template <int NC> DI void rs_table(Frame& F, const bf16_t* src, LAS float* tab) {
    constexpr int LPR = NC / 8, RPI = 64 / LPR, NI = 32 / RPI;
    const int lane = F.lane, sub = lane / LPR, cl = lane % LPR;
    u32x4 v[NI];
#pragma unroll
    for (int j = 0; j < NI; ++j) v[j] = *(const u32x4*)(src + (size_t)(32 * F.wave + RPI * j + sub) * NPROJ + 8 * cl);
#pragma unroll
    for (int j = 0; j < NI; ++j) { float s = 0.f;
#pragma unroll
        for (int p = 0; p < 4; ++p) { const float x0 = bflo(v[j][p]), x1 = bfhi(v[j][p]); s = __builtin_fmaf(x0, x0, s); s = __builtin_fmaf(x1, x1, s); }
#pragma unroll
        for (int o = 1; o < LPR; o <<= 1) s += shx(s, o, lane);
        if (cl == 0) tab[32 * F.wave + RPI * j + sub] = 1.0f / sqrtf(s * (1.0f / NC) + NORM_EPS); }
}
DI void p_post1(Frame& F, ArgsP a, int l) {
    const bf16_t* PROJ = (const bf16_t*)(F.ws + opq(WS_PROJ));
    bf16_t* KR = (bf16_t*)(F.ws + opq(WS_KR));
    bf16_t* DK = (bf16_t*)(F.ws + opq(WS_DK)); bf16_t* IK = (bf16_t*)(F.ws + opq(WS_IK)); float* IW = (float*)(F.ws + opq(WS_IW));
    const float* C32 = (const float*)(F.ws + opq(WS_ROPE32)); const float* S32 = C32 + (size_t)T * 32;
    const float* C16 = (const float*)(F.ws + opq(WS_ROPE16)); const float* S16 = C16 + (size_t)T * 16;
    const int lane = F.lane;
    float kmx0 = 0.f, kmx1 = 0.f;
    const int hd = lane >> 4, i2 = 2 * (lane & 15), i1 = lane & 15; const bool second = lane >= 16;
    constexpr int RB = 8;
    for (int r0 = F.gw; r0 < T; r0 += RB * F.NGW) {
        unsigned w1[RB], w2[RB]; f32x2 cs[RB], sn[RB]; float x1[RB], x2[RB], c16[RB], s16[RB], iw[RB];
#pragma unroll
        for (int j = 0; j < RB; ++j) { const int r = r0 + j * F.NGW; const float z0 = zero_op();
            w1[j] = 0u; w2[j] = 0u; cs[j] = (f32x2){z0, z0}; sn[j] = (f32x2){z0, z0}; x1[j] = z0; x2[j] = z0; c16[j] = z0; s16[j] = z0; iw[j] = z0;
            if (r < T) { const bf16_t* p = PROJ + (size_t)r * NPROJ;
                { const bf16_t* q = p + C_DK + hd * 64; w1[j] = *(const unsigned*)(q + i2); w2[j] = *(const unsigned*)(q + 32 + i2); }
                cs[j] = *(const f32x2*)(C32 + (size_t)r * 32 + i2); sn[j] = *(const f32x2*)(S32 + (size_t)r * 32 + i2);
                if (lane < 32) { const bf16_t* q = p + (second ? C_IK : C_KR); x1[j] = bf2f(q[i1]); x2[j] = bf2f(q[i1 + 16]); c16[j] = C16[(size_t)r * 16 + i1]; s16[j] = S16[(size_t)r * 16 + i1]; }
                if (lane < 8) iw[j] = bf2f(p[C_IW + lane]); } }
#pragma unroll
        for (int j = 0; j < RB; ++j) { const int r = r0 + j * F.NGW;
            if (r < T) {
            { const float a0 = bflo(w1[j]), a1 = bfhi(w1[j]), b0 = bflo(w2[j]), b1 = bfhi(w2[j]);
              bf16_t* o = DK + (size_t)r * 256 + hd * 64;
              *(unsigned*)(o + i2) = pk2(a0 * cs[j].x - b0 * sn[j].x, a1 * cs[j].y - b1 * sn[j].y); *(unsigned*)(o + 32 + i2) = pk2(b0 * cs[j].x + a0 * sn[j].x, b1 * cs[j].y + a1 * sn[j].y); }
            float kn2 = 0.f;
            if (lane < 32) { bf16_t* o = (second ? IK : KR) + (size_t)r * 32; o[i1] = (bf16_t)f2bf(x1[j] * c16[j] - x2[j] * s16[j]); o[i1 + 16] = (bf16_t)f2bf(x2[j] * c16[j] + x1[j] * s16[j]);
              kn2 = second ? (x1[j] * x1[j] + x2[j] * x2[j]) : 0.f; }
            kn2 = wave_sum(kn2, lane);
            if (r < SEQ) kmx0 = fmaxf(kmx0, kn2); else kmx1 = fmaxf(kmx1, kn2);
            if (lane < 8) IW[(size_t)r * 8 + lane] = iw[j] * 0.0625f;
            } }
    }
    if (lane == 0) { F.MISC[32 + F.wave] = __builtin_bit_cast(unsigned, kmx0); F.MISC[40 + F.wave] = __builtin_bit_cast(unsigned, kmx1); }
    __syncthreads();
    if (F.tid < 2) { unsigned m = 0u; for (int w = 0; w < NWAVES; ++w) { const unsigned v = F.MISC[32 + 8 * F.tid + w]; m = v > m ? v : m; }
        atomicMax((unsigned*)(F.ctl + CW_KMAX + 64 * (l * 2 + F.tid)), m); }
}
namespace pg8 {
struct EpiStore {
    static constexpr bool PERM = true;
    DI void prefetch(const Unit&, int) const {}
    bf16_t* O; int ld;
    DI void operator()(const f32x4 (&acc)[2][2][4][2], const Unit& u, int wr, int wc, int fr, int fq) const {
        const int row0 = u.pm * BM + wr * 64 + fr, col0 = u.pn * BM + wc * 32 + 8 * fq;
#pragma unroll
        for (int ai = 0; ai < 2; ++ai)
#pragma unroll
            for (int m = 0; m < 4; ++m) { bf16_t* rowp = O + (size_t)(row0 + ai * HALF + m * 16) * ld + col0;
#pragma unroll
                for (int bj = 0; bj < 2; ++bj) { const f32x4 v0 = acc[ai][bj][m][0], v1 = acc[ai][bj][m][1];
                    u32x4 w; w.x = cvt_pk_bf16(v0[0], v0[1]); w.y = cvt_pk_bf16(v0[2], v0[3]); w.z = cvt_pk_bf16(v1[0], v1[1]); w.w = cvt_pk_bf16(v1[2], v1[3]);
                    *(u32x4*)(rowp + bj * HALF) = w; } }
    }
};
struct EpiStoreRS {
    static constexpr bool PERM = true;
    DI void prefetch(const Unit&, int) const {}
    bf16_t* O; int ld; LAS const float* rs;
    DI void operator()(const f32x4 (&acc)[2][2][4][2], const Unit& u, int wr, int wc, int fr, int fq) const {
        const int row0 = u.pm * BM + wr * 64 + fr, col0 = u.pn * BM + wc * 32 + 8 * fq;
#pragma unroll
        for (int ai = 0; ai < 2; ++ai)
#pragma unroll
            for (int m = 0; m < 4; ++m) { bf16_t* rowp = O + (size_t)(row0 + ai * HALF + m * 16) * ld + col0; const float s = rs[wr * 64 + fr + ai * HALF + m * 16];
#pragma unroll
                for (int bj = 0; bj < 2; ++bj) { const f32x4 v0 = acc[ai][bj][m][0] * s, v1 = acc[ai][bj][m][1] * s;
                    u32x4 w; w.x = cvt_pk_bf16(v0[0], v0[1]); w.y = cvt_pk_bf16(v0[2], v0[3]); w.z = cvt_pk_bf16(v1[0], v1[1]); w.w = cvt_pk_bf16(v1[2], v1[3]);
                    *(u32x4*)(rowp + bj * HALF) = w; } }
    }
};
struct EpiBranch {
    static constexpr bool PERM = true;
    DI void prefetch(const Unit&, int) const {}
    bf16_t* MRG; const bf16_t* PROJ; int gate0; int first;
    DI void operator()(const f32x4 (&acc)[2][2][4][2], const Unit& u, int wr, int wc, int fr, int fq) const {
        const int row0 = u.pm * BM + wr * 64 + fr, col0 = u.pn * BM + wc * 32 + 8 * fq;
#pragma unroll
        for (int ai = 0; ai < 2; ++ai) {
                u32x4 gl[4][2], pv[4][2];
#pragma unroll
                for (int m = 0; m < 4; ++m) { const size_t row = (size_t)(row0 + ai * HALF + m * 16);
#pragma unroll
                    for (int bj = 0; bj < 2; ++bj) { gl[m][bj] = *(const u32x4*)(PROJ + row * NPROJ + gate0 + col0 + bj * HALF);
                        if (!first) pv[m][bj] = *(const u32x4*)(MRG + row * DM + col0 + bj * HALF); else pv[m][bj] = (u32x4){0u, 0u, 0u, 0u}; } }
                __builtin_amdgcn_sched_barrier(0);
#pragma unroll
                for (int m = 0; m < 4; ++m) { const size_t row = (size_t)(row0 + ai * HALF + m * 16);
#pragma unroll
                    for (int bj = 0; bj < 2; ++bj) { const f32x4 v0 = acc[ai][bj][m][0], v1 = acc[ai][bj][m][1]; const u32x4 g_ = gl[m][bj], p_ = pv[m][bj];
                        bf16_t* mp_ = MRG + row * DM + col0 + bj * HALF;
                        float o[8];
                        o[0] = fast_sigmoid(bflo(g_.x)) * v0[0]; o[1] = fast_sigmoid(bfhi(g_.x)) * v0[1]; o[2] = fast_sigmoid(bflo(g_.y)) * v0[2]; o[3] = fast_sigmoid(bfhi(g_.y)) * v0[3];
                        o[4] = fast_sigmoid(bflo(g_.z)) * v1[0]; o[5] = fast_sigmoid(bfhi(g_.z)) * v1[1]; o[6] = fast_sigmoid(bflo(g_.w)) * v1[2]; o[7] = fast_sigmoid(bfhi(g_.w)) * v1[3];
                        if (!first) { o[0] += bflo(p_.x); o[1] += bfhi(p_.x); o[2] += bflo(p_.y); o[3] += bfhi(p_.y); o[4] += bflo(p_.z); o[5] += bfhi(p_.z); o[6] += bflo(p_.w); o[7] += bfhi(p_.w); }
                        u32x4 w; w.x = cvt_pk_bf16(o[0], o[1]); w.y = cvt_pk_bf16(o[2], o[3]); w.z = cvt_pk_bf16(o[4], o[5]); w.w = cvt_pk_bf16(o[6], o[7]);
                        *(u32x4*)mp_ = w; } }
            }
    }
};
struct EpiResid {
    static constexpr bool PERM = false;
    DI void prefetch(const Unit&, int) const {}
    float* X; const float* gvec; size_t dofs; const float* Xin;
    DI void operator()(const f32x4 (&acc)[2][2][4][2], const Unit& u, int wr, int wc, int fr, int fq) const {
        const int row0 = u.pm * BM + wr * 64 + fr, col0 = u.pn * BM + wc * 32 + 4 * fq; const float* g = gvec + (size_t)((u.pm * BM) / SEQ) * 6 * DM;
#pragma unroll
        for (int bj = 0; bj < 2; ++bj) { f32x4 gv[2];
#pragma unroll
            for (int n = 0; n < 2; ++n) gv[n] = *(const f32x4*)(g + col0 + bj * HALF + n * 16);
            f32x4 xv[2][4][2];
#pragma unroll
            for (int ai = 0; ai < 2; ++ai)
#pragma unroll
                for (int m = 0; m < 4; ++m)
#pragma unroll
                    for (int n = 0; n < 2; ++n) xv[ai][m][n] = *(const f32x4*)(Xin + (size_t)(row0 + ai * HALF + m * 16) * DM + col0 + bj * HALF + n * 16);
            __builtin_amdgcn_sched_barrier(0);
#pragma unroll
            for (int ai = 0; ai < 2; ++ai)
#pragma unroll
                for (int m = 0; m < 4; ++m)
#pragma unroll
                    for (int n = 0; n < 2; ++n) { float* xp = X + (size_t)(row0 + ai * HALF + m * 16) * DM + col0 + bj * HALF + n * 16;
                        *(f32x4*)((char*)xp + dofs) = xv[ai][m][n] + gv[n] * acc[ai][bj][m][n]; } }
    }
};
struct MoeTab { LAS const int* cnt; LAS const int* tpre; LAS const int* off; LAS const int* xe; LAS const int* xt; };
template <bool GATHER, int NCOLT> struct MoeSched {
    const bf16_t* A; const bf16_t* Bt; const int* list; MoeTab tb; int K, G, c; LAS unsigned* ltab;
    DI bool next(int i, Unit& u) const {
        const int GX = G >> 3, x = c & 7, j = c >> 3; if (j >= GX) return false;
        LAS const int* xt = tb.xt + x * 5;
        const int L = i * GX + j; if (L >= __builtin_amdgcn_readfirstlane(xt[4]) * NCOLT) return false;
        const int tile = L / NCOLT; u.pn = L % NCOLT; int k = 0; while (__builtin_amdgcn_readfirstlane(xt[k + 1]) <= tile) ++k;
        const int e = __builtin_amdgcn_readfirstlane(tb.xe[x * 4 + k]), tp = __builtin_amdgcn_readfirstlane(xt[k]);
        const int of = __builtin_amdgcn_readfirstlane(tb.off[e]), cn = __builtin_amdgcn_readfirstlane(tb.cnt[e]);
        u.e = e; u.pm = (tile - tp) * BM; u.row0 = of + u.pm; const int left = cn - u.pm; u.nrows = left < BM ? left : BM; return true;
    }
    DI const char* abase(const Unit& u) const { return GATHER ? (const char*)A : (const char*)A + (size_t)u.row0 * K * 2; }
    DI const char* bbase(const Unit& u) const { return (const char*)Bt + ((size_t)u.e * NCOLT * BM + (size_t)u.pn * BM) * K * 2; }
    DI void aoffs(const Unit& u, int R, int C, unsigned (&v)[4]) const {
#pragma unroll
        for (int m = 0; m < 4; ++m) { int rr = R + 64 * m;
            if (GATHER) { rr = rr < u.nrows ? rr : 0; rr = list[u.e * ECAP + u.pm + rr]; }
            v[m] = (unsigned)(rr * K + C) * 2u; }
    }
    DI void prefetch(const Unit& u, int tid, int par) const {
        if (GATHER) { if (tid < 256) { const int rr = tid < u.nrows ? tid : 0;
            __builtin_amdgcn_global_load_lds((const unsigned*)(list + u.e * ECAP + u.pm + rr), (LAS unsigned*)(ltab + par * 256 + (tid & ~63)), 4, 0, 0); } }
    }
    DI void aoffs_next(const Unit& u, int R, int C, unsigned (&v)[4], int par) const {
        if (GATHER) {
#pragma unroll
            for (int m = 0; m < 4; ++m) v[m] = (unsigned)((int)ltab[par * 256 + R + 64 * m] * K + C) * 2u;
        } else aoffs(u, R, C, v);
    }
};
struct EpiSwiglu {
    static constexpr bool PERM = true;
    bf16_t* ACT; const float* bgu; LAS float* etab;
    DI void prefetch(const Unit& u, int tid) const {
        if (tid < 64) { const float* bg = bgu + (size_t)u.e * 2048 + u.pn * 128 + (tid < 32 ? 4 * tid : 1024 + 4 * (tid - 32));
            __builtin_amdgcn_global_load_lds((const unsigned*)bg, (LAS unsigned*)(etab + u.par * 256), 16, 0, 0); }
    }
    DI void operator()(const f32x4 (&acc)[2][2][4][2], const Unit& u, int wr, int wc, int fr, int fq) const {
        const int r0 = wr * 64 + fr, c0 = u.pn * BM + wc * 32 + 8 * fq; LAS const float* tb_ = etab + u.par * 256;
        f32x4 bgate[2], bup[2];
#pragma unroll
        for (int bj = 0; bj < 2; ++bj) { const int jj = wc * 16 + 4 * fq + bj * 64; bgate[bj] = *(LAS const f32x4*)(tb_ + jj); bup[bj] = *(LAS const f32x4*)(tb_ + 128 + jj); }
#pragma unroll
        for (int bj = 0; bj < 2; ++bj) { const int j0 = (c0 + bj * HALF) >> 1;
#pragma unroll
            for (int ai = 0; ai < 2; ++ai)
#pragma unroll
                for (int m = 0; m < 4; ++m) { const int r = r0 + ai * HALF + m * 16; const f32x4 v0 = acc[ai][bj][m][0], v1 = acc[ai][bj][m][1];
                    float g[4] = {v0[0] + bgate[bj][0], v0[2] + bgate[bj][1], v1[0] + bgate[bj][2], v1[2] + bgate[bj][3]};
                    float p[4] = {v0[1] + bup[bj][0], v0[3] + bup[bj][1], v1[1] + bup[bj][2], v1[3] + bup[bj][3]};
                    float o[4];
#pragma unroll
                    for (int k = 0; k < 4; ++k) { const float gg = fminf(g[k], 7.0f), uu = fminf(fmaxf(p[k], -7.0f), 7.0f); o[k] = (uu + 1.0f) * (gg * fast_sigmoid(1.702f * gg)); }
                    if (r < u.nrows) { u32x2 w; w.x = cvt_pk_bf16(o[0], o[1]); w.y = cvt_pk_bf16(o[2], o[3]); *(u32x2*)(ACT + (size_t)(u.row0 + r) * DM + j0) = w; } } }
    }
};
struct EpiDown {
    static constexpr bool PERM = true;
    bf16_t* EOUT; const float* bdn; const float* listw; LAS float* etab;
    DI void prefetch(const Unit& u, int tid) const {
        if (tid < 128) { const float* src = tid < 64 ? bdn + (size_t)u.e * DM + u.pn * BM + 4 * tid : listw + (size_t)u.e * ECAP + u.pm + 4 * (tid - 64);
            __builtin_amdgcn_global_load_lds((const unsigned*)src, (LAS unsigned*)(etab + u.par * 512 + (tid & 64) * 4), 16, 0, 0); }
    }
    DI void operator()(const f32x4 (&acc)[2][2][4][2], const Unit& u, int wr, int wc, int fr, int fq) const {
        const int r0 = wr * 64 + fr, c0 = u.pn * BM + wc * 32 + 8 * fq; LAS const float* tb_ = etab + u.par * 512;
        f32x4 b0[2], b1[2]; float cw[2][4];
#pragma unroll
        for (int bj = 0; bj < 2; ++bj) { const int cc = wc * 32 + 8 * fq + bj * HALF; b0[bj] = *(LAS const f32x4*)(tb_ + cc); b1[bj] = *(LAS const f32x4*)(tb_ + cc + 4); }
#pragma unroll
        for (int ai = 0; ai < 2; ++ai)
#pragma unroll
            for (int m = 0; m < 4; ++m) cw[ai][m] = tb_[256 + r0 + ai * HALF + m * 16];
#pragma unroll
        for (int ai = 0; ai < 2; ++ai)
#pragma unroll
            for (int m = 0; m < 4; ++m) { const int r = r0 + ai * HALF + m * 16;
                if (r < u.nrows) {
#pragma unroll
                    for (int bj = 0; bj < 2; ++bj) {
                        const f32x4 v0 = (acc[ai][bj][m][0] + b0[bj]) * cw[ai][m], v1 = (acc[ai][bj][m][1] + b1[bj]) * cw[ai][m];
                        u32x4 w; w.x = cvt_pk_bf16(v0[0], v0[1]); w.y = cvt_pk_bf16(v0[2], v0[3]); w.z = cvt_pk_bf16(v1[0], v1[1]); w.w = cvt_pk_bf16(v1[2], v1[3]);
                        *(u32x4*)(EOUT + (size_t)(u.row0 + r) * DM + c0 + bj * HALF) = w; } } }
    }
};
}

DI pg8::MoeTab moe_tables_again(Frame& F) {
    pg8::MoeTab tb; tb.cnt = (LAS int*)(F.MISC + 64); tb.tpre = (LAS int*)(F.MISC + 100); tb.off = (LAS int*)(F.MISC + 140); tb.xe = (LAS int*)(F.MISC + 176); tb.xt = (LAS int*)(F.MISC + 208);
    __syncthreads();
    return tb;
}
DI pg8::MoeTab moe_tables(Frame& F, int l) {
    LAS int* cnt = (LAS int*)(F.MISC + 64); LAS int* tpre = (LAS int*)(F.MISC + 100); LAS int* off = (LAS int*)(F.MISC + 140);
    LAS int* xe = (LAS int*)(F.MISC + 176); LAS int* xt = (LAS int*)(F.MISC + 208);
    __syncthreads();
    if (F.tid < NEXP) cnt[F.tid] = (int)__hip_atomic_load(F.ctl + CW_CNT + l * NEXP + F.tid, RLX_AGENT);
    __syncthreads();
    if (F.tid == 0) { int tp = 0, so = 0; for (int e = 0; e < NEXP; ++e) { tpre[e] = tp; off[e] = so; tp += (cnt[e] + 255) >> 8; so += cnt[e]; } tpre[NEXP] = tp; off[NEXP] = so; }
    if (F.tid >= 64 && F.tid < 64 + NEXP) {
        const int e = F.tid - 64, tl = (cnt[e] + 255) >> 8; int r = 0;
        for (int o = 0; o < NEXP; ++o) { const int to = (cnt[o] + 255) >> 8; r += (to > tl || (to == tl && o < e)) ? 1 : 0; }
        const int grp = r >> 3, pos = r & 7, x = (grp & 1) ? 7 - pos : pos; xe[x * 4 + grp] = e; }
    __syncthreads();
    if (F.tid < 8) { int s = 0; for (int k = 0; k < 4; ++k) { xt[F.tid * 5 + k] = s; s += (cnt[xe[F.tid * 4 + k]] + 255) >> 8; } xt[F.tid * 5 + 4] = s; }
    __syncthreads();
    pg8::MoeTab tb; tb.cnt = cnt; tb.tpre = tpre; tb.off = off; tb.xe = xe; tb.xt = xt; return tb;
}
DI unsigned f_sortable(float f) { const unsigned b = __builtin_bit_cast(unsigned, f); return b ^ ((b >> 31) ? 0xFFFFFFFFu : 0x80000000u); }
DI void p_norm2_router(Frame& F, ArgsP a, int l, size_t dofs = 0, int cslot = -1) {
    if (cslot < 0) cslot = l;
    LAS float* WT = (LAS float*)(F.lds + RING_OFF);
    { const float* rw = ((const float*)a->router_w) + (size_t)l * DM * NEXP;
#pragma unroll
      for (int ch = 0; ch < 2; ++ch) { const int k = 128 * F.wave + 64 * ch + F.lane; f32x4 w[8];
#pragma unroll
          for (int e4 = 0; e4 < 8; ++e4) w[e4] = *(const f32x4*)(rw + (size_t)k * NEXP + 4 * e4);
#pragma unroll
          for (int e4 = 0; e4 < 8; ++e4) { WT[(4 * e4 + 0) * DM + k] = w[e4].x; WT[(4 * e4 + 1) * DM + k] = w[e4].y; WT[(4 * e4 + 2) * DM + k] = w[e4].z; WT[(4 * e4 + 3) * DM + k] = w[e4].w; } } }
    __syncthreads();
    const float* MOD = (const float*)(F.ws + opq(WS_MOD)); const float* X = (const float*)(F.ws + opq(WS_X)); bf16_t* XN = (bf16_t*)(F.ws + opq(WS_XN) + dofs);
    int* LIST = (int*)(F.ws + opq(WS_LIST) + dofs); float* LISTW = (float*)(F.ws + opq(WS_LISTW) + dofs); int* TOKE = (int*)(F.ws + opq(WS_TOKE) + dofs);
    volatile LAS unsigned* RENT = (volatile LAS unsigned*)(F.lds + MISC_OFF + 1024);
    if (F.tid < NEXP) F.MISC[64 + F.tid] = 0u;
    const int lane = F.lane; const int e_mine = lane >> 1;
    const float rb = ((const float*)a->router_b)[l * NEXP + e_mine];
    constexpr int RPW = 8;
    const int rstride = F.NGW * RPW, riters = (T + rstride - 1) / rstride;
    for (int rit = 0; rit < riters; ++rit) {
        const int r0 = F.gw * RPW + rit * rstride; const bool ract = r0 < T;
        if (ract) {
        const int b = r0 / SEQ; const float* mod = MOD + (size_t)(l * 2 + b) * 6 * DM;
        RowCoef c; load_coef(c, ((const float*)a->norm_ffn_g) + l * DM, mod + 3 * DM, mod + 4 * DM, lane);
        f32x4 nx[4];
#pragma unroll
        for (int j = 0; j < 4; ++j) nx[j] = *(const f32x4*)(X + (size_t)r0 * DM + 4 * lane + 256 * j);
        for (int r = r0; r < r0 + RPW; ++r) {
            f32x4 h[4];
#pragma unroll
            for (int j = 0; j < 4; ++j) h[j] = nx[j];
            if (r + 1 < r0 + RPW) {
#pragma unroll
                for (int j = 0; j < 4; ++j) nx[j] = *(const f32x4*)(X + (size_t)(r + 1) * DM + 4 * lane + 256 * j); }
            const float rstd = row_rstd(h, lane);
#pragma unroll
            for (int j = 0; j < 4; ++j) h[j] = h[j] * rstd * c.a[j] + c.b[j];
            store_xn(XN + (size_t)r * DM, h, lane);
            float v[32];
#pragma unroll
            for (int e = 0; e < 32; ++e) { float s = 0.f;
#pragma unroll
                for (int j = 0; j < 4; ++j) { const f32x4 w = *(const LAS f32x4*)(WT + e * DM + 4 * lane + 256 * j); s += (h[j].x * w.x + h[j].y * w.y) + (h[j].z * w.z + h[j].w * w.w); }
                v[e] = s; if ((e & 3) == 3) __builtin_amdgcn_sched_barrier(0); }
            float a16[16], a8[8], a4[4], a2[2], a1;
            { const bool up = lane & 32;
#pragma unroll
              for (int i = 0; i < 16; ++i) { const float keep = up ? v[16 + i] : v[i], send = up ? v[i] : v[16 + i]; a16[i] = keep + shx(send, 32, lane); } }
            { const bool up = lane & 16;
#pragma unroll
              for (int i = 0; i < 8; ++i) { const float keep = up ? a16[8 + i] : a16[i], send = up ? a16[i] : a16[8 + i]; a8[i] = keep + shx(send, 16, lane); } }
            { const bool up = lane & 8;
#pragma unroll
              for (int i = 0; i < 4; ++i) { const float keep = up ? a8[4 + i] : a8[i], send = up ? a8[i] : a8[4 + i]; a4[i] = keep + shx(send, 8, lane); } }
            { const bool up = lane & 4;
#pragma unroll
              for (int i = 0; i < 2; ++i) { const float keep = up ? a4[2 + i] : a4[i], send = up ? a4[i] : a4[2 + i]; a2[i] = keep + shx(send, 4, lane); } }
            { const bool up = lane & 2; const float keep = up ? a2[1] : a2[0], send = up ? a2[0] : a2[1]; a1 = keep + shx(send, 2, lane); }
            a1 += shx(a1, 1, lane);
            const float logit = a1 + rb;
            unsigned long long key = ((unsigned long long)f_sortable(logit) << 32) | (unsigned)(31 - e_mine);
            int te[4]; float tv[4];
#pragma unroll
            for (int k = 0; k < 4; ++k) {
                unsigned long long m = key;
#pragma unroll
                for (int o = 1; o < 64; o <<= 1) { const unsigned long long t = shx64(m, o, lane); m = t > m ? t : m; }
                te[k] = 31 - (int)(unsigned)(m & 0xFFFFFFFFull); tv[k] = shl(logit, 2 * te[k]);
                if (e_mine == te[k]) key = 0ull;
            }
            const float e1 = __expf(tv[1] - tv[0]), e2 = __expf(tv[2] - tv[0]), e3 = __expf(tv[3] - tv[0]); const float inv = 1.0f / (1.0f + e1 + e2 + e3);
            if (lane < 4) {
                const int ek = lane == 0 ? te[0] : lane == 1 ? te[1] : lane == 2 ? te[2] : te[3];
                const float wk = (lane == 0 ? 1.0f : lane == 1 ? e1 : lane == 2 ? e2 : e3) * inv;
                const unsigned lr = __hip_atomic_fetch_add((LAS unsigned*)(F.MISC + 64 + ek), 1u, __ATOMIC_RELAXED, __HIP_MEMORY_SCOPE_WORKGROUP);
                RENT[((F.wave * RPW + (r - r0)) * 4 + lane) * 2] = (unsigned)ek | (lr << 8); RENT[((F.wave * RPW + (r - r0)) * 4 + lane) * 2 + 1] = __builtin_bit_cast(unsigned, wk);
            }
        }
        }
        __syncthreads();
        if (F.tid < NEXP) { const unsigned c = F.MISC[64 + F.tid]; F.MISC[96 + F.tid] = c ? __hip_atomic_fetch_add(F.ctl + CW_CNT + cslot * NEXP + F.tid, c, RLX_AGENT) : 0u; F.MISC[64 + F.tid] = 0u; }
        __syncthreads();
        if (ract && lane < 4 * RPW) { const int ri = lane >> 2, k = lane & 3, r = r0 + ri;
            const unsigned en = RENT[((F.wave * RPW + ri) * 4 + k) * 2]; const int ek = en & 0xff; const int rank = (int)(F.MISC[96 + ek] + (en >> 8));
            LIST[ek * ECAP + rank] = r; LISTW[ek * ECAP + rank] = __builtin_bit_cast(float, RENT[((F.wave * RPW + ri) * 4 + k) * 2 + 1]); TOKE[r * 4 + k] = ek | (rank << 8); }
        __syncthreads();
    }
}
DI void p_combine(Frame& F, ArgsP a, int l, const pg8::MoeTab& tb, size_t dofs = 0) {
    const float* MOD = (const float*)(F.ws + opq(WS_MOD)); const float* X = (const float*)(F.ws + opq(WS_X)); float* XO = (float*)(F.ws + opq(WS_X) + dofs); bf16_t* XN = (bf16_t*)(F.ws + opq(WS_XN) + dofs);
    const bf16_t* EOUT = (const bf16_t*)(F.ws + opq(WS_EOUT)); const int* TOKE = (const int*)(F.ws + opq(WS_TOKE));
    const int lane = F.lane; const bool lastl = (l == DEPTH - 1);
    constexpr int RPW = 8;
    for (int r0 = F.gw * RPW; r0 < T; r0 += F.NGW * RPW) {
        const int b = r0 / SEQ; const float* mod = MOD + (size_t)(l * 2 + b) * 6 * DM;
        f32x4 gf[4];
#pragma unroll
        for (int j = 0; j < 4; ++j) gf[j] = *(const f32x4*)(mod + 5 * DM + 4 * lane + 256 * j);
        RowCoef c;
        if (!lastl) { const float* modn = MOD + (size_t)((l + 1) * 2 + b) * 6 * DM; load_coef(c, ((const float*)a->norm_mix_g) + (l + 1) * DM, modn + 0 * DM, modn + 1 * DM, lane); }
        else {
#pragma unroll
            for (int j = 0; j < 4; ++j) { c.a[j] = *(const f32x4*)(((const float*)a->final_g) + 4 * lane + 256 * j); const float z0 = zero_op(); c.b[j] = (f32x4){z0, z0, z0, z0}; } }
        int myslot = 0;
        if (lane < 4 * RPW) { const int te = TOKE[(size_t)r0 * 4 + lane]; myslot = tb.off[te & 0xff] + (te >> 8); }
        u32x2 ne[4][4]; f32x4 nx[4];
#define CB_LOAD(r_) do { _Pragma("unroll") for (int k = 0; k < 4; ++k) { const int slot = __builtin_amdgcn_readlane(myslot, 4 * ((r_) - r0) + k); const bf16_t* ep = EOUT + (size_t)slot * DM; \
            _Pragma("unroll") for (int j = 0; j < 4; ++j) ne[k][j] = *(const u32x2*)(ep + 4 * lane + 256 * j); } \
            _Pragma("unroll") for (int j = 0; j < 4; ++j) nx[j] = *(const f32x4*)(X + (size_t)(r_) * DM + 4 * lane + 256 * j); } while (0)
        f32x4 v[4]; u32x2 ce[4][4];
#pragma unroll 1
        for (int r = r0; r < r0 + RPW; ++r) {
            if (r == r0) {
#pragma unroll
                for (int ri = 0; ri < 1; ++ri) CB_LOAD(r0); }
#pragma unroll
            for (int k = 0; k < 4; ++k)
#pragma unroll
                for (int j = 0; j < 4; ++j) ce[k][j] = ne[k][j];
#pragma unroll
            for (int j = 0; j < 4; ++j) v[j] = nx[j];
            if (r + 1 < r0 + RPW) CB_LOAD(r + 1);
            f32x4 y[4];
#pragma unroll
            for (int j = 0; j < 4; ++j) { const float z0 = zero_op(); y[j] = (f32x4){z0, z0, z0, z0}; }
#ifndef DBG_SKIP_MOE
#pragma unroll
            for (int k = 0; k < 4; ++k)
#pragma unroll
                for (int j = 0; j < 4; ++j) { const u32x2 w = ce[k][j]; y[j].x += bflo(w.x); y[j].y += bfhi(w.x); y[j].z += bflo(w.y); y[j].w += bfhi(w.y); }
#endif
#pragma unroll
            for (int j = 0; j < 4; ++j) v[j] = v[j] + gf[j] * y[j];
            const float rstd = row_rstd(v, lane);
            f32x4 h[4];
#pragma unroll
            for (int j = 0; j < 4; ++j) h[j] = v[j] * rstd * c.a[j] + c.b[j];
            if (!lastl) {
#pragma unroll
                for (int j = 0; j < 4; ++j) *(f32x4*)(XO + (size_t)r * DM + 4 * lane + 256 * j) = v[j];
                store_xn(XN + (size_t)r * DM, h, lane);
            } else {
#pragma unroll
                for (int j = 0; j < 4; ++j) *(f32x4*)((dofs ? XO : (float*)a->out) + (size_t)r * DM + 4 * lane + 256 * j) = h[j];
            }
        }
    }
}
DI f32x16 mfma32(bf16x8 a, bf16x8 b, f32x16 c) { return __builtin_amdgcn_mfma_f32_32x32x16_bf16(a, b, c, 0, 0, 0); }
typedef short v4i16_t __attribute__((ext_vector_type(4)));
DI s16x4 tr_read(LAS const unsigned char* p) { return __builtin_bit_cast(s16x4, __builtin_amdgcn_ds_read_tr16_b64_v4i16((LAS v4i16_t*)p)); }
DI int crow(int reg, int h) { return (reg & 3) + 8 * (reg >> 2) + 4 * h; }
template <int S> DI bf16x8 pack8(const f32x16& x) {
    u32x4 p; p.x = cvt_pk_bf16(x[8 * S + 0], x[8 * S + 1]); p.y = cvt_pk_bf16(x[8 * S + 2], x[8 * S + 3]); p.z = cvt_pk_bf16(x[8 * S + 4], x[8 * S + 5]); p.w = cvt_pk_bf16(x[8 * S + 6], x[8 * S + 7]);
    return __builtin_bit_cast(bf16x8, p);
}
DI bf16x8 scale8(bf16x8 v, float s) {
    u32x4 w = __builtin_bit_cast(u32x4, v); u32x4 o;
    o.x = pk2(bflo(w.x) * s, bfhi(w.x) * s); o.y = pk2(bflo(w.y) * s, bfhi(w.y) * s); o.z = pk2(bflo(w.z) * s, bfhi(w.z) * s); o.w = pk2(bflo(w.w) * s, bfhi(w.w) * s);
    return __builtin_bit_cast(bf16x8, o);
}
struct Rope8 { float c[8], d[8]; };
DI void rope_load(Rope8& r, const float* cs, const float* sn) {
    const f32x4 c0 = *(const f32x4*)cs, c1 = *(const f32x4*)(cs + 4), s0 = *(const f32x4*)sn, s1 = *(const f32x4*)(sn + 4);
#pragma unroll
    for (int j = 0; j < 4; ++j) { r.c[j] = c0[j]; r.c[4 + j] = c1[j]; r.d[j] = s0[j]; r.d[4 + j] = s1[j]; }
}
DI void rope_apply(bf16x8& a, bf16x8& b, const Rope8& r, float s) {
    const u32x4 wa = __builtin_bit_cast(u32x4, a), wb = __builtin_bit_cast(u32x4, b); u32x4 oa, ob;
#pragma unroll
    for (int p = 0; p < 4; ++p) { const float a0 = bflo(wa[p]), a1 = bfhi(wa[p]), b0 = bflo(wb[p]), b1 = bfhi(wb[p]);
        oa[p] = pk2((a0 * r.c[2 * p] - b0 * r.d[2 * p]) * s, (a1 * r.c[2 * p + 1] - b1 * r.d[2 * p + 1]) * s);
        ob[p] = pk2((b0 * r.c[2 * p] + a0 * r.d[2 * p]) * s, (b1 * r.c[2 * p + 1] + a1 * r.d[2 * p + 1]) * s); }
    asm volatile("" : "+v"(oa), "+v"(ob));
    a = __builtin_bit_cast(bf16x8, oa); b = __builtin_bit_cast(bf16x8, ob);
}
DI void rope8(bf16x8& a, bf16x8& b, const float* cs, const float* sn, float s) { Rope8 r; rope_load(r, cs, sn); rope_apply(a, b, r, s); }
template <int KB2, int PST = 4096> DI void pv_block(f32x16 (&o)[2], const f32x16& p, LAS const unsigned char* vs, int lane) {
    const int hi = lane >> 5, i16 = lane & 15, q4 = i16 >> 2, p4 = i16 & 3, blk = (lane >> 4) & 1;
    const bf16x8 pb0 = pack8<0>(p), pb1 = pack8<1>(p);
    LAS const unsigned char* base = vs + (32 * KB2 + 4 * hi + q4) * 64 + (16 * blk + 4 * p4) * 2;
#pragma unroll
    for (int dh = 0; dh < 2; ++dh) {
        const s16x4 l0 = tr_read(base + dh * PST), h0 = tr_read(base + dh * PST + 8 * 64), l1 = tr_read(base + dh * PST + 16 * 64), h1 = tr_read(base + dh * PST + 24 * 64);
        const bf16x8 v0 = __builtin_shufflevector(l0, h0, 0, 1, 2, 3, 4, 5, 6, 7), v1 = __builtin_shufflevector(l1, h1, 0, 1, 2, 3, 4, 5, 6, 7);
        o[dh] = mfma32(v0, pb0, o[dh]); o[dh] = mfma32(v1, pb1, o[dh]);
    }
}
DI void store_ot(bf16_t* orow, const f32x16 (&o)[2], float sc, int hi) {
#pragma unroll
    for (int dh = 0; dh < 2; ++dh)
#pragma unroll
        for (int g = 0; g < 4; ++g) { u32x2 w; w.x = pk2(o[dh][4 * g] * sc, o[dh][4 * g + 1] * sc); w.y = pk2(o[dh][4 * g + 2] * sc, o[dh][4 * g + 3] * sc);
            *(u32x2*)(orow + 32 * dh + 8 * g + 4 * hi) = w; }
}
DI float max3f(float a, float b, float c) { float r; asm("v_max3_f32 %0, %1, %2, %3" : "=v"(r) : "v"(a), "v"(b), "v"(c)); return r; }
DI float rowmax32(const f32x16& A, const f32x16& B) {
    float m = max3f(A[0], B[0], A[1]), n = max3f(B[1], A[2], B[2]);
#pragma unroll
    for (int i = 3; i < 15; i += 2) { m = max3f(m, A[i], B[i]); n = max3f(n, A[i + 1], B[i + 1]); }
    return max3f(m, n, fmaxf(A[15], B[15]));
}
DI void raise_ref(f32x16& p0, f32x16& p1, f32x16 (&o)[2], f32x16& negm, float& m_ref, float& l_run, bool& init, float mx, int lane) {
    mx = fmaxf(mx, shx(mx, 32, lane)); const float dl = init ? fmaxf(mx, 0.f) : mx; init = true;
    m_ref += dl; const float alpha = __builtin_amdgcn_exp2f(-dl); l_run *= alpha;
#pragma unroll
    for (int i = 0; i < 16; ++i) { o[0][i] *= alpha; o[1][i] *= alpha; p0[i] -= dl; p1[i] -= dl; negm[i] = -m_ref; }
}
template <int BIT> DI float mask_bit(float e, unsigned word) {
    unsigned m; asm("v_bfe_i32 %0, %1, %2, 1" : "=v"(m) : "v"(word), "n"(BIT));
    return __builtin_bit_cast(float, __builtin_bit_cast(unsigned, e) & m);
}
constexpr int AT_KS = 13312, AT_K0 = 0, AT_V0 = 2 * AT_KS, AT_VS = 8192;

DI void mla_unit(Frame& F, int b, int h, int qb) {
    const bf16_t* QM = (const bf16_t*)(F.ws + opq(WS_QM)); const bf16_t* KVM = (const bf16_t*)(F.ws + opq(WS_KVM)); const bf16_t* KR = (const bf16_t*)(F.ws + opq(WS_KR)); bf16_t* OUT = (bf16_t*)(F.ws + opq(WS_OMLA));
    const float* C16 = (const float*)(F.ws + opq(WS_ROPE16)); const float* S16 = C16 + (size_t)T * 16;
    const int tid = F.tid, lane = F.lane, r32 = lane & 31, hi = lane >> 5, w = F.wave;
    const int qw = qb * 256 + 32 * w; const size_t row = (size_t)b * SEQ + qw + r32;
    constexpr float QS = 0.10206207261596577f * 1.4426950408889634f;
    bf16x8 qf[6];
    { const bf16_t* qp = QM + row * 768 + h * 96 + 8 * hi;
#pragma unroll
      for (int s = 0; s < 6; ++s) qf[s] = *(const bf16x8*)(qp + 16 * s);
#pragma unroll
      for (int s = 0; s < 4; ++s) qf[s] = scale8(qf[s], QS);
      rope8(qf[4], qf[5], C16 + row * 16 + 8 * hi, S16 + row * 16 + 8 * hi, QS); }
    const int NS = 2 * (qb + 1), cw = 4 * qb + (w >> 1);
    constexpr int MK = 4 * AT_KS;
    const int kr = tid >> 3, c8 = tid & 7, kr2 = (tid >> 2) & 63, c4 = tid & 3, rp = tid >> 8;
    const bf16_t* gk = KVM + ((size_t)b * SEQ + kr) * 768 + h * 128 + 8 * c8;
    const bf16_t* gr = KR + ((size_t)b * SEQ + rp * 64 + kr2) * 32 + 8 * c4;
    const int lk = kr * 208 + c8 * 16, lr = rp * AT_KS + kr2 * 208 + 128 + c4 * 16, lv = (c8 >> 2) * 4096 + kr * 64 + (c8 & 3) * 16;
    LAS unsigned char* L = F.lds + RING_OFF;
    u32x4 rkA, rvA, rkB, rvB, rr;
#define MLA_LOAD(s) do { const bf16_t* g_ = gk + (size_t)(s) * 128 * 768; rkA = *(const u32x4*)g_; rvA = *(const u32x4*)(g_ + 64); rkB = *(const u32x4*)(g_ + 64 * 768); rvB = *(const u32x4*)(g_ + 64 * 768 + 64); rr = *(const u32x4*)(gr + (size_t)(s) * 128 * 32); } while (0)
#define MLA_WRITE(bf) do { LAS unsigned char* k_ = L + (bf) * 2 * AT_KS; LAS unsigned char* v_ = L + MK + (bf) * 2 * AT_VS; *(LAS u32x4*)(k_ + lk) = rkA; *(LAS u32x4*)(v_ + lv) = rvA; *(LAS u32x4*)(k_ + AT_KS + lk) = rkB; *(LAS u32x4*)(v_ + AT_VS + lv) = rvB; *(LAS u32x4*)(k_ + lr) = rr; } while (0)
    MLA_LOAD(0); MLA_WRITE(0);
    __syncthreads();
    float m_ref = 0.f, l_run = 0.f; bool init = false; f32x16 o[2], negm; const float zz0 = zero_op();
#pragma unroll
    for (int i = 0; i < 16; ++i) { o[0][i] = zz0; o[1][i] = zz0; negm[i] = zz0; }
    for (int s = 0; s < NS; ++s) {
        const int bf = s & 1;
        if (s + 1 < NS) MLA_LOAD(s + 1);
#pragma unroll
        for (int u2 = 0; u2 < 2; ++u2) {
            if (2 * s + u2 <= cw) {
                f32x16 p0, p1;
                LAS const unsigned char* kb = L + (bf * 2 + u2) * AT_KS + r32 * 208 + hi * 16;
#pragma unroll
                for (int s6 = 0; s6 < 6; ++s6) { const bf16x8 a0 = *(LAS const bf16x8*)(kb + 32 * s6), a1 = *(LAS const bf16x8*)(kb + 32 * 208 + 32 * s6); p0 = mfma32(a0, qf[s6], s6 == 0 ? negm : p0); p1 = mfma32(a1, qf[s6], s6 == 0 ? negm : p1); }
                asm volatile("s_nop 15\n\ts_nop 7" : "+v"(p0), "+v"(p1));
                const float mx = rowmax32(p0, p1);
                if (!init || __any(mx > 8.0f)) raise_ref(p0, p1, o, negm, m_ref, l_run, init, mx, lane);
                float ls0 = 0.f, one = 1.0f; asm volatile("" : "+v"(one));
#pragma unroll
                for (int i = 0; i < 16; ++i) { p0[i] = __builtin_amdgcn_exp2f(p0[i]); p1[i] = __builtin_amdgcn_exp2f(p1[i]); ls0 = __builtin_fmaf(p0[i], one, ls0); ls0 = __builtin_fmaf(p1[i], one, ls0); }
                l_run += ls0;
                LAS const unsigned char* vs = L + MK + (bf * 2 + u2) * AT_VS;
                pv_block<0>(o, p0, vs, lane); pv_block<1>(o, p1, vs, lane);
            }
        }
        if (s + 1 < NS) MLA_WRITE(bf ^ 1);
        __syncthreads();
    }
#undef MLA_LOAD
#undef MLA_WRITE
    const float lt = l_run + shx(l_run, 32, lane);
#ifdef DBG_ZERO_MLA
    store_ot(OUT + row * 384 + h * 64, o, zz0, hi);
#else
    store_ot(OUT + row * 384 + h * 64, o, 1.0f / lt, hi);
#endif
}

DI void sb_unit(Frame& F, int b, int h, int qb) {
    const bf16_t* PROJ = (const bf16_t*)(F.ws + opq(WS_PROJ)); bf16_t* OUT = (bf16_t*)(F.ws + opq(WS_OSB));
    const int tid = F.tid, lane = F.lane, r32 = lane & 31, hi = lane >> 5, w = F.wave;
    const int qw = qb * 256 + 32 * w, qg = qw + r32; const size_t row = (size_t)b * SEQ + qg;
    bf16x8 qf[4];
    { const bf16_t* qp = PROJ + row * NPROJ + C_SBQ + h * 64 + 8 * hi;
#pragma unroll
      for (int s = 0; s < 4; ++s) qf[s] = *(const bf16x8*)(qp + 16 * s); }
    const int t_hi = 4 * qb + 3, cw = 4 * qb + (w >> 1);
    const int kr = tid >> 3, c8 = tid & 7;
    const bf16_t* gk = PROJ + ((size_t)b * SEQ + kr) * NPROJ + C_SBK + h * 64 + 8 * c8;
    const bf16_t* gv = PROJ + ((size_t)b * SEQ + kr) * NPROJ + C_SBV + h * 64 + 8 * c8;
    const int lk = kr * 144 + c8 * 16, lv = (c8 >> 2) * 4096 + kr * 64 + (c8 & 3) * 16;
    LAS unsigned char* L = F.lds + RING_OFF;
    volatile LAS unsigned* dflag = F.MISC + 16;
    u32x4 rk, rv;
#define SB_LOAD(t) do { rk = *(const u32x4*)(gk + (size_t)(t) * 64 * NPROJ); rv = *(const u32x4*)(gv + (size_t)(t) * 64 * NPROJ); } while (0)
#define SB_WRITE(bf) do { *(LAS u32x4*)(L + AT_K0 + (bf) * AT_KS + lk) = rk; *(LAS u32x4*)(L + AT_V0 + (bf) * AT_VS + lv) = rv; } while (0)
    SB_LOAD(t_hi); SB_WRITE(0);
    __syncthreads();
    float carry = 0.f; bool done = false; f32x16 o[2]; const float zz0 = zero_op();
#pragma unroll
    for (int i = 0; i < 16; ++i) { o[0][i] = zz0; o[1][i] = zz0; }
    int kt = t_hi;
    for (int it = 0;; ++it, --kt) {
        const int bf = it & 1;
        if (kt > 0) SB_LOAD(kt - 1);
        if (kt <= cw && !done) {
            f32x16 z[2];
#pragma unroll
            for (int i = 0; i < 16; ++i) { z[0][i] = zz0; z[1][i] = zz0; }
            LAS const unsigned char* kb = L + AT_K0 + bf * AT_KS + r32 * 144 + hi * 16;
#pragma unroll
            for (int s = 0; s < 4; ++s) { const bf16x8 a0 = *(LAS const bf16x8*)(kb + 32 * s), a1 = *(LAS const bf16x8*)(kb + 32 * 144 + 32 * s); z[0] = mfma32(a0, qf[s], z[0]); z[1] = mfma32(a1, qf[s], z[1]); }
            const int kbase = 64 * kt;
            float own[8];
#pragma unroll
            for (int kb2 = 0; kb2 < 2; ++kb2)
#pragma unroll
                for (int g = 0; g < 4; ++g) {
                    float lsv[4];
#pragma unroll
                    for (int j = 0; j < 4; ++j) { const int i = 4 * g + j; const float zz = z[kb2][i] * 0.125f; const int key = kbase + 32 * kb2 + crow(i, hi);
                        const float sp = fmaxf(zz, 0.f) + 0.6931471805599453f * __builtin_amdgcn_logf(1.0f + __builtin_amdgcn_exp2f(-1.4426950408889634f * fabsf(zz)));
                        const bool valid = key < qg; lsv[j] = valid ? -sp : 0.f; z[kb2][i] = valid ? (zz - sp) : -INFINITY; }
                    const float e2 = lsv[3], e1 = e2 + lsv[2], e0 = e1 + lsv[1];
                    z[kb2][4 * g + 2] += e2; z[kb2][4 * g + 1] += e1; z[kb2][4 * g + 0] += e0;
                    own[4 * kb2 + g] = e0 + lsv[0];
                }
            float par[8];
#pragma unroll
            for (int g = 0; g < 8; ++g) par[g] = shx(own[g], 32, lane);
            float so = 0.f, sp_ = 0.f;
#pragma unroll
            for (int g = 7; g >= 0; --g) {
                const float off = carry + so + (hi ? sp_ : sp_ + par[g]);
#pragma unroll
                for (int j = 0; j < 4; ++j) { const int kb2 = g >> 2, i = 4 * (g & 3) + j; z[kb2][i] = __builtin_amdgcn_exp2f(1.4426950408889634f * (z[kb2][i] + off)); }
                so += own[g]; sp_ += par[g];
            }
            carry += hi ? (sp_ + so) : (so + sp_);
            LAS const unsigned char* vs = L + AT_V0 + bf * AT_VS;
            pv_block<0>(o, z[0], vs, lane); pv_block<1>(o, z[1], vs, lane);
            done = __all(carry < -104.0f);
        }
        if (lane == 0) dflag[bf * 8 + w] = (done || kt == 0) ? 1u : 0u;
        if (kt > 0) SB_WRITE(bf ^ 1);
        __syncthreads();
        if (kt == 0) break;
        bool alld = true;
#pragma unroll
        for (int i = 0; i < 8; ++i) alld = alld && (dflag[bf * 8 + i] != 0u);
        if (alld) break;
    }
#undef SB_LOAD
#undef SB_WRITE
#ifdef DBG_ZERO_SB
    store_ot(OUT + row * 384 + h * 64, o, zz0, hi);
#else
    store_ot(OUT + row * 384 + h * 64, o, 1.0f, hi);
#endif
}
constexpr int DS_HIST = 0, DS_BITS = 65536, DS_VST = 98304, DS_NB = 512, DS_CAP = 256, DS_TOPK = 256;
constexpr int DM_ABOVE = 160, DM_CNT = 192;
constexpr int DL_INV = DS_VST, DL_OFF = DS_VST + 3 * 128, DL_BIN = DS_VST + 6 * 128;

DI int ds_bin(float s, float inv, float off) { const float t = __builtin_fmaf(s, inv, off); return (int)__builtin_amdgcn_fmed3f(t, 0.f, (float)(DS_NB - 1)); }

DI void ds_scores(float (&sc)[16], const bf16x8 k0, const bf16x8 k1, const bf16x8 (&qt)[2], const bf16x8 (&qi)[8][2], const float (&wh)[8], float zz0) {
    f32x16 z;
#pragma unroll
    for (int i = 0; i < 16; ++i) z[i] = zz0;
    f32x16 lin = mfma32(k0, qt[0], z); lin = mfma32(k1, qt[1], lin);
    f32x16 cur = mfma32(k0, qi[0][0], z); cur = mfma32(k1, qi[0][1], cur);
#pragma unroll
    for (int i = 0; i < 16; ++i) sc[i] = lin[i];
    __builtin_amdgcn_sched_barrier(0);
#pragma unroll
    for (int h = 0; h < 8; ++h) {
        f32x16 nxt = cur;
        if (h < 7) { nxt = mfma32(k0, qi[h + 1][0], z); nxt = mfma32(k1, qi[h + 1][1], nxt); }
#pragma unroll
        for (int i = 0; i < 16; ++i) sc[i] = __builtin_fmaf(wh[h], __builtin_fabsf(cur[i]), sc[i]);
        cur = nxt;
        __builtin_amdgcn_sched_barrier(0);
    }
    asm volatile("" : "+v"(sc[0]), "+v"(sc[1]), "+v"(sc[2]), "+v"(sc[3]), "+v"(sc[4]), "+v"(sc[5]), "+v"(sc[6]), "+v"(sc[7]));
    asm volatile("" : "+v"(sc[8]), "+v"(sc[9]), "+v"(sc[10]), "+v"(sc[11]), "+v"(sc[12]), "+v"(sc[13]), "+v"(sc[14]), "+v"(sc[15]));
}

DI void dsa_select_unit(Frame& F, int b, int qt_, int l) {
    const bf16_t* PROJ = (const bf16_t*)(F.ws + opq(WS_PROJ)); const bf16_t* IK = (const bf16_t*)(F.ws + opq(WS_IK));
    const float* IW = (const float*)(F.ws + opq(WS_IW));
    const float* C16 = (const float*)(F.ws + opq(WS_ROPE16)); const float* S16 = C16 + (size_t)T * 16;
    const int tid = F.tid, lane = F.lane, r32 = lane & 31, hi = lane >> 5, w = F.wave;
    const int q0 = qt_ * 32, chunk = q0 >> 6, NK = 64 * (chunk + 1), nblk = NK >> 5;
    const size_t row = (size_t)b * SEQ + q0 + r32, krow0 = (size_t)b * SEQ;
    LAS unsigned char* L = F.lds + RING_OFF;
    LAS unsigned* HIST = (LAS unsigned*)(L + DS_HIST); LAS unsigned* BITS = (LAS unsigned*)(L + DS_BITS);
    volatile LAS unsigned* M = F.MISC;
    const float zz0 = zero_op();
    { unsigned z0 = 0u; asm volatile("" : "+v"(z0));
      for (int i = tid; i < (DS_BITS + 32768) / 16; i += NTHR) *(LAS u32x4*)(L + i * 16) = (u32x4){z0, z0, z0, z0}; }
    if (NK <= DS_TOPK) {
        __syncthreads();
        for (int i = tid; i < nblk * 32; i += NTHR) BITS[i] = 0xFFFFFFFFu;
        __syncthreads();
    } else {
        bf16x8 qi[8][2], qt[2]; float wh[8];
        float B = 0.f;
        { const bf16_t* qp = PROJ + row * NPROJ + C_IQ + 8 * hi;
          Rope8 rp; rope_load(rp, C16 + row * 16 + 8 * hi, S16 + row * 16 + 8 * hi);
          const f32x4 w0 = *(const f32x4*)(IW + row * 8), w1 = *(const f32x4*)(IW + row * 8 + 4);
          wh[0] = 0.5f * w0[0]; wh[1] = 0.5f * w0[1]; wh[2] = 0.5f * w0[2]; wh[3] = 0.5f * w0[3]; wh[4] = 0.5f * w1[0]; wh[5] = 0.5f * w1[1]; wh[6] = 0.5f * w1[2]; wh[7] = 0.5f * w1[3];
          float ql[2][8];
#pragma unroll
          for (int s = 0; s < 2; ++s)
#pragma unroll
              for (int j = 0; j < 8; ++j) ql[s][j] = zz0;
#pragma unroll
          for (int h = 0; h < 8; ++h) { qi[h][0] = *(const bf16x8*)(qp + 32 * h); qi[h][1] = *(const bf16x8*)(qp + 32 * h + 16); }
          __builtin_amdgcn_sched_barrier(0);
#pragma unroll
          for (int h = 0; h < 8; ++h) {
              rope_apply(qi[h][0], qi[h][1], rp, 1.0f);
              float n2 = 0.f;
#pragma unroll
              for (int s = 0; s < 2; ++s)
#pragma unroll
                  for (int j = 0; j < 8; ++j) { const float v = bf2f((unsigned short)qi[h][s][j]); n2 = __builtin_fmaf(v, v, n2); ql[s][j] = __builtin_fmaf(wh[h], v, ql[s][j]); }
              n2 += shx(n2, 32, lane); B += 2.0f * fabsf(wh[h]) * sqrtf(n2);
              __builtin_amdgcn_sched_barrier(0); }
#pragma unroll
          for (int s = 0; s < 2; ++s) { u32x4 p; p.x = pk2(ql[s][0], ql[s][1]); p.y = pk2(ql[s][2], ql[s][3]); p.z = pk2(ql[s][4], ql[s][5]); p.w = pk2(ql[s][6], ql[s][7]); asm volatile("" : "+v"(p)); qt[s] = __builtin_bit_cast(bf16x8, p); } }
        { const float kmax = sqrtf(__builtin_bit_cast(float, __hip_atomic_load(F.ctl + CW_KMAX + 64 * (l * 2 + b), RLX_AGENT)));
          B = fmaxf(B * kmax * 1.03f, 1e-20f);
          if (w == 0 && hi == 0) { ((LAS float*)(L + DL_INV))[r32] = 1024.0f / B; ((LAS float*)(L + DL_OFF))[r32] = 256.0f; M[DM_ABOVE + r32] = 0u; } }
        __syncthreads();
        const bf16_t* kbase = IK + (krow0 + r32) * 32 + 8 * hi;
#define DS_LOADK(K0_, K1_, kb_) do { const bf16_t* kp_ = kbase + (size_t)(kb_) * 32 * 32; K0_ = *(const bf16x8*)kp_; K1_ = *(const bf16x8*)(kp_ + 16); } while (0)
        int lev = 0;
        for (;;) {
            float pinv[3], poff[3]; int pbin[3];
#pragma unroll
            for (int v = 0; v < 3; ++v) { pinv[v] = ((LAS float*)(L + DL_INV))[v * 32 + r32]; poff[v] = ((LAS float*)(L + DL_OFF))[v * 32 + r32]; pbin[v] = ((LAS int*)(L + DL_BIN))[v * 32 + r32]; }
#ifdef DBG_REP_S1
            for (int rep_ = 0; rep_ < 2; ++rep_)
#endif
            {
#ifdef DBG_REP_S1
                if (rep_) { __syncthreads(); unsigned z0 = 0u; asm volatile("" : "+v"(z0)); for (int i = tid; i < 65536 / 16; i += NTHR) *(LAS u32x4*)(L + DS_HIST + i * 16) = (u32x4){z0, z0, z0, z0}; __syncthreads(); }
#endif
                bf16x8 c0, c1, n0, n1; c0 = c1 = n0 = n1 = qt[0];
                if (w < nblk) DS_LOADK(c0, c1, w);
                if (lev == 0) {
                    const float inv0 = pinv[0], off0 = poff[0];
                    for (int kb = w; kb < nblk; kb += NWAVES) {
                        if (kb + NWAVES < nblk) DS_LOADK(n0, n1, kb + NWAVES);
                        float sc[16]; ds_scores(sc, c0, c1, qt, qi, wh, zz0);
#pragma unroll
                        for (int i = 0; i < 16; ++i) { const int bin = ds_bin(sc[i], inv0, off0);
                            __hip_atomic_fetch_add((LAS unsigned*)((LAS unsigned char*)HIST + (bin << 7) + (r32 << 2)), 1u, __ATOMIC_RELAXED, __HIP_MEMORY_SCOPE_WORKGROUP); }
                        c0 = n0; c1 = n1;
                    }
                } else {
                    for (int kb = w; kb < nblk; kb += NWAVES) {
                        if (kb + NWAVES < nblk) DS_LOADK(n0, n1, kb + NWAVES);
                        float sc[16]; ds_scores(sc, c0, c1, qt, qi, wh, zz0);
#pragma unroll
                        for (int i = 0; i < 16; ++i) { int bin = ds_bin(sc[i], pinv[0], poff[0]); bool in = (bin == pbin[0]); bin = ds_bin(sc[i], pinv[1], poff[1]);
                            if (lev >= 2) { in = in && (bin == pbin[1]); bin = ds_bin(sc[i], pinv[2], poff[2]); }
                            if (in) __hip_atomic_fetch_add(HIST + bin * 32 + r32, 1u, __ATOMIC_RELAXED, __HIP_MEMORY_SCOPE_WORKGROUP); }
                        c0 = n0; c1 = n1;
                    }
                }
            }
            __syncthreads();
#pragma unroll 1
            for (int sq = 0; sq < 4; ++sq) {
                int lane = F.lane; asm volatile("" : "+v"(lane));
                const int q = 4 * w + sq; unsigned hw[8]; unsigned mysum = 0;
#pragma unroll
                for (int i = 0; i < 8; ++i) { hw[i] = HIST[(8 * lane + i) * 32 + q]; mysum += hw[i]; }
                unsigned suf = mysum;
#pragma unroll
                for (int o = 1; o < 64; o <<= 1) { const unsigned t = (unsigned)__builtin_amdgcn_ds_bpermute(((lane + o) & 63) << 2, (int)suf); if (lane + o < 64) suf += t; }
                const unsigned above0 = M[DM_ABOVE + q]; const unsigned need = DS_TOPK - above0;
                const unsigned long long bal = __ballot(suf >= need);
                const int Ls = 63 - __builtin_clzll(bal | 1ull);
                const unsigned sufL = (unsigned)__builtin_amdgcn_ds_bpermute(Ls << 2, (int)suf), sumL = (unsigned)__builtin_amdgcn_ds_bpermute(Ls << 2, (int)mysum);
                unsigned acc = sufL - sumL; int bstar = 8 * Ls; unsigned cstar = 0;
#pragma unroll
                for (int i = 7; i >= 0; --i) { const unsigned c = (unsigned)__builtin_amdgcn_ds_bpermute(Ls << 2, (int)hw[i]);
                    if (cstar == 0u) { if (acc + c >= need) { bstar = 8 * Ls + i; cstar = c; } else acc += c; } }
                if (lane == 0) { ((LAS int*)(L + DL_BIN))[lev * 32 + q] = bstar; M[DM_ABOVE + q] = above0 + acc; M[DM_CNT + q] = cstar; }
            }
            __syncthreads();
            unsigned mxc = 0;
#pragma unroll 1
            for (int q = 0; q < 32; ++q) { const unsigned c = M[DM_CNT + q]; mxc = c > mxc ? c : mxc; }
            if (mxc <= (unsigned)DS_CAP || lev == 2) break;
            if (w == 0 && hi == 0) { const float pinv_ = ((LAS float*)(L + DL_INV))[lev * 32 + r32], poff_ = ((LAS float*)(L + DL_OFF))[lev * 32 + r32]; const int pb_ = ((LAS int*)(L + DL_BIN))[lev * 32 + r32];
                ((LAS float*)(L + DL_INV))[(lev + 1) * 32 + r32] = pinv_ * 511.5f; ((LAS float*)(L + DL_OFF))[(lev + 1) * 32 + r32] = (poff_ - (float)pb_) * 511.5f; }
            { unsigned z0 = 0u; asm volatile("" : "+v"(z0));
              for (int i = tid; i < 65536 / 16; i += NTHR) *(LAS u32x4*)(L + DS_HIST + i * 16) = (u32x4){z0, z0, z0, z0}; }
            ++lev;
            __syncthreads();
        }
        __syncthreads();
        if (tid < 32) M[DM_CNT + tid] = 0u;
        __syncthreads();
        {
            float pinv[3], poff[3]; int pbin[3];
#pragma unroll
            for (int v = 0; v < 3; ++v) { pinv[v] = ((LAS float*)(L + DL_INV))[v * 32 + r32]; poff[v] = ((LAS float*)(L + DL_OFF))[v * 32 + r32]; pbin[v] = ((LAS int*)(L + DL_BIN))[v * 32 + r32]; }
            LAS unsigned long long* CAND = (LAS unsigned long long*)(L + DS_HIST);
#define DS_SELBLK(K0_, K1_, kb_) do { float sc[16]; ds_scores(sc, K0_, K1_, qt, qi, wh, zz0); \
            unsigned word = 0u; const unsigned kinv = 0xFFFFu - (unsigned)((kb_) * 32 + 4 * hi); \
            _Pragma("unroll") for (int i = 0; i < 16; ++i) { \
                int bin = ds_bin(sc[i], pinv[0], poff[0]); bool sel = bin > pbin[0], eq = bin == pbin[0]; \
                if (lev >= 1) { bin = ds_bin(sc[i], pinv[1], poff[1]); sel = sel || (eq && bin > pbin[1]); eq = eq && bin == pbin[1]; } \
                if (lev >= 2) { bin = ds_bin(sc[i], pinv[2], poff[2]); sel = sel || (eq && bin > pbin[2]); eq = eq && bin == pbin[2]; } \
                if (sel) word |= 1u << crow(i, 0); \
                if (eq) { const unsigned slot = __hip_atomic_fetch_add((LAS unsigned*)(M + DM_CNT + r32), 1u, __ATOMIC_RELAXED, __HIP_MEMORY_SCOPE_WORKGROUP); \
                    if (slot < (unsigned)DS_CAP) CAND[r32 * DS_CAP + slot] = ((unsigned long long)f_sortable(sc[i]) << 32) | (unsigned)(kinv - (unsigned)crow(i, 0)); } } \
            word <<= 4 * hi; \
            if (word) __hip_atomic_fetch_or(BITS + (kb_) * 32 + r32, word, __ATOMIC_RELAXED, __HIP_MEMORY_SCOPE_WORKGROUP); } while (0)
#ifdef DBG_REP_S2
            for (int rep_ = 0; rep_ < 2; ++rep_)
#endif
            {
#ifdef DBG_REP_S2
                if (rep_) { __syncthreads(); if (tid < 32) M[DM_CNT + tid] = 0u; __syncthreads(); }
#endif
                bf16x8 c0, c1, n0, n1; c0 = c1 = n0 = n1 = qt[0];
                if (w < nblk) DS_LOADK(c0, c1, w);
                if (lev == 0) {
                    const float inv0 = pinv[0], off0 = poff[0];
                    const float T1 = pbin[0] >= DS_NB - 1 ? INFINITY : (float)(pbin[0] + 1), T0 = pbin[0] <= 0 ? -INFINITY : (float)pbin[0];
                    for (int kb = w; kb < nblk; kb += NWAVES) {
                        if (kb + NWAVES < nblk) DS_LOADK(n0, n1, kb + NWAVES);
                        float sc[16]; ds_scores(sc, c0, c1, qt, qi, wh, zz0);
                        unsigned cb = 0u; const unsigned kinv = 0xFFFFu - (unsigned)(kb * 32 + 4 * hi);
#pragma unroll
                        for (int i = 15; i >= 0; --i) { const float t = __builtin_fmaf(sc[i], inv0, off0); const bool sel = t >= T1, eq = (t >= T0) && !sel;
                            cb = cb * 2u + (sel ? 1u : 0u);
                            if (eq) { const unsigned slot = __hip_atomic_fetch_add((LAS unsigned*)(M + DM_CNT + r32), 1u, __ATOMIC_RELAXED, __HIP_MEMORY_SCOPE_WORKGROUP);
                                if (slot < (unsigned)DS_CAP) CAND[r32 * DS_CAP + slot] = ((unsigned long long)f_sortable(sc[i]) << 32) | (unsigned)(kinv - (unsigned)crow(i, 0)); } }
                        unsigned word = (cb & 0xFu) | ((cb & 0xF0u) << 4) | ((cb & 0xF00u) << 8) | ((cb & 0xF000u) << 12);
                        word <<= 4 * hi;
                        if (word) __hip_atomic_fetch_or(BITS + kb * 32 + r32, word, __ATOMIC_RELAXED, __HIP_MEMORY_SCOPE_WORKGROUP);
                        c0 = n0; c1 = n1;
                    }
                } else
                for (int kb = w; kb < nblk; kb += NWAVES) {
                    if (kb + NWAVES < nblk) DS_LOADK(n0, n1, kb + NWAVES);
                    DS_SELBLK(c0, c1, kb);
                    c0 = n0; c1 = n1;
                }
            }
#undef DS_SELBLK
            __syncthreads();
#ifdef DBG_REP_RES
            for (int rep_ = 0; rep_ < 2; ++rep_)
#endif
#pragma unroll 1
            for (int sq = 0; sq < 4; ++sq) {
                int lane = F.lane; asm volatile("" : "+v"(lane));
                const int q = 4 * w + sq; unsigned cnt = M[DM_CNT + q]; cnt = cnt < (unsigned)DS_CAP ? cnt : (unsigned)DS_CAP;
                const unsigned need = DS_TOPK - M[DM_ABOVE + q];
                const unsigned cnt4 = cnt & ~3u;
                for (unsigned i = lane; i < cnt; i += 64) { const unsigned long long ki = CAND[q * DS_CAP + i]; unsigned rank = 0; unsigned j = 0;
                    for (; j < cnt4; j += 4) { const unsigned long long x0 = CAND[q * DS_CAP + j], x1 = CAND[q * DS_CAP + j + 1], x2 = CAND[q * DS_CAP + j + 2], x3 = CAND[q * DS_CAP + j + 3];
                        rank += (x0 > ki ? 1u : 0u) + (x1 > ki ? 1u : 0u) + (x2 > ki ? 1u : 0u) + (x3 > ki ? 1u : 0u); }
                    for (; j < cnt; ++j) rank += (CAND[q * DS_CAP + j] > ki) ? 1u : 0u;
                    if (rank < need) { const unsigned key = 0xFFFFu - (unsigned)(ki & 0xFFFFull); __hip_atomic_fetch_or(BITS + (key >> 5) * 32 + q, 1u << (key & 31), __ATOMIC_RELAXED, __HIP_MEMORY_SCOPE_WORKGROUP); } }
            }
            __syncthreads();
        }
#undef DS_LOADK
    }
    {
        unsigned* BM = (unsigned*)(F.ws + opq(WS_BM)) + (size_t)b * 256 * SEQ + q0;
        for (int i = tid; i < nblk * 32; i += NTHR) __hip_atomic_store(BM + (size_t)(i >> 5) * SEQ + (i & 31), BITS[i], RLX_AGENT);
        asm volatile("s_waitcnt vmcnt(0)" ::: "memory");
        __syncthreads();
        if (tid == 0) __hip_atomic_store(F.ctl + CW_SELF + b * 256 + qt_, (unsigned)(l + 1), RLX_AGENT);
    }
}

DI void dsa_attn_unit(Frame& F, int b, int hd, int qb, int l) {
    const bf16_t* PROJ = (const bf16_t*)(F.ws + opq(WS_PROJ)); const bf16_t* DK = (const bf16_t*)(F.ws + opq(WS_DK)); bf16_t* OUT = (bf16_t*)(F.ws + opq(WS_ODSA));
    const float* C32 = (const float*)(F.ws + opq(WS_ROPE32)); const float* S32 = C32 + (size_t)T * 32;
    const int tid = F.tid, lane = F.lane, r32 = lane & 31, hi = lane >> 5, w = F.wave;
    const int qw = qb * 256 + 32 * w; const size_t row = (size_t)b * SEQ + qw + r32;
    if (w == 0) { unsigned sp = 0;
        for (;;) { const unsigned fv = lane < 8 ? __hip_atomic_load(F.ctl + CW_SELF + b * 256 + 8 * qb + lane, RLX_AGENT) : (unsigned)(l + 1);
            if (__all(fv == (unsigned)(l + 1)) || ++sp > (1u << 22)) break; __builtin_amdgcn_s_sleep(2); }
        __builtin_amdgcn_fence(__ATOMIC_ACQUIRE, "agent"); }
    asm volatile("s_waitcnt vmcnt(0)" ::: "memory");
    __syncthreads();
    constexpr float QS = 0.125f * 1.4426950408889634f;
    bf16x8 qf[4];
    { const bf16_t* qp = PROJ + row * NPROJ + C_DQ + hd * 64 + 8 * hi;
#pragma unroll
      for (int s = 0; s < 4; ++s) qf[s] = *(const bf16x8*)(qp + 16 * s);
      rope8(qf[0], qf[2], C32 + row * 32 + 8 * hi, S32 + row * 32 + 8 * hi, QS); rope8(qf[1], qf[3], C32 + row * 32 + 16 + 8 * hi, S32 + row * 32 + 16 + 8 * hi, QS); }
    const int NT = 4 * (qb + 1), cw = 4 * qb + (w >> 1);
    const int kr = tid >> 3, c8 = tid & 7;
    const bf16_t* gk = DK + ((size_t)b * SEQ + kr) * 256 + hd * 64 + 8 * c8;
    const bf16_t* gv = PROJ + ((size_t)b * SEQ + kr) * NPROJ + C_DV + hd * 64 + 8 * c8;
    const unsigned* bm = (const unsigned*)(F.ws + opq(WS_BM)) + (size_t)b * 256 * SEQ + qw + r32;
    const int lk = kr * 144 + c8 * 16, lv = (c8 >> 2) * 4096 + kr * 64 + (c8 & 3) * 16;
    LAS unsigned char* L = F.lds + RING_OFF;
    constexpr int MK = 4 * AT_KS;
    u32x4 rkA, rvA, rkB, rvB; unsigned nA0, nA1, nB0, nB1;
#define DA_LOAD(t) do { rkA = *(const u32x4*)(gk + (size_t)(t) * 64 * 256); rvA = *(const u32x4*)(gv + (size_t)(t) * 64 * NPROJ); \
        rkB = *(const u32x4*)(gk + (size_t)((t) + 1) * 64 * 256); rvB = *(const u32x4*)(gv + (size_t)((t) + 1) * 64 * NPROJ); \
        nA0 = __hip_atomic_load(bm + (size_t)(2 * (t)) * SEQ, RLX_AGENT); nA1 = __hip_atomic_load(bm + (size_t)(2 * (t) + 1) * SEQ, RLX_AGENT); \
        nB0 = __hip_atomic_load(bm + (size_t)(2 * (t) + 2) * SEQ, RLX_AGENT); nB1 = __hip_atomic_load(bm + (size_t)(2 * (t) + 3) * SEQ, RLX_AGENT); } while (0)
#define DA_WRITE(bf) do { LAS unsigned char* k_ = L + (bf) * 2 * AT_KS; LAS unsigned char* v_ = L + MK + (bf) * 2 * AT_VS; \
        *(LAS u32x4*)(k_ + lk) = rkA; *(LAS u32x4*)(v_ + lv) = rvA; *(LAS u32x4*)(k_ + AT_KS + lk) = rkB; *(LAS u32x4*)(v_ + AT_VS + lv) = rvB; } while (0)
    DA_LOAD(0); DA_WRITE(0);
    unsigned cA0 = nA0, cA1 = nA1, cB0 = nB0, cB1 = nB1;
    __syncthreads();
    float m_ref = 0.f, l_run = 0.f; bool init = false; f32x16 o[2], negm; const float zz0 = zero_op();
#pragma unroll
    for (int i = 0; i < 16; ++i) { o[0][i] = zz0; o[1][i] = zz0; negm[i] = zz0; }
    for (int t = 0; t < NT; t += 2) {
        const int bf = (t >> 1) & 1;
        if (t + 2 < NT) DA_LOAD(t + 2);
#pragma unroll
        for (int u2 = 0; u2 < 2; ++u2) {
        if (t + u2 <= cw) {
            const unsigned wd0 = (u2 ? cB0 : cA0) >> (4 * hi), wd1 = (u2 ? cB1 : cA1) >> (4 * hi);
            f32x16 p0, p1;
            LAS const unsigned char* kb = L + (bf * 2 + u2) * AT_KS + r32 * 144 + hi * 16;
#pragma unroll
            for (int s = 0; s < 4; ++s) { const bf16x8 a0 = *(LAS const bf16x8*)(kb + 32 * s), a1 = *(LAS const bf16x8*)(kb + 32 * 144 + 32 * s); p0 = mfma32(a0, qf[s], s == 0 ? negm : p0); p1 = mfma32(a1, qf[s], s == 0 ? negm : p1); }
            asm volatile("s_nop 15\n\ts_nop 7" : "+v"(p0), "+v"(p1));
            const float mx = rowmax32(p0, p1);
            if (!init || __any(mx > 8.0f)) raise_ref(p0, p1, o, negm, m_ref, l_run, init, mx, lane);
            float ls0 = 0.f, one = 1.0f; asm volatile("" : "+v"(one));
#define DA_E(i) do { p0[i] = mask_bit<((i) & 3) + 8 * ((i) >> 2)>(__builtin_amdgcn_exp2f(p0[i]), wd0); p1[i] = mask_bit<((i) & 3) + 8 * ((i) >> 2)>(__builtin_amdgcn_exp2f(p1[i]), wd1); ls0 = __builtin_fmaf(p0[i], one, ls0); ls0 = __builtin_fmaf(p1[i], one, ls0); } while (0)
            DA_E(0); DA_E(1); DA_E(2); DA_E(3); DA_E(4); DA_E(5); DA_E(6); DA_E(7); DA_E(8); DA_E(9); DA_E(10); DA_E(11); DA_E(12); DA_E(13); DA_E(14); DA_E(15);
#undef DA_E
            l_run += ls0;
            LAS const unsigned char* vs = L + MK + (bf * 2 + u2) * AT_VS;
            pv_block<0>(o, p0, vs, lane); pv_block<1>(o, p1, vs, lane);
        }
        }
        if (t + 2 < NT) { DA_WRITE(bf ^ 1); cA0 = nA0; cA1 = nA1; cB0 = nB0; cB1 = nB1; }
        __syncthreads();
    }
#undef DA_LOAD
#undef DA_WRITE
    const float lt = l_run + shx(l_run, 32, lane);
    store_ot(OUT + row * 256 + hd * 64, o, 1.0f / lt, hi);
}
constexpr int N_SEL = T / 32, N_MLA = BATCH * 6 * 32, N_DSAA = BATCH * 4 * 32, N_SB = BATCH * 6 * 32, N_ATT = N_SEL + N_MLA + N_DSAA + N_SB;
DI void p_attention(Frame& F, ArgsP a, int l, int qslot) {
    for (;;) {
        __syncthreads();
        if (F.tid == 0) F.MISC[12] = __hip_atomic_fetch_add(F.ctl + CW_QATT + 64 * qslot, 1u, RLX_AGENT);
        __syncthreads();
        int u = (int)F.MISC[12];
        if (u >= N_ATT + N_CVT) break;
        { int t_ = threadIdx.x; asm volatile("" : "+v"(t_)); F.tid = t_; F.lane = t_ & 63; }
        if (u < 3 * N_CVT) { const int q3 = u / 3; if (u - 3 * q3 == 2) { cvt_unit(F, a, l, q3); continue; } u -= q3; } else u -= N_CVT;
        if (u < N_SEL) { const int qt = 255 - u / 2, b = u & 1; dsa_select_unit(F, b, qt, l); }
        else if (u < N_SEL + N_MLA + N_DSAA) {
            const int v = u - N_SEL, qb = 31 - v / 20, r = v % 20;
            if (r < 8) dsa_attn_unit(F, r / 4, r % 4, qb, l); else mla_unit(F, (r - 8) / 6, (r - 8) % 6, qb);
        }
        else { const int v = u - N_SEL - N_MLA - N_DSAA; const int qb = 31 - v / 12, bh = v % 12; sb_unit(F, bh / 6, bh % 6, qb); }
    }
}

constexpr int PH_PER_LAYER = 10, N_PHASES = 2 + DEPTH * PH_PER_LAYER;
__global__ void __launch_bounds__(NTHR, 2) mk_fwd(Args a_unused) {
    ArgsP a = (ArgsP)__builtin_amdgcn_kernarg_segment_ptr();
    extern __shared__ __attribute__((aligned(16))) unsigned char lds_raw[];
    Frame F;
    F.lds = (LAS unsigned char*)lds_raw; F.MISC = (volatile LAS unsigned*)(F.lds + MISC_OFF);
    F.tid = threadIdx.x; F.lane = F.tid & 63; F.wave = __builtin_amdgcn_readfirstlane(F.tid >> 6);
    F.G = gridDim.x; F.bx = blockIdx.x; F.gw = blockIdx.x * NWAVES + F.wave; F.NGW = F.G * NWAVES; F.ws = (unsigned char*)a->ws; F.ctl = (gu32*)((unsigned char*)a->ws + WS_CTL);
    for (int u = F.tid; u < 256; u += NTHR) F.MISC[u] = 0u;
    __syncthreads();
    const int lo = a->ph_lo, hi = a->ph_hi;
    const bool one = (hi - lo) > 1;
    XcdBarrier bar; bar.bar = (unsigned*)(F.ctl + CW_BAR); bar.x = 0; bar.st = nullptr;
    if (one) bar = xcd_barrier_post((unsigned*)(F.ctl + CW_BAR), F.MISC + 8);
#define IN(k) (lo <= (k) && (k) < hi)
#define XN ((bf16_t*)(F.ws + opq(WS_XN)))
#define PROJ ((bf16_t*)(F.ws + opq(WS_PROJ)))
#define REFRESH() do { int t_ = threadIdx.x; asm volatile("" : "+v"(t_)); F.tid = t_; F.lane = t_ & 63; size_t z_ = 0; asm volatile("" : "+s"(z_)); a = (ArgsP)__builtin_amdgcn_kernarg_segment_ptr(); asm volatile("" : "+s"(a)); F.ws = (unsigned char*)a->ws + z_; F.ctl = (gu32*)(F.ws + opq(WS_CTL)); { LAS unsigned char* l_ = (LAS unsigned char*)lds_raw; asm volatile("" : "+s"(l_)); F.lds = l_; F.MISC = (volatile LAS unsigned*)(l_ + MISC_OFF); } \
    int b_ = blockIdx.x; asm volatile("" : "+s"(b_)); F.bx = b_; F.gw = b_ * NWAVES + F.wave; } while (0)
#ifdef DBG_DOUBLE_BAR
#define SEAM(k) do { if (IN(k) && IN((k) + 1)) { XcdBarrier b2_ = bar; size_t z_ = 0; asm volatile("" : "+s"(z_)); b2_.bar = (unsigned*)((unsigned char*)a->ws + z_ + WS_CTL) + CW_BAR; xcd_barrier(b2_); xcd_barrier(b2_); } } while (0)
#else
#define SEAM(k) do { if (IN(k) && IN((k) + 1)) { XcdBarrier b2_ = bar; size_t z_ = 0; asm volatile("" : "+s"(z_)); b2_.bar = (unsigned*)((unsigned char*)a->ws + z_ + WS_CTL) + CW_BAR; xcd_barrier(b2_); } } while (0)
#endif

    if (IN(0)) { REFRESH(); p0_mod(F, a); p0_rope(F, a); p0_convert(F, a); p0_convert_up(F, a);
#ifdef DBG_DOUBLE_P0
        p0_convert(F, a);
#endif
    } SEAM(0);
    if (IN(1)) { REFRESH(); p_norm_first(F, a); } SEAM(1);

    for (int l = 0; l < DEPTH; ++l) {
        const int pb = 2 + l * PH_PER_LAYER;
#ifndef DBG_SKIP_MIXER
        if (IN(pb + 0)) { REFRESH();
#ifdef DBG_REP_GIN
            for (int rep_ = 0; rep_ < 2; ++rep_) {
#else
            {
#endif

            pg8::DenseSched S; S.init(XN, (const bf16_t*)(F.ws + opq(WS_WIN)) + (size_t)l * NPROJ * DM, T, NPROJ, DM, F.G, F.bx);
            pg8::EpiStore E{PROJ, NPROJ};
            pg8::gemm_phase<pg8::EpiStore, pg8::DenseSched, true>(F.lds + RING_OFF, S, E);
                    }
        } SEAM(pb + 0);
        if (IN(pb + 2)) { REFRESH();
            p_post1(F, a, l);
            LAS float* tabq = (LAS float*)(F.lds + MISC_OFF + 1024); LAS float* tabkv = tabq + 256;
            { pg8::DenseSched S; S.init(PROJ + C_CQ, (const bf16_t*)(F.ws + opq(WS_WUQ)) + (size_t)l * 768 * 256, T, 768, 256, F.G, F.bx, NPROJ);
              pg8::Unit u0; if (S.next(0, u0)) rs_table<256>(F, PROJ + (size_t)u0.pm * 256 * NPROJ + C_CQ, tabq);
              __syncthreads();
              pg8::EpiStoreRS E{(bf16_t*)(F.ws + opq(WS_QM)), 768, tabq}; pg8::gemm_phase<pg8::EpiStoreRS, pg8::DenseSched, false>(F.lds + RING_OFF, S, E); }
            REFRESH();
            { pg8::DenseSched S; S.init(PROJ + C_CKV, (const bf16_t*)(F.ws + opq(WS_WUKV)) + (size_t)l * 768 * 128, T, 768, 128, F.G, (F.bx + 128) % F.G, NPROJ);
              pg8::Unit u0; if (S.next(0, u0)) rs_table<128>(F, PROJ + (size_t)u0.pm * 256 * NPROJ + C_CKV, tabkv);
              __syncthreads();
              pg8::EpiStoreRS E{(bf16_t*)(F.ws + opq(WS_KVM)), 768, tabkv}; pg8::gemm_phase<pg8::EpiStoreRS, pg8::DenseSched, false>(F.lds + RING_OFF, S, E); }
        } SEAM(pb + 2);
        if (IN(pb + 3)) { REFRESH(); p_attention(F, a, l, l);
#ifdef DBG_DOUBLE_ATT
            p_attention(F, a, l, l + 4);
#endif
        } SEAM(pb + 3);
        if (IN(pb + 4)) { REFRESH();
#ifdef DBG_REP_SMALL
            for (int rep_ = 0; rep_ < 2; ++rep_) {
#else
            {
#endif

            for (int s = 0; s < 3; ++s) {
                const bf16_t* A = (const bf16_t*)(F.ws + (s == 0 ? WS_OSB : s == 1 ? WS_OMLA : WS_ODSA));
                const bf16_t* B = (const bf16_t*)(F.ws + (s == 0 ? WS_WSB : s == 1 ? WS_WMLA : WS_WDSA)) + (size_t)l * DM * (s == 2 ? 256 : 384);
                pg8::DenseSched S; S.init(A, B, T, DM, s == 2 ? 256 : 384, F.G, F.bx);
                pg8::EpiBranch E{(bf16_t*)(F.ws + opq(WS_MRG)), PROJ, C_GATE + s * DM, s == 0};
                pg8::gemm_phase<pg8::EpiBranch, pg8::DenseSched, false>(F.lds + RING_OFF, S, E);
            }
                    }
        } SEAM(pb + 4);
        if (IN(pb + 5)) { REFRESH();
            pg8::DenseSched S; S.init((const bf16_t*)(F.ws + opq(WS_MRG)), (const bf16_t*)(F.ws + opq(WS_WOUT)) + (size_t)l * DM * DM, T, DM, DM, F.G, F.bx);
            pg8::EpiResid E{(float*)(F.ws + opq(WS_X)), (const float*)(F.ws + opq(WS_MOD)) + (size_t)l * 2 * 6 * DM + 2 * DM, 0, l == 0 ? (const float*)a->x : (const float*)(F.ws + opq(WS_X))};
            pg8::gemm_phase<pg8::EpiResid, pg8::DenseSched, false>(F.lds + RING_OFF, S, E);
#ifdef DBG_REP_OUT
            { pg8::EpiResid E2 = E; E2.dofs = (size_t)1600 * MiB; pg8::gemm_phase<pg8::EpiResid, pg8::DenseSched, false>(F.lds + RING_OFF, S, E2); }
#endif
        } SEAM(pb + 5);
#endif
        if (IN(pb + 6)) { REFRESH(); p_norm2_router(F, a, l);
#ifdef DBG_REP_ROUTER
            p_norm2_router(F, a, l, (size_t)1600 * MiB, 64 + l);
#endif
        } SEAM(pb + 6);
#ifndef DBG_SKIP_MOE
        if (IN(pb + 7)) { REFRESH();
#ifdef DBG_REP_MOE
            for (int rep_ = 0; rep_ < 2; ++rep_) {
#else
            {
#endif

            const pg8::MoeTab tb = moe_tables(F, l);
            pg8::MoeSched<true, 8> S{XN, (const bf16_t*)(F.ws + opq(WS_WGU)) + (size_t)l * NEXP * 2048 * DM, (const int*)(F.ws + opq(WS_LIST)), tb, DM, F.G, F.bx, (LAS unsigned*)(F.lds + MISC_OFF + 1024)};
            pg8::EpiSwiglu E{(bf16_t*)(F.ws + opq(WS_ACT)), ((const float*)a->b_gu) + (size_t)l * NEXP * 2048, (LAS float*)(F.lds + MISC_OFF + 3072)};
            pg8::gemm_phase<pg8::EpiSwiglu, pg8::MoeSched<true, 8>, true>(F.lds + RING_OFF, S, E);
                    }
        } SEAM(pb + 7);
        if (IN(pb + 8)) { REFRESH();
#ifdef DBG_REP_MOE
            for (int rep_ = 0; rep_ < 2; ++rep_) {
#else
            {
#endif

            const pg8::MoeTab tb = moe_tables_again(F);
            pg8::MoeSched<false, 4> S{(const bf16_t*)(F.ws + opq(WS_ACT)), (const bf16_t*)(F.ws + opq(WS_WDN)) + (size_t)l * NEXP * DM * DM, nullptr, tb, DM, F.G, F.bx, (LAS unsigned*)(F.lds + MISC_OFF + 1024)};
            pg8::EpiDown E{(bf16_t*)(F.ws + opq(WS_EOUT)), ((const float*)a->b_dn) + (size_t)l * NEXP * DM, (const float*)(F.ws + opq(WS_LISTW)), (LAS float*)(F.lds + MISC_OFF + 3072)};
            pg8::gemm_phase<pg8::EpiDown, pg8::MoeSched<false, 4>, true>(F.lds + RING_OFF, S, E);
                    }
        } SEAM(pb + 8);
#endif
        if (IN(pb + 9)) { REFRESH(); const pg8::MoeTab tb = moe_tables_again(F);
#ifdef DBG_REP_COMBINE
            p_combine(F, a, l, tb, (size_t)1600 * MiB);
#endif
            p_combine(F, a, l, tb); } SEAM(pb + 9);
    }
#undef IN
#undef SEAM
#undef XN
#undef PROJ
}

#ifndef MK_MULTI
#define MK_MULTI 0
#endif
extern "C" void kernel_launch(void* const* d_in, const int* in_sizes, int n_in, void* d_out, int out_size, void* d_ws, size_t ws_size, hipStream_t stream) {
    static int grid = 0;
    if (grid == 0) {
        if (n_in != 23 || in_sizes[0] != T * DM || out_size != T * DM || ws_size < WS_END) { fprintf(stderr, "kernel_launch: unexpected shapes (n_in %d, ws %zu); nothing launched\n", n_in, ws_size); grid = -1; return; }
        int dev = 0, cus = 0, per_cu = 0;
        if (hipGetDevice(&dev) != hipSuccess || hipDeviceGetAttribute(&cus, hipDeviceAttributeMultiprocessorCount, dev) != hipSuccess) { grid = -1; return; }
        if (hipFuncSetAttribute((const void*)mk_fwd, hipFuncAttributeMaxDynamicSharedMemorySize, LDS_BYTES) != hipSuccess) { fprintf(stderr, "kernel_launch: hipFuncSetAttribute failed\n"); grid = -1; return; }
        if (hipOccupancyMaxActiveBlocksPerMultiprocessor(&per_cu, (const void*)mk_fwd, NTHR, LDS_BYTES) != hipSuccess || per_cu < 1) { fprintf(stderr, "kernel_launch: note: occupancy query says %d\n", per_cu); (void)hipGetLastError(); }
        grid = cus;
    }
    if (grid < 0) return;
    if (hipMemsetAsync((char*)d_ws + WS_CTL, 0, CTL_ZERO_BYTES, stream) != hipSuccess) return;
    Args a{};
    a.x = (gcf)d_in[0]; a.c = (gcf)d_in[1]; a.pos = (gci)d_in[2];
    a.ada_w = (gcf)d_in[3]; a.ada_b = (gcf)d_in[4]; a.norm_mix_g = (gcf)d_in[5]; a.w_in = (gcf)d_in[6];
    a.q_norm_g = (gcf)d_in[7]; a.kv_norm_g = (gcf)d_in[8]; a.w_uq = (gcf)d_in[9]; a.w_ukv = (gcf)d_in[10];
    a.w_sb_out = (gcf)d_in[11]; a.w_mla_out = (gcf)d_in[12]; a.w_dsa_out = (gcf)d_in[13]; a.w_out = (gcf)d_in[14];
    a.norm_ffn_g = (gcf)d_in[15]; a.router_w = (gcf)d_in[16]; a.router_b = (gcf)d_in[17];
    a.w_gu = (gcf)d_in[18]; a.b_gu = (gcf)d_in[19]; a.w_dn = (gcf)d_in[20]; a.b_dn = (gcf)d_in[21]; a.final_g = (gcf)d_in[22];
    a.out = (GAS float*)d_out; a.ws = (GAS unsigned char*)d_ws;
#if MK_MULTI
    for (int p = 0; p < N_PHASES; ++p) { a.ph_lo = p; a.ph_hi = p + 1; hipLaunchKernelGGL(mk_fwd, dim3(grid), dim3(NTHR), LDS_BYTES, stream, a); }
#else
    a.ph_lo = 0; a.ph_hi = N_PHASES; hipLaunchKernelGGL(mk_fwd, dim3(grid), dim3(NTHR), LDS_BYTES, stream, a);
#endif
}
```
